# Optimizing an MI355X kernel written in HIP

```python
import math
import jax, jax.numpy as jnp
from jax import lax
import numpy as np

D_MODEL = 1024
BATCH = 8
SEQ = 2048
DEPTH = 4

N_MIXERS = 2
HEAD_DIM = 64
N_HEADS_A = 16
N_KV_HEADS_A = 4
GROUP_A = N_HEADS_A // N_KV_HEADS_A
WINDOW = 128
BLOCK_A = WINDOW
N_HEADS_B = 16
BLOCK_B = 128
D_FF = 4 * D_MODEL
N_BUCKETS = 32
MAX_DISTANCE = 128
EPS = 1e-6
NEG = -1e30
N_LAYERS_A = (DEPTH + 1) // 2
N_LAYERS_B = DEPTH // 2
QKV_A = (N_HEADS_A + 2 * N_KV_HEADS_A) * HEAD_DIM
HD_B = N_HEADS_B * HEAD_DIM
QKVF_B = 3 * HD_B + N_HEADS_B
FORGET_BIAS_MEAN = 3.0

kernel_name = "hybrid_swa_sink_fox_sqrelu"


def rmsnorm(x, g):
    xf = x.astype(jnp.float32)
    y = xf * lax.rsqrt(jnp.mean(xf * xf, axis=-1, keepdims=True) + EPS)
    return (y * g.astype(jnp.float32)).astype(x.dtype)


def t5_bucket(dist):
    max_exact = N_BUCKETS // 2
    d = jnp.maximum(dist, 0)
    dl = jnp.maximum(d, 1).astype(jnp.float32)
    large = max_exact + (jnp.log(dl / max_exact) / math.log(MAX_DISTANCE / max_exact)
                         * (N_BUCKETS - max_exact)).astype(jnp.int32)
    large = jnp.minimum(large, N_BUCKETS - 1)
    return jnp.where(d < max_exact, d, large)


def swa_sink_attention(h, w_qkv, b_qkv, w_o, b_o, sinks, rel_bias):
    B, S, _ = h.shape
    nb = S // BLOCK_A
    qkv = h @ w_qkv + b_qkv
    q, k, v = jnp.split(qkv, [N_HEADS_A * HEAD_DIM, (N_HEADS_A + N_KV_HEADS_A) * HEAD_DIM], axis=-1)
    q = q.reshape(B, nb, BLOCK_A, N_KV_HEADS_A, GROUP_A, HEAD_DIM)
    k = k.reshape(B, nb, BLOCK_A, N_KV_HEADS_A, HEAD_DIM)
    v = v.reshape(B, nb, BLOCK_A, N_KV_HEADS_A, HEAD_DIM)
    pad = jnp.zeros_like(k[:, :1])
    k2 = jnp.concatenate([jnp.concatenate([pad, k[:, :-1]], axis=1), k], axis=2)
    v2 = jnp.concatenate([jnp.concatenate([pad, v[:, :-1]], axis=1), v], axis=2)
    scale = 1.0 / math.sqrt(HEAD_DIM)
    scores = jnp.einsum('bnqhgd,bnkhd->bnhgqk', q, k2).astype(jnp.float32) * scale
    qi = jnp.arange(BLOCK_A, dtype=jnp.int32)[:, None]
    kj = jnp.arange(2 * BLOCK_A, dtype=jnp.int32)[None, :]
    dist = qi + BLOCK_A - kj
    bias = rel_bias[t5_bucket(dist)].astype(jnp.float32)
    bias = bias.transpose(2, 0, 1).reshape(N_KV_HEADS_A, GROUP_A, BLOCK_A, 2 * BLOCK_A)
    in_window = (dist >= 0) & (dist < WINDOW)
    blk = jnp.arange(nb, dtype=jnp.int32)[:, None, None]
    valid = in_window[None] & ((blk > 0) | (kj >= BLOCK_A)[None])
    scores = jnp.where(valid[None, :, None, None], scores + bias, NEG)
    sink = jnp.broadcast_to(sinks.astype(jnp.float32).reshape(N_KV_HEADS_A, GROUP_A, 1, 1),
                            scores.shape[:-1] + (1,))
    probs = jax.nn.softmax(jnp.concatenate([scores, sink], axis=-1), axis=-1)[..., :-1]
    out = jnp.einsum('bnhgqk,bnkhd->bnqhgd', probs.astype(v2.dtype), v2)
    out = out.reshape(B, S, N_HEADS_A * HEAD_DIM)
    return out @ w_o + b_o


def forgetting_attention(h, w_qkvf, b_f, w_o):
    B, S, _ = h.shape
    proj = h @ w_qkvf
    q, k, v, fz = jnp.split(proj, [HD_B, 2 * HD_B, 3 * HD_B], axis=-1)
    q = q.reshape(B, S, N_HEADS_B, HEAD_DIM)
    k = k.reshape(B, S, N_HEADS_B, HEAD_DIM)
    v = v.reshape(B, S, N_HEADS_B, HEAD_DIM)
    log_f = jax.nn.log_sigmoid((fz + b_f).astype(jnp.float32))
    c = jnp.cumsum(log_f, axis=1).transpose(0, 2, 1)
    scale = 1.0 / math.sqrt(HEAD_DIM)
    outs = []
    for n in range(S // BLOCK_B):
        q0, q1 = n * BLOCK_B, (n + 1) * BLOCK_B
        s = jnp.einsum('bqhd,bkhd->bhqk', q[:, q0:q1], k[:, :q1]).astype(jnp.float32) * scale
        decay = c[:, :, q0:q1, None] - c[:, :, None, :q1]
        causal = (q0 + jnp.arange(BLOCK_B)[:, None]) >= jnp.arange(q1)[None, :]
        p = jax.nn.softmax(jnp.where(causal, s + decay, NEG), axis=-1)
        outs.append(jnp.einsum('bhqk,bkhd->bqhd', p.astype(v.dtype), v[:, :q1]))
    out = jnp.concatenate(outs, axis=1).reshape(B, S, HD_B)
    return out @ w_o


def setup_inputs(seed: int = 0) -> dict:
    key = jax.random.key(seed)
    ks = jax.random.split(key, 16)
    nrm = jax.random.normal
    D = D_MODEL
    x = nrm(ks[0], (BATCH, SEQ, D), jnp.float32)
    rel_bias = 0.5 * nrm(ks[1], (N_BUCKETS, N_HEADS_A), jnp.float32)
    norm_mix = 1.0 + 0.05 * nrm(ks[2], (DEPTH, D), jnp.float32)
    norm_mlp = 1.0 + 0.05 * nrm(ks[3], (DEPTH, D), jnp.float32)
    w_qkv_a = nrm(ks[4], (N_LAYERS_A, D, QKV_A), jnp.float32) * D ** -0.5
    b_qkv_a = 0.02 * nrm(ks[5], (N_LAYERS_A, QKV_A), jnp.float32)
    sinks_a = 0.5 * nrm(ks[6], (N_LAYERS_A, N_HEADS_A), jnp.float32)
    w_o_a = nrm(ks[7], (N_LAYERS_A, N_HEADS_A * HEAD_DIM, D), jnp.float32) * (N_HEADS_A * HEAD_DIM) ** -0.5
    b_o_a = 0.02 * nrm(ks[8], (N_LAYERS_A, D), jnp.float32)
    col_scale = jnp.concatenate([jnp.ones((3 * HD_B,), jnp.float32),
                                 0.1 * jnp.ones((N_HEADS_B,), jnp.float32)])
    w_qkvf_b = nrm(ks[9], (N_LAYERS_B, D, QKVF_B), jnp.float32) * D ** -0.5 * col_scale
    b_f_b = FORGET_BIAS_MEAN + 0.5 * nrm(ks[10], (N_LAYERS_B, N_HEADS_B), jnp.float32)
    w_o_b = nrm(ks[11], (N_LAYERS_B, HD_B, D), jnp.float32) * HD_B ** -0.5
    w_up = nrm(ks[12], (DEPTH, D, D_FF), jnp.float32) * D ** -0.5
    w_down = nrm(ks[13], (DEPTH, D_FF, D), jnp.float32) * D_FF ** -0.5
    norm_final = 1.0 + 0.05 * nrm(ks[14], (D,), jnp.float32)
    return {"x": x, "rel_bias": rel_bias, "norm_mix": norm_mix, "norm_mlp": norm_mlp,
            "w_qkv_a": w_qkv_a, "b_qkv_a": b_qkv_a, "sinks_a": sinks_a, "w_o_a": w_o_a,
            "b_o_a": b_o_a, "w_qkvf_b": w_qkvf_b, "b_f_b": b_f_b, "w_o_b": w_o_b,
            "w_up": w_up, "w_down": w_down, "norm_final": norm_final}


def reference(x, rel_bias, norm_mix, norm_mlp, w_qkv_a, b_qkv_a, sinks_a, w_o_a, b_o_a,
              w_qkvf_b, b_f_b, w_o_b, w_up, w_down, norm_final):
    for i in range(DEPTH):
        h = rmsnorm(x, norm_mix[i])
        j = i // N_MIXERS
        if i % N_MIXERS == 0:
            x = x + swa_sink_attention(h, w_qkv_a[j], b_qkv_a[j], w_o_a[j], b_o_a[j],
                                       sinks_a[j], rel_bias)
        else:
            x = x + forgetting_attention(h, w_qkvf_b[j], b_f_b[j], w_o_b[j])
        h = rmsnorm(x, norm_mlp[i])
        x = x + jnp.square(jax.nn.relu(h @ w_up[i])) @ w_down[i]
    return rmsnorm(x, norm_final)
```

```cpp
#include <hip/hip_runtime.h>
#include <math.h>
#include <stdint.h>

namespace {
constexpr int D = 1024, NB = 8, S = 2048, M = NB * S, DEPTH = 4, HD = 64;
constexpr int QKV_A = 1536, QKVF_B = 3088, FF = 4096;
constexpr float EPS = 1e-6f;
constexpr int CB = 2;
constexpr int CR = CB * S;

__global__ void rmsnorm_k(const float* __restrict__ x, const float* __restrict__ g, float* __restrict__ y, int rows) {
    const int wave = (blockIdx.x * blockDim.x + threadIdx.x) >> 6, lane = threadIdx.x & 63;
    if (wave >= rows) return;
    const float4* xr = (const float4*)(x + (size_t)wave * D) + lane;
    float4 v[4]; float s = 0.f;
#pragma unroll
    for (int j = 0; j < 4; ++j) { v[j] = xr[64 * j]; s += v[j].x * v[j].x + v[j].y * v[j].y + v[j].z * v[j].z + v[j].w * v[j].w; }
#pragma unroll
    for (int o = 1; o < 64; o <<= 1) s += __shfl_xor(s, o);
    const float r = 1.0f / sqrtf(s * (1.0f / D) + EPS);
    float4* yr = (float4*)(y + (size_t)wave * D) + lane;
    const float4* gr = (const float4*)g + lane;
#pragma unroll
    for (int j = 0; j < 4; ++j) { const float4 gg = gr[64 * j]; float4 o; o.x = v[j].x * r * gg.x; o.y = v[j].y * r * gg.y; o.z = v[j].z * r * gg.z; o.w = v[j].w * r * gg.w; yr[64 * j] = o; }
}

__global__ void __launch_bounds__(256) gemm_k(const float* __restrict__ A, const float* __restrict__ W, const float* __restrict__ bias, float* C, int rows, int N, int K, int mode) {
    __shared__ float As[16][64 + 4];
    __shared__ float Ws[16][64 + 4];
    const int tid = threadIdx.x, tx = tid & 15, ty = tid >> 4;
    const int r0 = blockIdx.y * 64, c0 = blockIdx.x * 64;
    float acc[4][4];
#pragma unroll
    for (int i = 0; i < 4; ++i)
#pragma unroll
        for (int j = 0; j < 4; ++j) acc[i][j] = 0.f;
    for (int k0 = 0; k0 < K; k0 += 16) {
        { const int r = tid >> 2, kk = (tid & 3) * 4; const float4 a = *(const float4*)(A + (size_t)(r0 + r) * K + k0 + kk);
          As[kk + 0][r] = a.x; As[kk + 1][r] = a.y; As[kk + 2][r] = a.z; As[kk + 3][r] = a.w; }
        { const int kk = tid >> 4, c = (tid & 15) * 4; float4 w = make_float4(0.f, 0.f, 0.f, 0.f);
          if (c0 + c < N) w = *(const float4*)(W + (size_t)(k0 + kk) * N + c0 + c);
          *(float4*)&Ws[kk][c] = w; }
        __syncthreads();
#pragma unroll
        for (int kk = 0; kk < 16; ++kk) {
            const float4 a = *(const float4*)&As[kk][ty * 4]; const float4 w = *(const float4*)&Ws[kk][tx * 4];
            const float av[4] = {a.x, a.y, a.z, a.w}, wv[4] = {w.x, w.y, w.z, w.w};
#pragma unroll
            for (int i = 0; i < 4; ++i)
#pragma unroll
                for (int j = 0; j < 4; ++j) acc[i][j] = fmaf(av[i], wv[j], acc[i][j]);
        }
        __syncthreads();
    }
    const int c = c0 + tx * 4;
    if (c >= N) return;
    float4 bv = make_float4(0.f, 0.f, 0.f, 0.f);
    if (bias) bv = *(const float4*)(bias + c);
#pragma unroll
    for (int i = 0; i < 4; ++i) {
        float* cp = C + (size_t)(r0 + ty * 4 + i) * N + c;
        float4 o = make_float4(acc[i][0] + bv.x, acc[i][1] + bv.y, acc[i][2] + bv.z, acc[i][3] + bv.w);
        if (mode == 1) { o.x = o.x > 0.f ? o.x * o.x : 0.f; o.y = o.y > 0.f ? o.y * o.y : 0.f; o.z = o.z > 0.f ? o.z * o.z : 0.f; o.w = o.w > 0.f ? o.w * o.w : 0.f; }
        if (mode == 2) { const float4 p = *(const float4*)cp; o.x += p.x; o.y += p.y; o.z += p.z; o.w += p.w; }
        *(float4*)cp = o;
    }
}

__device__ __forceinline__ int t5_bucket(int d) {
    if (d < 16) return d;
    int b = 16 + (int)(logf((float)d / 16.0f) / 2.0794415416798357f * 16.0f);
    return b < 31 ? b : 31;
}

__global__ void __launch_bounds__(64) swa_k(const float* __restrict__ qkv, const float* __restrict__ rel_bias, const float* __restrict__ sinks, float* __restrict__ out) {
    const int lane = threadIdx.x;
    const int tb = blockIdx.x % (S / 64), head = (blockIdx.x / (S / 64)) % 16, b = blockIdx.x / (S / 64) / 16;
    const int t = tb * 64 + lane, kvh = head >> 2;
    __shared__ float btab[128];
    for (int d = lane; d < 128; d += 64) btab[d] = rel_bias[t5_bucket(d) * 16 + head];
    __syncthreads();
    const float* qp = qkv + (size_t)(b * S + t) * QKV_A + head * 64;
    float q[64];
#pragma unroll
    for (int d = 0; d < 64; d += 4) { const float4 v = *(const float4*)(qp + d); q[d] = v.x; q[d + 1] = v.y; q[d + 2] = v.z; q[d + 3] = v.w; }
    float acc[64];
#pragma unroll
    for (int d = 0; d < 64; ++d) acc[d] = 0.f;
    const float sink = sinks[head];
    float m = sink, l = 1.0f;
    const int s_lo = max(0, tb * 64 - 127), s_hi = tb * 64 + 63;
    for (int s = s_lo; s <= s_hi; ++s) {
        const float* kp = qkv + (size_t)(b * S + s) * QKV_A + 1024 + kvh * 64;
        const float* vp = kp + 256;
        float dot = 0.f;
#pragma unroll
        for (int d = 0; d < 64; ++d) dot = fmaf(q[d], kp[d], dot);
        const int dist = t - s;
        const bool valid = dist >= 0 && dist < 128;
        if (valid) {
            const float sc = dot * 0.125f + btab[dist];
            const float mn = fmaxf(m, sc), f = expf(m - mn), p = expf(sc - mn);
            l = l * f + p;
#pragma unroll
            for (int d = 0; d < 64; ++d) acc[d] = acc[d] * f + p * vp[d];
            m = mn;
        }
    }
    const float inv = 1.0f / l;
    float* op = out + (size_t)(b * S + t) * D + head * 64;
#pragma unroll
    for (int d = 0; d < 64; d += 4) *(float4*)(op + d) = make_float4(acc[d] * inv, acc[d + 1] * inv, acc[d + 2] * inv, acc[d + 3] * inv);
}

__global__ void __launch_bounds__(64) fcum_k(const float* __restrict__ proj, const float* __restrict__ bf, float* __restrict__ c) {
    const int lane = threadIdx.x, h = blockIdx.x % 16, b = blockIdx.x / 16;
    float v[32]; float s = 0.f; const float bb = bf[h];
    for (int i = 0; i < 32; ++i) { const float z = proj[(size_t)(b * S + lane * 32 + i) * QKVF_B + 3072 + h] + bb;
        const float ls = fminf(z, 0.f) - log1pf(expf(-fabsf(z))); s += ls; v[i] = s; }
    float pre = s;
#pragma unroll
    for (int o = 1; o < 64; o <<= 1) { const float u = __shfl_up(pre, o); if (lane >= o) pre += u; }
    const float base = pre - s;
    for (int i = 0; i < 32; ++i) c[(size_t)(b * 16 + h) * S + lane * 32 + i] = base + v[i];
}

__global__ void __launch_bounds__(64) fox_k(const float* __restrict__ proj, const float* __restrict__ c, float* __restrict__ out) {
    const int lane = threadIdx.x;
    const int tb = blockIdx.x % (S / 64), head = (blockIdx.x / (S / 64)) % 16, b = blockIdx.x / (S / 64) / 16;
    const int t = tb * 64 + lane;
    const float* qp = proj + (size_t)(b * S + t) * QKVF_B + head * 64;
    const float* cb = c + (size_t)(b * 16 + head) * S;
    float q[64];
#pragma unroll
    for (int d = 0; d < 64; d += 4) { const float4 v = *(const float4*)(qp + d); q[d] = v.x; q[d + 1] = v.y; q[d + 2] = v.z; q[d + 3] = v.w; }
    float acc[64];
#pragma unroll
    for (int d = 0; d < 64; ++d) acc[d] = 0.f;
    const float ct = cb[t];
    float m = -1e30f, l = 0.f;
    const int s_hi = tb * 64 + 63;
    for (int s = 0; s <= s_hi; ++s) {
        const float* kp = proj + (size_t)(b * S + s) * QKVF_B + 1024 + head * 64;
        const float* vp = kp + 1024;
        float dot = 0.f;
#pragma unroll
        for (int d = 0; d < 64; ++d) dot = fmaf(q[d], kp[d], dot);
        if (s <= t) {
            const float sc = dot * 0.125f + (ct - cb[s]);
            const float mn = fmaxf(m, sc), f = expf(m - mn), p = expf(sc - mn);
            l = l * f + p;
#pragma unroll
            for (int d = 0; d < 64; ++d) acc[d] = acc[d] * f + p * vp[d];
            m = mn;
        }
    }
    const float inv = 1.0f / l;
    float* op = out + (size_t)(b * S + t) * D + head * 64;
#pragma unroll
    for (int d = 0; d < 64; d += 4) *(float4*)(op + d) = make_float4(acc[d] * inv, acc[d + 1] * inv, acc[d + 2] * inv, acc[d + 3] * inv);
}
}

extern "C" void kernel_launch(void* const* d_in, const int* in_sizes, int n_in, void* d_out, int out_size, void* d_ws, size_t ws_size, hipStream_t stream) {
    const float* x = (const float*)d_in[0]; const float* rel_bias = (const float*)d_in[1];
    const float* norm_mix = (const float*)d_in[2]; const float* norm_mlp = (const float*)d_in[3];
    const float* w_qkv_a = (const float*)d_in[4]; const float* b_qkv_a = (const float*)d_in[5]; const float* sinks_a = (const float*)d_in[6];
    const float* w_o_a = (const float*)d_in[7]; const float* b_o_a = (const float*)d_in[8];
    const float* w_qkvf_b = (const float*)d_in[9]; const float* b_f_b = (const float*)d_in[10]; const float* w_o_b = (const float*)d_in[11];
    const float* w_up = (const float*)d_in[12]; const float* w_down = (const float*)d_in[13]; const float* norm_final = (const float*)d_in[14];
    float* out = (float*)d_out;
    float* ws = (float*)d_ws;
    float* xc = ws;
    float* hb = xc + (size_t)M * D;
    float* pj = hb + (size_t)CR * D;
    float* at = pj + (size_t)CR * QKVF_B;
    float* ff = at + (size_t)CR * D;
    float* cc = ff + (size_t)CR * FF;
    hipMemcpyAsync(xc, x, (size_t)M * D * 4, hipMemcpyDeviceToDevice, stream);
    for (int ch = 0; ch < NB / CB; ++ch) {
        float* xr = xc + (size_t)ch * CR * D;
        for (int i = 0; i < DEPTH; ++i) {
            const int j = i / 2;
            rmsnorm_k<<<CR / 4, 256, 0, stream>>>(xr, norm_mix + i * D, hb, CR);
            if (i % 2 == 0) {
                gemm_k<<<dim3(QKV_A / 64, CR / 64), 256, 0, stream>>>(hb, w_qkv_a + (size_t)j * D * QKV_A, b_qkv_a + j * QKV_A, pj, CR, QKV_A, D, 0);
                swa_k<<<CB * 16 * (S / 64), 64, 0, stream>>>(pj, rel_bias, sinks_a + j * 16, at);
                gemm_k<<<dim3(D / 64, CR / 64), 256, 0, stream>>>(at, w_o_a + (size_t)j * D * D, b_o_a + j * D, xr, CR, D, D, 2);
            } else {
                gemm_k<<<dim3((QKVF_B + 63) / 64, CR / 64), 256, 0, stream>>>(hb, w_qkvf_b + (size_t)j * D * QKVF_B, nullptr, pj, CR, QKVF_B, D, 0);
                fcum_k<<<CB * 16, 64, 0, stream>>>(pj, b_f_b + j * 16, cc);
                fox_k<<<CB * 16 * (S / 64), 64, 0, stream>>>(pj, cc, at);
                gemm_k<<<dim3(D / 64, CR / 64), 256, 0, stream>>>(at, w_o_b + (size_t)j * D * D, nullptr, xr, CR, D, D, 2);
            }
            rmsnorm_k<<<CR / 4, 256, 0, stream>>>(xr, norm_mlp + i * D, hb, CR);
            gemm_k<<<dim3(FF / 64, CR / 64), 256, 0, stream>>>(hb, w_up + (size_t)i * D * FF, nullptr, ff, CR, FF, D, 1);
            gemm_k<<<dim3(D / 64, CR / 64), 256, 0, stream>>>(ff, w_down + (size_t)i * FF * D, nullptr, xr, CR, D, FF, 2);
        }
        rmsnorm_k<<<CR / 4, 256, 0, stream>>>(xr, norm_final, out + (size_t)ch * CR * D, CR);
    }
}
```

```cpp
#include <hip/hip_runtime.h>
#include <cstdio>
#include <cstdint>
struct XcdBarrier; __device__ __forceinline__ void xcd_barrier(const XcdBarrier& b);
namespace pg8 {
#define PG8_LAS __attribute__((address_space(3)))
typedef unsigned short bf16_t;
typedef short bf16x8 __attribute__((ext_vector_type(8)));
typedef float f32x4 __attribute__((ext_vector_type(4)));
typedef unsigned u32x4 __attribute__((ext_vector_type(4)));
constexpr int BM = 256, BK = 64, HALF = 128, HTB = HALF * BK * 2  , STAGE_BYTES = 8 * HTB, NXCD = 8, WGM = 8;

__host__ __device__ __forceinline__ int lds_byte(int r, int c) { const int st = (r >> 4) * 2 + (c >> 5), rr = r & 15, cc = c & 31, ob = rr * 64 + cc * 2; return st * 1024 + (ob ^ (((ob >> 9) & 1) << 5)); }
__host__ __device__ __forceinline__ void stage_rc(int b, int& R, int& C) { const int st = b / 1024, sb = b % 1024, swz = sb ^ (((sb >> 9) & 1) << 5); R = (st >> 1) * 16 + swz / 64; C = (st & 1) * 32 + (swz % 64) / 2; }
__host__ __device__ __forceinline__ int perm32(int rho) { const int n = rho >> 4, i = rho & 15; return 8 * (i >> 2) + 4 * n + (i & 3); }

struct Unit { int pm, pn; };
struct Gemm { const bf16_t* A; const bf16_t* Bt; int M, N, K; size_t a_bstride; };

struct StaticOrder {
    int nM, nN, nwg, G, c;
    __host__ __device__ void init(int M, int N, int G_, int c_) { nM = M / BM; nN = N / BM; nwg = nM * nN; G = G_; c = c_; }
    __host__ __device__ bool next(int i, Unit& u) const {
        const long L = (long)i * G + c; if (L >= nwg) return false;
        int wgid = (int)L; { const int q = nwg / NXCD, r = nwg % NXCD, xcd = wgid % NXCD, off = wgid / NXCD; wgid = (xcd < r ? xcd * (q + 1) : r * (q + 1) + (xcd - r) * q) + off; }
        const int nig = WGM * nN, gid = wgid / nig, fm = gid * WGM, gsz = (nM - fm) < WGM ? (nM - fm) : WGM;
        u.pm = fm + ((wgid % nig) % gsz); u.pn = (wgid % nig) / gsz; return true;
    }
    __device__ __forceinline__ void a_ready(const Unit&) const {}
    __device__ __forceinline__ void done(const Unit&) const {}
};

constexpr float RMS_EPS = 1e-6f;
constexpr size_t EP_SSQ = (size_t)1 << 20, EP_XB = (size_t)94 << 20, EP_BLK = (size_t)128 << 20, EP_BLKB = (size_t)16 << 20, EP_KOFF = (size_t)4 << 20, EP_VOFF = (size_t)8 << 20;
constexpr float EP_C2 = 0.125f * 1.4426950408889634f;
typedef unsigned u32x2 __attribute__((ext_vector_type(2)));
__device__ __forceinline__ unsigned cvt_pk_bf16(float lo, float hi) { unsigned r; asm volatile("v_cvt_pk_bf16_f32 %0, %1, %2" : "=v"(r) : "v"(lo), "v"(hi)); return r; }
__device__ __forceinline__ float row_rstd(const float* ssq, int row) { const f32x4 s = *(const f32x4*)(ssq + 4 * (size_t)row); return 1.0f / sqrtf(((s[0] + s[1]) + (s[2] + s[3])) * (1.0f / 1024.0f) + RMS_EPS); }

struct EpiProj {
    static constexpr bool PERM = true, AFTER_DRAIN = false;
    unsigned char* ws; const float* bias; int mode;
    __device__ __forceinline__ void operator()(const f32x4 (&acc)[2][2][4][2], const Unit& u, int wr, int wc, int fr, int fq) const {
        const int row0 = u.pm * BM + wr * 64 + fr, lrow0 = (u.pm & 7) * BM + wr * 64 + fr;
        unsigned char* blk = ws + EP_BLK + (size_t)(u.pm >> 3) * EP_BLKB;
        const float* ssq = (const float*)(ws + EP_SSQ) + (mode == 2 ? (size_t)0 : (size_t)4 * 16384); bf16_t* Q = (bf16_t*)blk; bf16_t* Kp = (bf16_t*)(blk + EP_KOFF); bf16_t* Vp = (bf16_t*)(blk + EP_VOFF);
        const int nq = mode == 2 ? 16 : 4, nk = mode == 0 ? 1 : 4, ldq = mode == 2 ? 4096 : 1024, ldk = mode == 0 ? 256 : 1024, act = mode == 2 ? 1 : 0; const float scale0 = mode == 2 ? 1.0f : EP_C2;
        bf16_t* base; int ld, ct; float sc = 1.f;
        if (u.pn < nq) { base = Q; ld = ldq; ct = u.pn; sc = scale0; } else if (u.pn < nq + nk) { base = Kp; ld = ldk; ct = u.pn - nq; } else { base = Vp; ld = ldk; ct = u.pn - nq - nk; }
        const int col0 = ct * BM + wc * 64 + 8 * fq, bcol0 = u.pn * BM + wc * 64 + 8 * fq;
        f32x4 bv[2][2];
#pragma unroll
        for (int bj = 0; bj < 2; ++bj)
#pragma unroll
            for (int n = 0; n < 2; ++n) bv[bj][n] = bias ? *(const f32x4*)(bias + bcol0 + bj * 32 + 4 * n) : (f32x4){0.f, 0.f, 0.f, 0.f};
        float rs[2][4];
#pragma unroll
        for (int ai = 0; ai < 2; ++ai) {
#pragma unroll
            for (int m = 0; m < 4; ++m) rs[ai][m] = row_rstd(ssq, row0 + ai * HALF + m * 16);
            asm volatile("" ::: "memory"); }
#pragma unroll
        for (int ai = 0; ai < 2; ++ai)
#pragma unroll
            for (int m = 0; m < 4; ++m) { bf16_t* rowp = base + (size_t)(lrow0 + ai * HALF + m * 16) * ld + col0; const float r = rs[ai][m];
#pragma unroll
                for (int bj = 0; bj < 2; ++bj) { f32x4 v0 = acc[ai][bj][m][0] * r + bv[bj][0], v1 = acc[ai][bj][m][1] * r + bv[bj][1];
                    if (act == 1) {
#pragma unroll
                        for (int e = 0; e < 4; ++e) { const float a = fmaxf(v0[e], 0.f), b = fmaxf(v1[e], 0.f); v0[e] = a * a; v1[e] = b * b; } }
                    v0 = v0 * sc; v1 = v1 * sc; u32x4 w; w.x = cvt_pk_bf16(v0[0], v0[1]); w.y = cvt_pk_bf16(v0[2], v0[3]); w.z = cvt_pk_bf16(v1[0], v1[1]); w.w = cvt_pk_bf16(v1[2], v1[3]);
                    *(u32x4*)(rowp + bj * 32) = w; } }
    }
};

struct EpiRes {
    static constexpr bool PERM = true, AFTER_DRAIN = true;
    unsigned char* ws; const float* bias; int sq;
    float* fout; const float* fgain; const XcdBarrier* fbar;
    __device__ __forceinline__ void fused(f32x4 (&acc)[2][2][4][2], const Unit& u, int wr, int wc, int fr, int fq, PG8_LAS unsigned char* lds, int wid, int lane) const {
        bf16_t* xb = (bf16_t*)(ws + EP_XB); float* ssq = (float*)(ws + EP_SSQ) + (sq ? (size_t)4 * 16384 : 0);
        PG8_LAS float* P = (PG8_LAS float*)lds;
        const int col0 = u.pn * BM + wc * 64 + 8 * fq;
        f32x4 bv[2][2];
#pragma unroll
        for (int bj = 0; bj < 2; ++bj)
#pragma unroll
            for (int n = 0; n < 2; ++n) bv[bj][n] = bias ? *(const f32x4*)(bias + col0 + bj * 32 + 4 * n) : (f32x4){0.f, 0.f, 0.f, 0.f};
#pragma unroll
        for (int ai = 0; ai < 2; ++ai)
#pragma unroll
            for (int m = 0; m < 4; ++m) { const int r = ai * HALF + wr * 64 + m * 16 + fr; const size_t off = (size_t)(u.pm * BM + r) * 1024 + col0; float s = 0.f;
#pragma unroll
                for (int bj = 0; bj < 2; ++bj) { const u32x4 b = *(const u32x4*)(xb + off + bj * 32);
                    f32x4 o0 = acc[ai][bj][m][0] + bv[bj][0], o1 = acc[ai][bj][m][1] + bv[bj][1];
                    o0[0] += __uint_as_float(b.x << 16); o0[1] += __uint_as_float(b.x & 0xffff0000u); o0[2] += __uint_as_float(b.y << 16); o0[3] += __uint_as_float(b.y & 0xffff0000u);
                    o1[0] += __uint_as_float(b.z << 16); o1[1] += __uint_as_float(b.z & 0xffff0000u); o1[2] += __uint_as_float(b.w << 16); o1[3] += __uint_as_float(b.w & 0xffff0000u);
                    u32x4 w; w.x = cvt_pk_bf16(o0[0], o0[1]); w.y = cvt_pk_bf16(o0[2], o0[3]); w.z = cvt_pk_bf16(o1[0], o1[1]); w.w = cvt_pk_bf16(o1[2], o1[3]);
                    if (fout) { acc[ai][bj][m][0] = o0; acc[ai][bj][m][1] = o1; } else *(u32x4*)(xb + off + bj * 32) = w;
                    s += ((o0[0] * o0[0] + o0[1] * o0[1]) + (o0[2] * o0[2] + o0[3] * o0[3])) + ((o1[0] * o1[0] + o1[1] * o1[1]) + (o1[2] * o1[2] + o1[3] * o1[3])); }
                s += __shfl_xor(s, 16); s += __shfl_xor(s, 32);
                if (fq == 0) P[r * 4 + wc] = s;
                if (m == 3) asm volatile("" ::: "memory"); }
        asm volatile("s_waitcnt lgkmcnt(0)" ::: "memory"); __builtin_amdgcn_s_barrier(); asm volatile("" ::: "memory");
        const int tid = wid * 64 + lane;
        if (tid < 256) { const f32x4 p = *(const PG8_LAS f32x4*)(P + tid * 4); ssq[(size_t)(u.pm * BM + tid) * 4 + u.pn] = (p[0] + p[1]) + (p[2] + p[3]); }
        if (fout) {
            xcd_barrier(*fbar);
            f32x4 gv[2][2];
#pragma unroll
            for (int bj = 0; bj < 2; ++bj)
#pragma unroll
                for (int n = 0; n < 2; ++n) gv[bj][n] = *(const f32x4*)(fgain + col0 + bj * 32 + 4 * n);
#pragma unroll
            for (int ai = 0; ai < 2; ++ai)
#pragma unroll
                for (int m = 0; m < 4; ++m) { const int row = u.pm * BM + ai * HALF + wr * 64 + m * 16 + fr; const float rs = row_rstd(ssq, row); float* orow = fout + (size_t)row * 1024 + col0;
#pragma unroll
                    for (int bj = 0; bj < 2; ++bj)
#pragma unroll
                        for (int n = 0; n < 2; ++n) __builtin_nontemporal_store((acc[ai][bj][m][n] * rs) * gv[bj][n], (f32x4*)(orow + bj * 32 + 4 * n)); }
        }
    }
};

template <class Epi, class Sched, bool ALIGN_EPI = false, bool SP2 = false>
__device__ __forceinline__ void gemm_phase(PG8_LAS unsigned char* lds, const Gemm g, const Sched& S, const Epi& E) {
    int tid_ = threadIdx.x; asm volatile("" : "+v"(tid_));
    const int tid = tid_, wid = __builtin_amdgcn_readfirstlane(tid >> 6), lane = tid & 63, wr = wid >> 2, wc = wid & 3, fr = lane & 15, fq = lane >> 4;
    const int K = g.K, nt = K / BK;
    unsigned voffA[2], voffB[2];
#pragma unroll
    for (int i = 0; i < 2; ++i) { int R, C; stage_rc(tid * 16 + i * 8192, R, C); const int Rb = Epi::PERM ? ((R & ~31) + perm32(R & 31)) : R;
        voffA[i] = (unsigned)(R * K + C) * 2u; voffB[i] = (unsigned)(((Rb >> 5) * 64 + (Rb & 31)) * K + C) * 2u; }
    const size_t kstep = (size_t)(BK * 2);
    const size_t hstep = (size_t)HALF * K * 2;
    const size_t tstep = 2 * hstep;
    const size_t hstepB = (size_t)32 * K * 2;
    const unsigned ldsw = (unsigned)wid * 1024u;
    const int aoff = lds_byte(wr * 64 + fr, fq * 8), boff = lds_byte(wc * 32 + fr, fq * 8);
#define PG8_SA(b, h) (((b) * 2 + (h)) * HTB)
#define PG8_SB(b, h) ((4 + (b) * 2 + (h)) * HTB)
#define PG8_STAGE(bufoff, gbase, voff) do { _Pragma("unroll") for (int _i = 0; _i < 2; ++_i) \
        __builtin_amdgcn_global_load_lds((const unsigned*)((const char*)(gbase) + (voff)[_i]), (PG8_LAS unsigned*)(lds + (bufoff) + ldsw + _i * 8192), 16, 0, 0); } while (0)
#define PG8_LDA(dst, b, h) do { _Pragma("unroll") for (int m = 0; m < 4; ++m) _Pragma("unroll") for (int k = 0; k < 2; ++k) dst[m][k] = *(const PG8_LAS bf16x8*)(lds + PG8_SA(b, h) + aoff + m * 2048 + k * 1024); } while (0)
#define PG8_LDB(dst, b, h) do { _Pragma("unroll") for (int n = 0; n < 2; ++n) _Pragma("unroll") for (int k = 0; k < 2; ++k) dst[n][k] = *(const PG8_LAS bf16x8*)(lds + PG8_SB(b, h) + boff + n * 2048 + k * 1024); } while (0)
#define PG8_MMA(ai, bj, At, Bt) do { __builtin_amdgcn_s_setprio(1); _Pragma("unroll") for (int m = 0; m < 4; ++m) _Pragma("unroll") for (int n = 0; n < 2; ++n) _Pragma("unroll") for (int k = 0; k < 2; ++k) \
        acc[ai][bj][m][n] = __builtin_amdgcn_mfma_f32_16x16x32_bf16(Bt[n][k], At[m][k], acc[ai][bj][m][n], 0, 0, 0); __builtin_amdgcn_s_setprio(0); } while (0)
#define PG8_WAIT_V(n) asm volatile("s_waitcnt vmcnt(" #n ")" ::: "memory")
#define PG8_WAIT_L(n) asm volatile("s_waitcnt lgkmcnt(" #n ")" ::: "memory")
#define PG8_BAR __builtin_amdgcn_s_barrier()
#define PG8_SCHED __builtin_amdgcn_sched_barrier(0)
    Unit cur, nxt; int ui = 0;
    if (!S.next(0, cur)) return;
    f32x4 acc[2][2][4][2];
#pragma unroll
    for (int a = 0; a < 2; ++a)
#pragma unroll
        for (int b = 0; b < 2; ++b)
#pragma unroll
            for (int m = 0; m < 4; ++m)
#pragma unroll
                for (int n = 0; n < 2; ++n) acc[a][b][m][n] = (f32x4){0.f, 0.f, 0.f, 0.f};
    bf16x8 At[4][2], B0[2][2], B1[2][2];
    const char* cA = (const char*)g.A + (size_t)(cur.pm >> 3) * g.a_bstride + (size_t)(cur.pm & 7) * tstep; const char* cB = (const char*)g.Bt + (size_t)cur.pn * tstep;
    S.a_ready(cur);
    if constexpr (SP2) {
        PG8_STAGE(PG8_SB(0, 0), cB, voffB); PG8_STAGE(PG8_SB(0, 1), cB + hstepB, voffB); PG8_STAGE(PG8_SA(0, 0), cA, voffA); PG8_STAGE(PG8_SA(0, 1), cA + hstep, voffA);
        if (wr == 1) PG8_BAR;
        PG8_WAIT_V(2); PG8_BAR;
        PG8_STAGE(PG8_SB(1, 0), cB + kstep, voffB); PG8_STAGE(PG8_SA(1, 0), cA + kstep, voffA); PG8_STAGE(PG8_SB(1, 1), cB + hstepB + kstep, voffB);
        PG8_WAIT_V(6); PG8_BAR;
    } else {
        PG8_STAGE(PG8_SB(0, 0), cB, voffB); PG8_STAGE(PG8_SA(0, 0), cA, voffA); PG8_STAGE(PG8_SB(0, 1), cB + hstepB, voffB); PG8_STAGE(PG8_SA(0, 1), cA + hstep, voffA);
        if (wr == 1) PG8_BAR;
        PG8_WAIT_V(4); PG8_BAR;
        PG8_STAGE(PG8_SB(1, 0), cB + kstep, voffB); PG8_STAGE(PG8_SA(1, 0), cA + kstep, voffA); PG8_STAGE(PG8_SB(1, 1), cB + hstepB + kstep, voffB);
        PG8_WAIT_V(6); PG8_BAR;
    }
    for (;;) {
        const bool has_next = S.next(ui + 1, nxt);
        const char* nA = has_next ? (const char*)g.A + (size_t)(nxt.pm >> 3) * g.a_bstride + (size_t)(nxt.pm & 7) * tstep : cA; const char* nB = has_next ? (const char*)g.Bt + (size_t)nxt.pn * tstep : cB;
        for (int t = 0; t < nt; t += 2) {
            const bool last = (t == nt - 2);
            const char* a1 = cA + (size_t)(t + 1) * kstep;
            const char* a2 = last ? nA : cA + (size_t)(t + 2) * kstep; const char* b2 = last ? nB : cB + (size_t)(t + 2) * kstep;
            const char* a3 = a2 + kstep; const char* b3 = b2 + kstep;
            if (last && has_next) S.a_ready(nxt);
            if constexpr (SP2) {
            PG8_LDB(B0, 0, 0); PG8_LDB(B1, 0, 1); PG8_SCHED; PG8_LDA(At, 0, 0); PG8_STAGE(PG8_SA(1, 1), a1 + hstep, voffA);
            PG8_WAIT_V(8); PG8_WAIT_L(0); PG8_BAR; PG8_MMA(0, 0, At, B0); PG8_MMA(0, 1, At, B1); PG8_BAR; PG8_SCHED;
            PG8_LDA(At, 0, 1); PG8_STAGE(PG8_SB(0, 0), b2, voffB); PG8_STAGE(PG8_SB(0, 1), b2 + hstepB, voffB); PG8_STAGE(PG8_SA(0, 0), a2, voffA);
            PG8_WAIT_V(8); PG8_WAIT_L(0); PG8_BAR; PG8_MMA(1, 0, At, B0); PG8_MMA(1, 1, At, B1); PG8_BAR; PG8_SCHED;
            PG8_LDB(B0, 1, 0); PG8_LDB(B1, 1, 1); PG8_SCHED; PG8_LDA(At, 1, 0); PG8_STAGE(PG8_SA(0, 1), a2 + hstep, voffA);
            PG8_WAIT_V(8); PG8_WAIT_L(0); PG8_BAR; PG8_MMA(0, 0, At, B0); PG8_MMA(0, 1, At, B1); PG8_BAR; PG8_SCHED;
            PG8_LDA(At, 1, 1); PG8_STAGE(PG8_SB(1, 0), b3, voffB); PG8_STAGE(PG8_SB(1, 1), b3 + hstepB, voffB); PG8_STAGE(PG8_SA(1, 0), a3, voffA);
            PG8_WAIT_V(8); PG8_WAIT_L(0); PG8_BAR; PG8_MMA(1, 0, At, B0); PG8_MMA(1, 1, At, B1); PG8_BAR; PG8_SCHED;
            } else {
            PG8_LDB(B0, 0, 0); PG8_SCHED; PG8_LDA(At, 0, 0); PG8_STAGE(PG8_SA(1, 1), a1 + hstep, voffA);
            PG8_WAIT_L(8); PG8_BAR; PG8_WAIT_L(0); PG8_MMA(0, 0, At, B0); PG8_BAR; PG8_SCHED;
            PG8_LDB(B1, 0, 1); PG8_STAGE(PG8_SB(0, 0), b2, voffB);
            PG8_BAR; PG8_WAIT_L(0); PG8_MMA(0, 1, At, B1); PG8_BAR;
            PG8_LDA(At, 0, 1); PG8_STAGE(PG8_SA(0, 0), a2, voffA);
            PG8_BAR; PG8_WAIT_L(0); PG8_MMA(1, 0, At, B0); PG8_BAR; PG8_SCHED;
            PG8_STAGE(PG8_SB(0, 1), b2 + hstepB, voffB);
            PG8_WAIT_V(6); PG8_BAR; PG8_MMA(1, 1, At, B1); PG8_BAR;
            PG8_LDB(B0, 1, 0); PG8_SCHED; PG8_LDA(At, 1, 0); PG8_STAGE(PG8_SA(0, 1), a2 + hstep, voffA);
            PG8_WAIT_L(8); PG8_BAR; PG8_WAIT_L(0); PG8_MMA(0, 0, At, B0); PG8_BAR; PG8_SCHED;
            PG8_LDB(B1, 1, 1); PG8_STAGE(PG8_SB(1, 0), b3, voffB);
            PG8_BAR; PG8_WAIT_L(0); PG8_MMA(0, 1, At, B1); PG8_BAR;
            PG8_LDA(At, 1, 1); PG8_STAGE(PG8_SA(1, 0), a3, voffA);
            PG8_BAR; PG8_WAIT_L(0); PG8_MMA(1, 0, At, B0); PG8_BAR; PG8_SCHED;
            PG8_STAGE(PG8_SB(1, 1), b3 + hstepB, voffB);
            PG8_WAIT_V(6); PG8_BAR; PG8_MMA(1, 1, At, B1); PG8_BAR;
            }
        }
        if constexpr (ALIGN_EPI) { if (wr == 0) PG8_BAR; }
        if constexpr (!Epi::AFTER_DRAIN) { E(acc, cur, wr, wc, fr, fq); S.done(cur); }
        if (!has_next) break;
#pragma unroll
        for (int a = 0; a < 2; ++a)
#pragma unroll
            for (int b = 0; b < 2; ++b)
#pragma unroll
                for (int m = 0; m < 4; ++m)
#pragma unroll
                    for (int n = 0; n < 2; ++n) acc[a][b][m][n] = (f32x4){0.f, 0.f, 0.f, 0.f};
        cur = nxt; cA = nA; cB = nB; ++ui;
        if constexpr (ALIGN_EPI) { if (wr == 1) PG8_BAR; }
    }
    PG8_WAIT_V(0);
    if constexpr (!ALIGN_EPI) { if (wr == 0) PG8_BAR; }
    PG8_BAR;
    if constexpr (Epi::AFTER_DRAIN) { E.fused(acc, cur, wr, wc, fr, fq, lds, wid, lane); S.done(cur); }
#undef PG8_SA
#undef PG8_SB
#undef PG8_STAGE
#undef PG8_LDA
#undef PG8_LDB
#undef PG8_MMA
#undef PG8_WAIT_V
#undef PG8_WAIT_L
#undef PG8_BAR
#undef PG8_SCHED
}
}
#include <cmath>
namespace att {
typedef unsigned short bf16;
using bf16x8 = __attribute__((ext_vector_type(8))) short;
using s16x4 = __attribute__((ext_vector_type(4))) short;
using f32x16 = __attribute__((ext_vector_type(16))) float;
using f32x4 = __attribute__((ext_vector_type(4))) float;
using u32x4 = __attribute__((ext_vector_type(4))) unsigned;
#define ALAS __attribute__((address_space(3)))
constexpr int SEQ = 2048, D = 64, DM = 1024, NW = 8, QBLK = 32, QB = QBLK * NW, KVBLK = 64, NQB = SEQ / QB;
constexpr int NSLOT = 3, SLOTB = 8192;
constexpr int LDS_K = 0, LDS_V = NSLOT * SLOTB, LDS_WS = 2 * NSLOT * SLOTB, LDS_OST = LDS_WS + NW * 64 * 4, LDS_E = LDS_OST + NW * 4096  , LDS_TAB = LDS_E + 2048 * 4  , LDS_OFFS = LDS_TAB + 640 * 4, LDS_KX = LDS_OFFS + 512  , LDS_BYTES = LDS_KX + 2048 * 8 + 16;
constexpr float LOG2E = 1.4426950408889634f;
constexpr float C2 = 0.125f * LOG2E;
__device__ __forceinline__ int crow(int r, int hi) { return (r & 3) + 8 * (r >> 2) + 4 * hi; }
#define SBAR() __builtin_amdgcn_sched_barrier(0)
__device__ __forceinline__ void glds16(const void* gsrc, unsigned lds_dst) { unsigned keep;
  asm volatile("s_mov_b32 %0, m0\n\ts_mov_b32 m0, %2\n\ts_nop 0\n\tglobal_load_lds_dwordx4 %1, off\n\ts_mov_b32 m0, %0" : "=&s"(keep) : "v"(gsrc), "s"(lds_dst) : "memory"); }
typedef float f32x2_t __attribute__((ext_vector_type(2))); typedef __bf16 bf16x2_t __attribute__((ext_vector_type(2)));
__device__ __forceinline__ unsigned cvtpk_s(float lo, float hi) { f32x2_t v = {lo, hi}; bf16x2_t b = __builtin_convertvector(v, bf16x2_t); return __builtin_bit_cast(unsigned, b); }
#define WAIT_BAR(N) asm volatile("s_waitcnt vmcnt(" #N ") lgkmcnt(0)\n\ts_barrier" ::: "memory")
typedef ALAS const char* lds_cptr;
typedef short v4i16_t __attribute__((ext_vector_type(4)));
#define MX3(a, b, c) __builtin_fmaxf(__builtin_fmaxf((a), (b)), (c))
__device__ __forceinline__ float rowmax(const f32x16& p0, const f32x16& p1) {
  float a = MX3(p0[0], p0[1], p1[0]), b = MX3(p0[2], p0[3], p1[1]); a = MX3(a, p1[2], p1[3]);
#pragma unroll
  for (int r = 4; r < 16; r += 4) { a = MX3(a, p0[r], p0[r + 1]); b = MX3(b, p0[r + 2], p0[r + 3]); a = MX3(a, p1[r], p1[r + 1]); b = MX3(b, p1[r + 2], p1[r + 3]); }
  float m = __builtin_fmaxf(a, b); auto rr = __builtin_amdgcn_permlane32_swap(__float_as_uint(m), __float_as_uint(m), false, false);
  return __builtin_fmaxf(__uint_as_float(rr[0]), __uint_as_float(rr[1])); }
__device__ __forceinline__ void qkt(f32x16& p0, f32x16& p1, lds_cptr Kslot, const bf16x8* qr, const f32x16& cin, int r32, int hi) {
  lds_cptr kb = Kslot + hi * 1024 + r32 * 16;
#pragma unroll
  for (int d0 = 0; d0 < 4; ++d0) {
    const bf16x8 b0 = *(const ALAS bf16x8*)(kb + d0 * 2048);
    const bf16x8 b1 = *(const ALAS bf16x8*)(kb + d0 * 2048 + 512);
    if (d0 == 0) { p0 = __builtin_amdgcn_mfma_f32_32x32x16_bf16(b0, qr[0], cin, 0, 0, 0); p1 = __builtin_amdgcn_mfma_f32_32x32x16_bf16(b1, qr[0], cin, 0, 0, 0); }
    else { p0 = __builtin_amdgcn_mfma_f32_32x32x16_bf16(b0, qr[d0], p0, 0, 0, 0); p1 = __builtin_amdgcn_mfma_f32_32x32x16_bf16(b1, qr[d0], p1, 0, 0, 0); } }
}
__device__ __forceinline__ void pv(f32x16* o, int vb, bf16x8 pa0, bf16x8 pa1, bf16x8 pa2, bf16x8 pa3) {
#pragma unroll
  for (int d0 = 0; d0 < 2; ++d0) { s16x4 lo[4], hi[4];
#pragma unroll
    for (int ks = 0; ks < 4; ++ks) {
      asm volatile("ds_read_b64_tr_b16 %0,%1 offset:%c2" : "=&v"(lo[ks]) : "v"(vb), "i"(d0 * 4096 + ks * 1024) : "memory");
      asm volatile("ds_read_b64_tr_b16 %0,%1 offset:%c2" : "=&v"(hi[ks]) : "v"(vb), "i"(d0 * 4096 + ks * 1024 + 512) : "memory"); }
    asm volatile("s_waitcnt lgkmcnt(0)" ::: "memory"); SBAR();
#define PK(k) (bf16x8){lo[k][0], lo[k][1], lo[k][2], lo[k][3], hi[k][0], hi[k][1], hi[k][2], hi[k][3]}
    o[d0] = __builtin_amdgcn_mfma_f32_32x32x16_bf16(pa0, PK(0), o[d0], 0, 0, 0);
    o[d0] = __builtin_amdgcn_mfma_f32_32x32x16_bf16(pa1, PK(1), o[d0], 0, 0, 0);
    o[d0] = __builtin_amdgcn_mfma_f32_32x32x16_bf16(pa2, PK(2), o[d0], 0, 0, 0);
    o[d0] = __builtin_amdgcn_mfma_f32_32x32x16_bf16(pa3, PK(3), o[d0], 0, 0, 0);
#undef PK
  }
}
__device__ __forceinline__ int t5_bucket(int d) {
  if (d < 16) return d;
  const int b = 16 + (int)(__logf((float)d * (1.0f / 16.0f)) * (16.0f / 2.0794415416798357f));
  return b < 31 ? b : 31;
}
struct AttnAux { const float* rel_bias; const float* sinks; const float* CL; const float* CT; };

template <int MODE> __device__ __forceinline__ void attn_unit_v1(int b, int h, int qb, const bf16* Q, const bf16* __restrict__ K, const bf16* __restrict__ V, bf16* O, ALAS char* shm, const AttnAux& ax) {
  constexpr int KP = MODE == 0 ? 256 : 1024;
  int tid_ = threadIdx.x; asm volatile("" : "+v"(tid_));
  const int tid = tid_, lane = tid & 63, r32 = lane & 31, hi = lane >> 5; const int wid = __builtin_amdgcn_readfirstlane(tid >> 6);
  const int kvh = MODE == 0 ? (h >> 2) : h;
  const long rowbase = 0; const int q0 = qb * QB;
  const bf16* Qw = Q + (rowbase + q0 + wid * QBLK) * DM + h * D;
  const bf16* Kh = K + rowbase * KP + kvh * D, *Vh = V + rowbase * KP + kvh * D;
  const unsigned lds0 = (unsigned)(uintptr_t)shm;
  ALAS float* wsf = (ALAS float*)(shm + LDS_WS) + wid * 64;
  ALAS float* Ef = (ALAS float*)(shm + LDS_E);
  ALAS float* TAB = (ALAS float*)(shm + LDS_TAB);
  ALAS float* OFFS = (ALAS float*)(shm + LDS_OFFS);
  const bf16* ksrc = Kh + (long)lane * KP + wid * 8;
  const bf16* vsrc = Vh + (long)(16 * (wid & 3) + (lane >> 2)) * KP + (wid >> 2) * 32 + (lane & 3) * 8;
  const unsigned kdst = lds0 + LDS_K + wid * 1024, vdst = lds0 + LDS_V + wid * 1024;
#define DMA_K(t, slot) glds16(ksrc + (long)(t) * KVBLK * KP, (unsigned)__builtin_amdgcn_readfirstlane(kdst + (slot)))
#define DMA_V(t, slot) glds16(vsrc + (long)(t) * KVBLK * KP, (unsigned)__builtin_amdgcn_readfirstlane(vdst + (slot)))
  const int vb0 = (int)(lds0 + LDS_V) + ((lane >> 4) & 1) * 32 + (lane & 3) * 8 + (4 * hi + ((lane & 15) >> 2)) * 64;
  const lds_cptr Kbase = (lds_cptr)shm + LDS_K;
  const int t_lo = MODE == 0 ? (qb > 0 ? 4 * qb - 2 : 0) : 0, t_hi = 4 * qb + 3;
  bf16x8 qr[4];
#pragma unroll
  for (int d0 = 0; d0 < 4; ++d0) qr[d0] = *reinterpret_cast<const bf16x8*>(&Qw[(long)r32 * DM + d0 * 16 + hi * 8]);
  float mhat, l_reg; f32x16 o[2]; o[0] = f32x16{}; o[1] = f32x16{};
  const int qg = q0 + wid * QBLK + r32;
  bf16x8 qx = bf16x8{};
  if (MODE == 0) {
    { const int dist = tid - 256; float v = -INFINITY;
      if (dist >= 0 && dist < 128) v = ax.rel_bias[t5_bucket(dist) * 16 + h] * LOG2E;
      TAB[tid] = v; if (tid < 128) TAB[512 + tid] = -INFINITY; }
    mhat = ax.sinks[h] * LOG2E; l_reg = hi == 0 ? 1.0f : 0.0f;
  } else {
    if (wid == 0) { float v = (lane <= t_hi) ? ax.CT[(size_t)(b * 16 + h) * 32 + (lane & 31)] : 0.f; if (lane >= 32) v = 0.f; float inc = v;
#pragma unroll
      for (int s = 1; s < 32; s <<= 1) { const float uu = __shfl_up(inc, s); if (lane >= s) inc += uu; }
      if (lane < 32) OFFS[lane] = inc - v; }
    asm volatile("s_waitcnt lgkmcnt(0)\n\ts_barrier" ::: "memory");
    const float* cl = ax.CL + (size_t)(b * 16 + h) * SEQ;
    for (int k = tid; k < (t_hi + 1) * 64; k += 512) Ef[k] = -(cl[k] + OFFS[k >> 6]);
    mhat = -INFINITY; l_reg = 0.f;
    if (hi == 0) { qx[0] = 0x3F80; qx[1] = 0x3F80; qx[2] = 0x3F80; }
  }
  f32x16 zero16 = f32x16{}; asm volatile("" : "+v"(zero16));
  DMA_K(t_lo, 0); DMA_V(t_lo, 0);
  for (int t = t_lo; t <= t_hi; ++t) {
    const int sl = ((t - t_lo) & 1) * SLOTB;
    WAIT_BAR(0);
    if (t < t_hi) { DMA_K(t + 1, sl ^ SLOTB); DMA_V(t + 1, sl ^ SLOTB); }
    if (MODE == 0) {
      const int qw = q0 + wid * QBLK;
      if (64 * t > qw + 31 || 64 * t + 63 < qw - 127) continue;
    }
    f32x16 p0, p1;
    qkt(p0, p1, Kbase + sl, qr, zero16, r32, hi);
    if (MODE == 1) {
      bf16x8 kx0 = bf16x8{}, kx1 = bf16x8{};
      const float e0 = Ef[64 * t + r32], e1 = Ef[64 * t + 32 + r32];
      if (hi == 0) {
        { const unsigned a = cvtpk_s(e0, 0.f) & 0xffffu; const float r1 = e0 - __uint_as_float(a << 16); const unsigned bb = cvtpk_s(r1, 0.f) & 0xffffu; const float r2 = r1 - __uint_as_float(bb << 16); const unsigned c = cvtpk_s(r2, 0.f) & 0xffffu;
          kx0[0] = (short)a; kx0[1] = (short)bb; kx0[2] = (short)c; }
        { const unsigned a = cvtpk_s(e1, 0.f) & 0xffffu; const float r1 = e1 - __uint_as_float(a << 16); const unsigned bb = cvtpk_s(r1, 0.f) & 0xffffu; const float r2 = r1 - __uint_as_float(bb << 16); const unsigned c = cvtpk_s(r2, 0.f) & 0xffffu;
          kx1[0] = (short)a; kx1[1] = (short)bb; kx1[2] = (short)c; }
      }
      p0 = __builtin_amdgcn_mfma_f32_32x32x16_bf16(kx0, qx, p0, 0, 0, 0); p1 = __builtin_amdgcn_mfma_f32_32x32x16_bf16(kx1, qx, p1, 0, 0, 0);
      if (t >= 4 * qb) {
        const int kb = 64 * t + 4 * hi;
#pragma unroll
        for (int r = 0; r < 16; ++r) { const int kv = kb + (r & 3) + 8 * (r >> 2); if (kv > qg) p0[r] = -INFINITY; if (kv + 32 > qg) p1[r] = -INFINITY; }
      }
    } else {
      const int ib = 256 + qg - 64 * t - 4 * hi;
#pragma unroll
      for (int g = 0; g < 4; ++g) { const int idx = ib - 8 * g; f32x4 t0 = {TAB[idx], TAB[idx - 1], TAB[idx - 2], TAB[idx - 3]}, t1 = {TAB[idx - 32], TAB[idx - 33], TAB[idx - 34], TAB[idx - 35]};
        asm volatile("" : "+v"(t0), "+v"(t1));
#pragma unroll
        for (int e = 0; e < 4; ++e) { p0[4 * g + e] += t0[e]; p1[4 * g + e] += t1[e]; } }
    }
    const float rm = rowmax(p0, p1);
    const float mn = __builtin_fmaxf(mhat, rm), f = __builtin_amdgcn_exp2f(mhat - mn); mhat = mn;
    float sacc = 0.f;
#pragma unroll
    for (int r = 0; r < 16; ++r) { p0[r] = __builtin_amdgcn_exp2f(p0[r] - mn); p1[r] = __builtin_amdgcn_exp2f(p1[r] - mn); sacc += p0[r] + p1[r]; }
    l_reg = l_reg * f + sacc;
    if (hi == 0) wsf[r32] = f;
    asm volatile("s_waitcnt lgkmcnt(0)" ::: "memory");
#pragma unroll
    for (int d_ = 0; d_ < 2; ++d_)
#pragma unroll
      for (int r = 0; r < 16; ++r) o[d_][r] *= wsf[crow(r, hi)];
    u32x4 pw0, pw1, pw2, pw3;
#define PKW(P, B) cvtpk_s(P[B], P[B + 1])
    pw0 = (u32x4){PKW(p0, 0), PKW(p0, 2), PKW(p0, 4), PKW(p0, 6)}; pw1 = (u32x4){PKW(p0, 8), PKW(p0, 10), PKW(p0, 12), PKW(p0, 14)};
    pw2 = (u32x4){PKW(p1, 0), PKW(p1, 2), PKW(p1, 4), PKW(p1, 6)}; pw3 = (u32x4){PKW(p1, 8), PKW(p1, 10), PKW(p1, 12), PKW(p1, 14)};
#undef PKW
    SBAR(); pv(o, vb0 + sl, __builtin_bit_cast(bf16x8, pw0), __builtin_bit_cast(bf16x8, pw1), __builtin_bit_cast(bf16x8, pw2), __builtin_bit_cast(bf16x8, pw3));
  }
  { auto rr = __builtin_amdgcn_permlane32_swap(__float_as_uint(l_reg), __float_as_uint(l_reg), false, false); l_reg = __uint_as_float(rr[0]) + __uint_as_float(rr[1]); }
  if (hi == 0) wsf[32 + r32] = l_reg;
  asm volatile("s_waitcnt lgkmcnt(0)" ::: "memory");
  float rli[16];
#pragma unroll
  for (int r = 0; r < 16; ++r) rli[r] = __builtin_amdgcn_rcpf(wsf[32 + crow(r, hi)]);
  bf16* Ow = O + (rowbase + q0 + wid * QBLK) * DM + h * D;
  { ALAS bf16* stg = (ALAS bf16*)(shm + LDS_OST) + wid * 2048;
#pragma unroll
    for (int r = 0; r < 16; ++r) { const int orow = crow(r, hi);
#pragma unroll
      for (int d0 = 0; d0 < 2; ++d0) stg[orow * 64 + d0 * 32 + r32] = (bf16)(cvtpk_s(o[d0][r] * rli[r], 0.f) & 0xffffu); }
    asm volatile("s_waitcnt lgkmcnt(0)" ::: "memory");
#pragma unroll
    for (int i = 0; i < 4; ++i) { const int row = i * 8 + (lane >> 3), ch = lane & 7; const u32x4 v = *(const ALAS u32x4*)(stg + row * 64 + ch * 8); *(u32x4*)(Ow + (long)row * DM + ch * 8) = v; } }
  asm volatile("s_waitcnt lgkmcnt(0)\n\ts_barrier" ::: "memory");
#undef DMA_K
#undef DMA_V
}

__device__ __forceinline__ void attn_swa_sweep(int h, int half, const bf16* Q, const bf16* __restrict__ K, const bf16* __restrict__ V, bf16* O, ALAS char* shm, const AttnAux& ax) {
  constexpr int KP = 256, NS = 4, NPAIR = 9;
  constexpr int S_K = 0, S_V = NS * SLOTB, S_WS = 2 * NS * SLOTB, S_QST = S_WS + NW * 64 * 4, S_OST = S_QST + NW * 4096, S_TAB = S_OST + NW * 1024;
  static_assert(S_TAB + 640 * 4 <= 131072, "sweep scratch inside the 128 KiB ring region");
  int tid_ = threadIdx.x; asm volatile("" : "+v"(tid_));
  const int tid = tid_, lane = tid & 63, r32 = lane & 31, hi = lane >> 5; const int wid = __builtin_amdgcn_readfirstlane(tid >> 6);
  const int kvh = h >> 2, R0 = 1024 * half, T0 = R0 / 64 - 2;
  const int j0 = (wid & 1) | ((wid & 2) << 1) | ((wid & 4) >> 1), a0 = j0 >> 2; const bool kodd = ((j0 >> 1) & 1) != 0;
  const bf16* Kh = K + kvh * D, *Vh = V + kvh * D;
  const unsigned lds0 = (unsigned)(uintptr_t)shm;
  ALAS float* wsf = (ALAS float*)(shm + S_WS) + wid * 64;
  ALAS float* TAB = (ALAS float*)(shm + S_TAB);
  const bf16* ksrc = Kh + (long)lane * KP + wid * 8;
  const bf16* vsrc = Vh + (long)(16 * (wid & 3) + (lane >> 2)) * KP + (wid >> 2) * 32 + (lane & 3) * 8;
  const unsigned kdst = lds0 + S_K + wid * 1024, vdst = lds0 + S_V + wid * 1024;
#define DMA_KV(s_) do { const int t__ = T0 + (s_) < 0 ? 0 : T0 + (s_); const int sl__ = ((s_) & (NS - 1)) * SLOTB; glds16(ksrc + (long)t__ * KVBLK * KP, (unsigned)__builtin_amdgcn_readfirstlane(kdst + sl__)); \
                        glds16(vsrc + (long)t__ * KVBLK * KP, (unsigned)__builtin_amdgcn_readfirstlane(vdst + sl__)); } while (0)
  const int vb0 = (int)(lds0 + S_V) + ((lane >> 4) & 1) * 32 + (lane & 3) * 8 + (4 * hi + ((lane & 15) >> 2)) * 64;
  const lds_cptr Kbase = (lds_cptr)shm + S_K;
  const bf16* qsrc = Q + (long)(R0 + 32 * j0 + (lane >> 3)) * DM + h * D + (((lane & 7) ^ ((lane >> 3) & 7)) * 8);
  const unsigned qdst = lds0 + S_QST + wid * 4096;
#define QDMA(blk) do { const bf16* q__ = qsrc + (long)(blk) * 256 * DM; \
    glds16(q__, (unsigned)__builtin_amdgcn_readfirstlane(qdst)); glds16(q__ + 8 * DM, (unsigned)__builtin_amdgcn_readfirstlane(qdst + 1024)); \
    glds16(q__ + 16 * DM, (unsigned)__builtin_amdgcn_readfirstlane(qdst + 2048)); glds16(q__ + 24 * DM, (unsigned)__builtin_amdgcn_readfirstlane(qdst + 3072)); } while (0)
  const lds_cptr qrd = (lds_cptr)shm + S_QST + wid * 4096 + r32 * 128;
  asm volatile("s_waitcnt lgkmcnt(0)\n\ts_barrier" ::: "memory");
  QDMA(0); DMA_KV(0); DMA_KV(1);
  { const int dist = tid - 256; float v = -INFINITY;
    if (dist >= 0 && dist < 128) v = ax.rel_bias[t5_bucket(dist) * 16 + h] * LOG2E;
    TAB[tid] = v; if (tid < 128) TAB[512 + tid] = -INFINITY; }
  const float sink2 = ax.sinks[h] * LOG2E;
  bf16* Ow = O + (long)(R0 + 32 * j0) * DM + h * D;
  bf16x8 qr[4]; qr[0] = bf16x8{}; qr[1] = bf16x8{}; qr[2] = bf16x8{}; qr[3] = bf16x8{};
  float mhat = 0.f, l_reg = 0.f; f32x16 o[2]; o[0] = f32x16{}; o[1] = f32x16{}; int qg = 0;
  f32x16 zero16 = f32x16{}; asm volatile("" : "+v"(zero16));
  for (int P = 0; P <= NPAIR; ++P) {
    if (P < NPAIR) {
      asm volatile("s_waitcnt vmcnt(0) lgkmcnt(0)\n\ts_barrier" ::: "memory");
      if (P + 1 < NPAIR) { DMA_KV(2 * P + 2); DMA_KV(2 * P + 3); }
    }
    const int q = P - a0;
    if (q < 0 || q > 8) continue;
    const bool second = (q & 1) != 0;
    if (!second) {
      if (q >= 2) {
        const int u = (q >> 1) - 1;
        { auto rr = __builtin_amdgcn_permlane32_swap(__float_as_uint(l_reg), __float_as_uint(l_reg), false, false); l_reg = __uint_as_float(rr[0]) + __uint_as_float(rr[1]); }
        if (hi == 0) wsf[32 + r32] = l_reg;
        asm volatile("s_waitcnt lgkmcnt(0)" ::: "memory");
        ALAS bf16* stg = (ALAS bf16*)(shm + S_OST) + wid * 512;
        bf16* Ob = Ow + (long)u * 256 * DM + (long)(lane >> 3) * DM + (lane & 7) * 8;
#pragma unroll
        for (int i = 0; i < 4; ++i) {
#pragma unroll
          for (int rr = 0; rr < 4; ++rr) { const int r = 4 * i + rr; const float rl = __builtin_amdgcn_rcpf(wsf[32 + crow(r, hi)]);
#pragma unroll
            for (int d0 = 0; d0 < 2; ++d0) stg[(rr + 4 * hi) * 64 + d0 * 32 + r32] = (bf16)(cvtpk_s(o[d0][r] * rl, 0.f) & 0xffffu); }
          asm volatile("s_waitcnt lgkmcnt(0)" ::: "memory");
          const u32x4 v = *(const ALAS u32x4*)(stg + lane * 8);
          asm volatile("s_waitcnt lgkmcnt(0)" ::: "memory");
          *(u32x4*)(Ob + (long)(8 * i) * DM) = v;
        }
      }
      if (q == 8) continue;
      const int u = q >> 1;
#pragma unroll
      for (int d0 = 0; d0 < 4; ++d0) qr[d0] = *(const ALAS bf16x8*)(qrd + (((2 * d0 + hi) ^ (r32 & 7)) * 16));
      asm volatile("s_waitcnt lgkmcnt(0)" ::: "memory");
      if (u < 3) QDMA(u + 1);
      mhat = sink2; l_reg = hi == 0 ? 1.0f : 0.0f; o[0] = f32x16{}; o[1] = f32x16{};
      qg = R0 + 32 * (j0 + 8 * u) + r32;
    }
    for (int e = 0; e < 2; ++e) {
      if (e == 0 ? (kodd && !second) : (!kodd && second)) continue;
      const int s = 2 * P + e, t = T0 + s;
      if (t < 0) continue;
      const int sl = (s & (NS - 1)) * SLOTB;
      f32x16 p0, p1;
      { const int ib = 256 + qg - 64 * t - 4 * hi;
#pragma unroll
        for (int g = 0; g < 4; ++g) { const int idx = ib - 8 * g; f32x4 t0 = {TAB[idx], TAB[idx - 1], TAB[idx - 2], TAB[idx - 3]}, t1 = {TAB[idx - 32], TAB[idx - 33], TAB[idx - 34], TAB[idx - 35]};
          asm volatile("" : "+v"(t0), "+v"(t1));
#pragma unroll
          for (int ee = 0; ee < 4; ++ee) { p0[4 * g + ee] = t0[ee] - mhat; p1[4 * g + ee] = t1[ee] - mhat; } } }
      { lds_cptr kb = Kbase + sl + hi * 1024 + r32 * 16;
#pragma unroll
        for (int d0 = 0; d0 < 4; ++d0) { const bf16x8 b0 = *(const ALAS bf16x8*)(kb + d0 * 2048), b1 = *(const ALAS bf16x8*)(kb + d0 * 2048 + 512);
          p0 = __builtin_amdgcn_mfma_f32_32x32x16_bf16(b0, qr[d0], p0, 0, 0, 0); p1 = __builtin_amdgcn_mfma_f32_32x32x16_bf16(b1, qr[d0], p1, 0, 0, 0); } }
      const float rm = rowmax(p0, p1);
      const bool mv = rm > 8.0f;
      if (__builtin_expect(__any(mv), 0)) {
        const float dl = mv ? rm : 0.f, f = __builtin_amdgcn_exp2f(-dl); mhat += dl;
#pragma unroll
        for (int r = 0; r < 16; ++r) { p0[r] -= dl; p1[r] -= dl; }
        l_reg *= f;
        if (hi == 0) wsf[r32] = f;
        asm volatile("s_waitcnt lgkmcnt(0)" ::: "memory");
#pragma unroll
        for (int d_ = 0; d_ < 2; ++d_)
#pragma unroll
          for (int r = 0; r < 16; ++r) o[d_][r] *= wsf[crow(r, hi)];
      }
      float sa0 = 0.f, sa1 = 0.f;
#pragma unroll
      for (int r = 0; r < 16; ++r) { p0[r] = __builtin_amdgcn_exp2f(p0[r]); p1[r] = __builtin_amdgcn_exp2f(p1[r]); sa0 += p0[r]; sa1 += p1[r]; }
      l_reg += sa0 + sa1;
      u32x4 pw0, pw1, pw2, pw3;
#define PKW(P_, B) cvtpk_s(P_[B], P_[B + 1])
      pw0 = (u32x4){PKW(p0, 0), PKW(p0, 2), PKW(p0, 4), PKW(p0, 6)}; pw1 = (u32x4){PKW(p0, 8), PKW(p0, 10), PKW(p0, 12), PKW(p0, 14)};
      pw2 = (u32x4){PKW(p1, 0), PKW(p1, 2), PKW(p1, 4), PKW(p1, 6)}; pw3 = (u32x4){PKW(p1, 8), PKW(p1, 10), PKW(p1, 12), PKW(p1, 14)};
#undef PKW
      SBAR(); pv(o, vb0 + sl, __builtin_bit_cast(bf16x8, pw0), __builtin_bit_cast(bf16x8, pw1), __builtin_bit_cast(bf16x8, pw2), __builtin_bit_cast(bf16x8, pw3));
    }
  }
#undef DMA_KV
#undef QDMA
}

__device__ __forceinline__ void kload8(bf16x8* kf, lds_cptr kp) {
  kf[0] = *(const ALAS bf16x8*)(kp);        kf[1] = *(const ALAS bf16x8*)(kp + 512);
  kf[2] = *(const ALAS bf16x8*)(kp + 2048); kf[3] = *(const ALAS bf16x8*)(kp + 2560);
  kf[4] = *(const ALAS bf16x8*)(kp + 4096); kf[5] = *(const ALAS bf16x8*)(kp + 4608);
  kf[6] = *(const ALAS bf16x8*)(kp + 6144); kf[7] = *(const ALAS bf16x8*)(kp + 6656);
}
__device__ __forceinline__ void kload2(bf16x8* kf, lds_cptr kp, int j) { kf[2 * j] = *(const ALAS bf16x8*)(kp + j * 2048); kf[2 * j + 1] = *(const ALAS bf16x8*)(kp + j * 2048 + 512); }
__device__ __forceinline__ s16x4 vtr(lds_cptr p) { return __builtin_bit_cast(s16x4, __builtin_amdgcn_ds_read_tr16_b64_v4i16((ALAS v4i16_t*)p)); }
__device__ __forceinline__ void cmask(f32x16& p0, f32x16& p1, int jb, int qrel, int hi) {
  const int kb = 64 * jb + 4 * hi;
#pragma unroll
  for (int r = 0; r < 16; ++r) { const int kv = kb + (r & 3) + 8 * (r >> 2); if (kv > qrel) p0[r] = -INFINITY; if (kv + 32 > qrel) p1[r] = -INFINITY; }
}
__device__ __forceinline__ bf16x8 kx_frag(float e, int hi) {
  const unsigned a = cvtpk_s(e, 0.f) & 0xffffu; const float r1 = e - __uint_as_float(a << 16);
  const unsigned bb = cvtpk_s(r1, 0.f) & 0xffffu; const float r2 = r1 - __uint_as_float(bb << 16);
  const unsigned c = cvtpk_s(r2, 0.f) & 0xffffu;
  u32x4 w = {hi == 0 ? (a | (bb << 16)) : 0u, hi == 0 ? (c | 0x3F800000u) : 0u, hi == 0 ? 0x3F803F80u : 0u, 0u};
  return __builtin_bit_cast(bf16x8, w);
}
__device__ __forceinline__ bf16x8 qx_frag(float nm, int hi) {
  const unsigned a = cvtpk_s(nm, 0.f) & 0xffffu; const float r1 = nm - __uint_as_float(a << 16);
  const unsigned bb = cvtpk_s(r1, 0.f) & 0xffffu; const float r2 = r1 - __uint_as_float(bb << 16);
  const unsigned c = cvtpk_s(r2, 0.f) & 0xffffu;
  u32x4 w = {hi == 0 ? 0x3F803F80u : 0u, hi == 0 ? (0x3F80u | (a << 16)) : 0u, hi == 0 ? (bb | (c << 16)) : 0u, 0u};
  return __builtin_bit_cast(bf16x8, w);
}

template <int MODE, int THRL> __device__ __forceinline__ void attn_unit_v2(int b, int h, int qb, const bf16* Q, const bf16* __restrict__ K, const bf16* __restrict__ V, bf16* O, ALAS char* shm, const AttnAux& ax, bool stage) {
  constexpr int KP = MODE == 0 ? 256 : 1024;
  int tid_ = threadIdx.x; asm volatile("" : "+v"(tid_));
  const int tid = tid_, lane = tid & 63, r32 = lane & 31, hi = lane >> 5; const int wid = __builtin_amdgcn_readfirstlane(tid >> 6);
  const int kvh = MODE == 0 ? (h >> 2) : h;
  const long rowbase = 0; const int q0 = qb * QB;
  const int tb = MODE == 0 ? (qb > 0 ? 4 * qb - 2 : 0) : 0; const int NT = 4 * qb + 4 - tb;
  const bf16* Qw = Q + (rowbase + q0 + wid * QBLK) * DM + h * D;
  const bf16* Kh = K + (rowbase + (long)tb * KVBLK) * KP + kvh * D, *Vh = V + (rowbase + (long)tb * KVBLK) * KP + kvh * D;
  const unsigned lds0 = (unsigned)(uintptr_t)shm;
  ALAS float* wsf = (ALAS float*)(shm + LDS_WS) + wid * 64;
  ALAS float* Ef = (ALAS float*)(shm + LDS_E);
  ALAS float* TAB = (ALAS float*)(shm + LDS_TAB);
  ALAS float* OFFS = (ALAS float*)(shm + LDS_OFFS);
  typedef unsigned u32x2_t __attribute__((ext_vector_type(2)));
  ALAS u32x2_t* KX = (ALAS u32x2_t*)(shm + LDS_KX);
  const int kxi = hi == 0 ? r32 : SEQ, kxs = hi == 0 ? 64 : 0, kxh = hi == 0 ? 32 : 0; const unsigned kxc = hi == 0 ? 0x3F803F80u : 0u;
  const bf16* ksrc = Kh + (long)lane * KP + wid * 8;
  const bf16* vsrc = Vh + (long)(16 * (wid & 3) + (lane >> 2)) * KP + (wid >> 2) * 32 + (lane & 3) * 8;
  const unsigned kdst = lds0 + LDS_K + wid * 1024, vdst = lds0 + LDS_V + wid * 1024;
#define DMA_K(t, slot) glds16(ksrc + (long)(t) * KVBLK * KP, (unsigned)__builtin_amdgcn_readfirstlane(kdst + (slot)))
#define DMA_V(t, slot) glds16(vsrc + (long)(t) * KVBLK * KP, (unsigned)__builtin_amdgcn_readfirstlane(vdst + (slot)))
  const int vb0 = (int)(lds0 + LDS_V) + ((lane >> 4) & 1) * 32 + (lane & 3) * 8 + (4 * hi + ((lane & 15) >> 2)) * 64;
  const lds_cptr shm3 = (lds_cptr)shm; const lds_cptr kp0 = shm3 + LDS_K + hi * 1024 + r32 * 16; const lds_cptr vp0 = shm3 + LDS_V + ((lane >> 4) & 1) * 32 + (lane & 3) * 8 + (4 * hi + ((lane & 15) >> 2)) * 64;
  bf16x8 kf[8];
  DMA_K(0, 0); DMA_V(0, 0); DMA_K(1, SLOTB);
  bf16x8 qr[4];
#pragma unroll
  for (int d0 = 0; d0 < 4; ++d0) qr[d0] = *reinterpret_cast<const bf16x8*>(&Qw[(long)r32 * DM + d0 * 16 + hi * 8]);
  const int qrel = wid * QBLK + r32, qg = q0 + qrel;
  bf16x8 qx = bf16x8{};
  if (MODE == 0) {
    for (int i = tid; i < 640; i += 512) { const int dist = i - 256; float v = -INFINITY;
      if (dist >= 0 && dist < 128) v = ax.rel_bias[t5_bucket(dist) * 16 + h] * LOG2E;
      TAB[i] = v; }
  } else if (stage) {
    if (wid == 0) { float v = ax.CT[(size_t)(b * 16 + h) * 32 + (lane & 31)]; if (lane >= 32) v = 0.f; float inc = v;
#pragma unroll
      for (int s = 1; s < 32; s <<= 1) { const float uu = __shfl_up(inc, s); if (lane >= s) inc += uu; }
      if (lane < 32) OFFS[lane] = inc - v; }
    asm volatile("s_waitcnt lgkmcnt(0)\n\ts_barrier" ::: "memory");
    const float* cl = ax.CL + (size_t)(b * 16 + h) * SEQ;
    for (int k = tid; k < SEQ; k += 512) { const float e = -(cl[k] + OFFS[k >> 6]); Ef[k] = e;
      const unsigned a = cvtpk_s(e, 0.f) & 0xffffu; const float r1 = e - __uint_as_float(a << 16);
      const unsigned bb = cvtpk_s(r1, 0.f) & 0xffffu; const float r2 = r1 - __uint_as_float(bb << 16);
      const unsigned c = cvtpk_s(r2, 0.f) & 0xffffu;
      KX[k] = (u32x2_t){a | (bb << 16), c | 0x3F800000u}; }
    if (tid == 0) KX[SEQ] = (u32x2_t){0u, 0u};
  }
  DMA_K(2, 2 * SLOTB);
  WAIT_BAR(3);
  float mhat, l_reg; f32x16 o[2]; o[0] = f32x16{}; o[1] = f32x16{};
  if (MODE == 0) { mhat = ax.sinks[h] * LOG2E; l_reg = hi == 0 ? 1.0f : 0.0f; }
  else { mhat = Ef[qg]; l_reg = 0.f; }
  f32x16 negm = f32x16{};
  if (MODE == 0) {
#pragma unroll
    for (int r = 0; r < 16; ++r) negm[r] = -mhat;
    asm volatile("" : "+v"(negm)); }
  else qx = qx_frag(-mhat, hi);
  bool resc = false;
  u32x2_t ec0 = {0u, 0u}, ec1 = {0u, 0u};
#define MASKB(C0, C1, t) do { if (MODE == 0) { const int ib_ = 256 + qg - 64 * (tb + (t)) - 4 * hi; \
      _Pragma("unroll") for (int r = 0; r < 16; ++r) { const int idx_ = ib_ - ((r & 3) + 8 * (r >> 2)); C0[r] += TAB[idx_]; C1[r] += TAB[idx_ - 32]; } } \
    else { const int jb_ = (t) - (NT - 4); if (jb_ >= 0) cmask(C0, C1, jb_, qrel, hi); } } while (0)
#define DECIDE(C0, C1) do { float a = MX3(C0[0], C0[1], C1[0]), b_ = MX3(C0[2], C0[3], C1[1]); a = MX3(a, C1[2], C1[3]); \
      _Pragma("unroll") for (int r = 4; r < 16; r += 4) { a = MX3(a, C0[r], C0[r + 1]); b_ = MX3(b_, C0[r + 2], C0[r + 3]); a = MX3(a, C1[r], C1[r + 1]); b_ = MX3(b_, C1[r + 2], C1[r + 3]); } \
      float rm = __builtin_fmaxf(a, b_); { auto rr = __builtin_amdgcn_permlane32_swap(__float_as_uint(rm), __float_as_uint(rm), false, false); rm = __builtin_fmaxf(__uint_as_float(rr[0]), __uint_as_float(rr[1])); } \
      resc = false; \
      if (__builtin_expect(__any(rm > (float)THRL), 0)) { const float dl = __builtin_fmaxf(rm, 0.f); mhat += dl; \
        _Pragma("unroll") for (int r = 0; r < 16; ++r) { C0[r] -= dl; C1[r] -= dl; } \
        if (MODE == 0) { _Pragma("unroll") for (int r = 0; r < 16; ++r) negm[r] = -mhat; asm volatile("" : "+v"(negm)); } else qx = qx_frag(-mhat, hi); \
        const float f = __builtin_amdgcn_exp2f(-dl); l_reg *= f; if (hi == 0) wsf[r32] = f; resc = true; } } while (0)
#define RESC() do { if (resc) { asm volatile("s_waitcnt lgkmcnt(0)" ::: "memory"); \
      _Pragma("unroll") for (int d_ = 0; d_ < 2; ++d_) _Pragma("unroll") for (int r = 0; r < 16; ++r) o[d_][r] *= wsf[crow(r, hi)]; } } while (0)
  f32x16 pA0, pA1, pB0, pB1;
  int sl_prev = 0, sl_cur = 0, sl_next = SLOTB;
#define ROT() do { sl_prev = sl_cur; sl_cur = sl_next; sl_next = (sl_next == (NSLOT - 1) * SLOTB) ? 0 : sl_next + SLOTB; } while (0)
  if (MODE == 0) qkt(pA0, pA1, shm3 + LDS_K, qr, negm, r32, hi); else qkt(pA0, pA1, shm3 + LDS_K, qr, f32x16{}, r32, hi);
#define KXF(e) __builtin_bit_cast(bf16x8, (u32x4){(e)[0], (e)[1], kxc, 0u})
  if (MODE == 1) { const u32x2_t e0 = KX[kxi + kxs * tb], e1 = KX[kxi + kxs * tb + kxh];
    pA0 = __builtin_amdgcn_mfma_f32_32x32x16_bf16(KXF(e0), qx, pA0, 0, 0, 0); pA1 = __builtin_amdgcn_mfma_f32_32x32x16_bf16(KXF(e1), qx, pA1, 0, 0, 0);
    ec0 = KX[kxi + kxs * (tb + 1)]; ec1 = KX[kxi + kxs * (tb + 1) + kxh]; }
  MASKB(pA0, pA1, 0);
  DECIDE(pA0, pA1);
#pragma unroll
  for (int r = 0; r < 16; ++r) { pA0[r] = __builtin_amdgcn_exp2f(pA0[r]); pA1[r] = __builtin_amdgcn_exp2f(pA1[r]); }
  WAIT_BAR(0);
  DMA_K(3, 0); DMA_V(1, SLOTB);
  ROT();
  kload8(kf, kp0 + sl_cur);
  WAIT_BAR(2);
  s16x4 vlo[8], vhi[8]; u32x4 pw0, pw1, pw2, pw3;
#define PKW(P, B) cvtpk_s(P[B], P[B + 1])
#define PAF(k) __builtin_bit_cast(bf16x8, pw##k)
#define VFR(i) (bf16x8){vlo[i][0], vlo[i][1], vlo[i][2], vlo[i][3], vhi[i][0], vhi[i][1], vhi[i][2], vhi[i][3]}
#define PIN(x) asm volatile("" : "+v"(x))
#define GAPA(MF, A0, A1, A2, A3, W0, W1, PW) do { MF; sacc += A0; sacc += A1; sacc += A2; sacc += A3; PIN(sacc); W0; W1; PIN(PW); SBAR(); } while (0)
#define EX(v) __builtin_amdgcn_exp2f(v)
#define GAPB(MF, X, B) do { MF; X[B] = EX(X[B]); X[B + 1] = EX(X[B + 1]); X[B + 2] = EX(X[B + 2]); X[B + 3] = EX(X[B + 3]); PIN(X); SBAR(); } while (0)
#define VRD(i) do { vlo[i] = vtr(vp_ + (((i) >> 2) * 4096 + ((i) & 3) * 1024)); vhi[i] = vtr(vp_ + (((i) >> 2) * 4096 + ((i) & 3) * 1024 + 512)); } while (0)
#define KRD(G, j) do { if (G) { kload2(kf, kp0 + sl_next, j); SBAR(); } } while (0)
#define MF32(a, b, c) __builtin_amdgcn_mfma_f32_32x32x16_bf16(a, b, c, 0, 0, 0)
#define CIN (MODE == 0 ? negm : f32x16{})
#define STEP(C0, C1, P0, P1, t, GK, GV, GL) do { SBAR(); \
    const lds_cptr vp_ = vp0 + sl_prev; \
    VRD(0); SBAR(); float sacc = (P0[0] + P0[1]); \
    GAPA(C0 = MF32(kf[0], qr[0], CIN), P0[2], P0[3], P0[4], P0[5],     pw0[0] = PKW(P0, 0), pw0[1] = PKW(P0, 2), pw0); \
    VRD(4); SBAR(); GAPA(C1 = MF32(kf[1], qr[0], CIN), P0[6], P0[7], P0[8], P0[9],     pw0[2] = PKW(P0, 4), pw0[3] = PKW(P0, 6), pw0); \
    VRD(1); SBAR(); GAPA(C0 = MF32(kf[2], qr[1], C0),   P0[10], P0[11], P0[12], P0[13], pw1[0] = PKW(P0, 8), pw1[1] = PKW(P0, 10), pw1); \
    VRD(5); SBAR(); GAPA(C1 = MF32(kf[3], qr[1], C1),   P0[14], P0[15], P1[0], P1[1],   pw1[2] = PKW(P0, 12), pw1[3] = PKW(P0, 14), pw1); \
    VRD(2); SBAR(); GAPA(C0 = MF32(kf[4], qr[2], C0),   P1[2], P1[3], P1[4], P1[5],     pw2[0] = PKW(P1, 0), pw2[1] = PKW(P1, 2), pw2); \
    VRD(6); SBAR(); GAPA(C1 = MF32(kf[5], qr[2], C1),   P1[6], P1[7], P1[8], P1[9],     pw2[2] = PKW(P1, 4), pw2[3] = PKW(P1, 6), pw2); \
    VRD(3); SBAR(); GAPA(C0 = MF32(kf[6], qr[3], C0),   P1[10], P1[11], P1[12], P1[13], pw3[0] = PKW(P1, 8), pw3[1] = PKW(P1, 10), pw3); \
    VRD(7); SBAR(); GAPA(C1 = MF32(kf[7], qr[3], C1),   P1[14], P1[15], 0.f, 0.f,       pw3[2] = PKW(P1, 12), pw3[3] = PKW(P1, 14), pw3); \
    if (MODE == 1) { C0 = MF32(KXF(ec0), qx, C0); C1 = MF32(KXF(ec1), qx, C1); SBAR(); } \
    l_reg += sacc; \
    if (GK) { DMA_K((t) + 3, sl_cur); } if (GV) { DMA_V((t) + 1, sl_next); } \
    MASKB(C0, C1, t); \
    DECIDE(C0, C1); \
    SBAR(); \
    GAPB(o[0] = MF32(PAF(0), VFR(0), o[0]), C0, 0); \
    GAPB(o[1] = MF32(PAF(0), VFR(4), o[1]), C0, 4); \
    KRD(GL, 0); GAPB(o[0] = MF32(PAF(1), VFR(1), o[0]), C0, 8); \
    KRD(GL, 1); GAPB(o[1] = MF32(PAF(1), VFR(5), o[1]), C0, 12); \
    KRD(GL, 2); GAPB(o[0] = MF32(PAF(2), VFR(2), o[0]), C1, 0); \
    KRD(GL, 3); GAPB(o[1] = MF32(PAF(2), VFR(6), o[1]), C1, 4); \
    GAPB(o[0] = MF32(PAF(3), VFR(3), o[0]), C1, 8); \
    GAPB(o[1] = MF32(PAF(3), VFR(7), o[1]), C1, 12); \
    if (MODE == 1 && (GL)) { ec0 = KX[kxi + kxs * (tb + (t) + 1)]; ec1 = KX[kxi + kxs * (tb + (t) + 1) + kxh]; } \
    } while (0)
  int t = 1;
  if (MODE == 1) {
    for (; t + 5 < NT; t += 2) {
      STEP(pB0, pB1, pA0, pA1, t, true, true, true);     WAIT_BAR(2); RESC(); ROT();
      STEP(pA0, pA1, pB0, pB1, t + 1, true, true, true); WAIT_BAR(2); RESC(); ROT();
    }
  }
#define ENDW(tt) do { if ((tt) + 3 < NT) { WAIT_BAR(2); } else if ((tt) + 2 < NT) { WAIT_BAR(1); } else { WAIT_BAR(0); } } while (0)
  for (; t + 1 < NT; t += 2) {
    STEP(pB0, pB1, pA0, pA1, t, (t + 3 < NT), (t + 1 < NT), (t + 1 < NT));       ENDW(t);     RESC(); ROT();
    STEP(pA0, pA1, pB0, pB1, t + 1, (t + 4 < NT), (t + 2 < NT), (t + 2 < NT));   ENDW(t + 1); RESC(); ROT();
  }
  STEP(pB0, pB1, pA0, pA1, NT - 1, false, false, false); RESC();
  { float sacc = pB0[0] + pB0[1];
#pragma unroll
    for (int r = 2; r < 16; ++r) sacc += pB0[r];
#pragma unroll
    for (int r = 0; r < 16; ++r) sacc += pB1[r];
    l_reg += sacc;
    pw0 = (u32x4){PKW(pB0, 0), PKW(pB0, 2), PKW(pB0, 4), PKW(pB0, 6)}; pw1 = (u32x4){PKW(pB0, 8), PKW(pB0, 10), PKW(pB0, 12), PKW(pB0, 14)};
    pw2 = (u32x4){PKW(pB1, 0), PKW(pB1, 2), PKW(pB1, 4), PKW(pB1, 6)}; pw3 = (u32x4){PKW(pB1, 8), PKW(pB1, 10), PKW(pB1, 12), PKW(pB1, 14)};
    SBAR(); pv(o, vb0 + sl_cur, PAF(0), PAF(1), PAF(2), PAF(3)); }
  { auto rr = __builtin_amdgcn_permlane32_swap(__float_as_uint(l_reg), __float_as_uint(l_reg), false, false); l_reg = __uint_as_float(rr[0]) + __uint_as_float(rr[1]); }
  if (hi == 0) wsf[32 + r32] = l_reg;
  asm volatile("s_waitcnt lgkmcnt(0)" ::: "memory");
  float rli[16];
#pragma unroll
  for (int r = 0; r < 16; ++r) rli[r] = __builtin_amdgcn_rcpf(wsf[32 + crow(r, hi)]);
  bf16* Ow = O + (rowbase + q0 + wid * QBLK) * DM + h * D;
  { ALAS bf16* stg = (ALAS bf16*)(shm + LDS_OST) + wid * 2048;
#pragma unroll
    for (int r = 0; r < 16; ++r) { const int orow = crow(r, hi);
#pragma unroll
      for (int d0 = 0; d0 < 2; ++d0) stg[orow * 64 + d0 * 32 + r32] = (bf16)(cvtpk_s(o[d0][r] * rli[r], 0.f) & 0xffffu); }
    asm volatile("s_waitcnt lgkmcnt(0)" ::: "memory");
#pragma unroll
    for (int i = 0; i < 4; ++i) { const int row = i * 8 + (lane >> 3), ch = lane & 7; const u32x4 v = *(const ALAS u32x4*)(stg + row * 64 + ch * 8); *(u32x4*)(Ow + (long)row * DM + ch * 8) = v; } }
  asm volatile("s_waitcnt lgkmcnt(0)\n\ts_barrier" ::: "memory");
#undef DMA_K
#undef DMA_V
#undef MASKB
#undef DECIDE
#undef RESC
#undef ROT
#undef PKW
#undef PAF
#undef VFR
#undef PIN
#undef GAPA
#undef EX
#undef GAPB
#undef VRD
#undef KRD
#undef MF32
#undef CIN
#undef KXF
#undef STEP
#undef ENDW
}
}
#define GAS __attribute__((address_space(1)))
#define LAS __attribute__((address_space(3)))
typedef unsigned short bf16;
typedef unsigned v4u __attribute__((ext_vector_type(4)));
typedef float f32x4 __attribute__((ext_vector_type(4)));
typedef short bf16x8 __attribute__((ext_vector_type(8)));
typedef GAS unsigned gu32;
typedef GAS unsigned long long gu64;
#define RLX_AGENT __ATOMIC_RELAXED, __HIP_MEMORY_SCOPE_AGENT
#define LDS_WAIT() asm volatile("s_waitcnt lgkmcnt(0)" ::: "memory")
#define VM_WAIT() asm volatile("s_waitcnt vmcnt(0)" ::: "memory")
__device__ __forceinline__ unsigned long long rt() { return __builtin_amdgcn_s_memrealtime(); }
__device__ __forceinline__ unsigned f2bf(float f) { unsigned u = __builtin_bit_cast(unsigned, f); return (u + 0x7fffu + ((u >> 16) & 1u)) >> 16; }
__device__ __forceinline__ unsigned pk2(float lo, float hi) { return f2bf(lo) | (f2bf(hi) << 16); }

#define XB_TMO      128
#define XB_XCNT(j)  (256  + 64 * (j))
#define XB_XSUB(j)  (1280 + 64 * (j))
#define XB_XGEN(j)  (2304 + 64 * (j))
#define XB_TOP      3328
#define XB_TOPGEN   3392
#define XCD_BAR_WORDS 3456
#define XB_SPIN_CAP (1u << 18)

__device__ __forceinline__ unsigned xb_ld(unsigned* p)              { return __hip_atomic_load(p, __ATOMIC_RELAXED, __HIP_MEMORY_SCOPE_AGENT); }
__device__ __forceinline__ unsigned xb_add(unsigned* p, unsigned v) { return __hip_atomic_fetch_add(p, v, __ATOMIC_RELAXED, __HIP_MEMORY_SCOPE_AGENT); }
__device__ __forceinline__ unsigned xb_xcc_id() { return (unsigned)__builtin_amdgcn_s_getreg((3 << 11) | 20) & 0xFu; }
#define XB_SPIN(cond, bar) do { unsigned _sp = 0; while (cond) { __builtin_amdgcn_s_sleep(1); \
    if ((++_sp & 255u) == 0u) { if (xb_ld(&(bar)[XB_TMO])) break; if (_sp > XB_SPIN_CAP) { atomicAdd(&(bar)[XB_TMO], 1u); break; } } } } while (0)

struct XcdBarrier {
    unsigned* bar; unsigned x; unsigned G;
    volatile LAS unsigned* st;
};

__device__ __forceinline__ XcdBarrier xcd_barrier_post(unsigned* bar, volatile LAS unsigned* st, unsigned G) {
    XcdBarrier b; b.bar = bar; b.x = xb_xcc_id(); b.st = st; b.G = G;
    if (threadIdx.x == 0) (void)xb_add(&bar[XB_XCNT(b.x)], 1u);
    return b;
}
__device__ __forceinline__ void xcd_barrier_complete(unsigned* bar, unsigned x, unsigned& nloc, unsigned& nx, const unsigned G) {
    unsigned sum, cnt, mine, sp = 0u;
    for (;;) {
        sum = 0u; cnt = 0u; mine = 0u;
#pragma unroll
        for (unsigned j = 0; j < 16; ++j) { const unsigned c = xb_ld(&bar[XB_XCNT(j)]); sum += c; cnt += (c > 0u) ? 1u : 0u; mine = (j == x) ? c : mine; }
        if (sum == G) break;
        __builtin_amdgcn_s_sleep(1);
        if ((++sp & 255u) == 0u) { if (xb_ld(&bar[XB_TMO])) break; if (sp > XB_SPIN_CAP) { atomicAdd(&bar[XB_TMO], 1u); break; } }
    }
    nloc = mine > 0u ? mine : 1u; nx = cnt > 0u ? cnt : 1u;
}

__device__ __forceinline__ void xcd_barrier(const XcdBarrier& b) {
    asm volatile("s_waitcnt vmcnt(0)" ::: "memory");
    __syncthreads();
    if (threadIdx.x == 0) {
        unsigned* bar = b.bar; asm volatile("" : "+s"(bar));
        __builtin_amdgcn_s_waitcnt(0);
        unsigned nloc = b.st[0], nx = b.st[1];
        unsigned bx_ = b.x; asm volatile("" : "+s"(bx_));
        if (nloc == 0u) { xcd_barrier_complete(bar, bx_, nloc, nx, b.G); b.st[0] = nloc; b.st[1] = nx; }
        if (nx == 1u) asm volatile("buffer_inv sc1" ::: "memory");
        const unsigned old = xb_add(&bar[XB_XSUB(bx_)], 1u);
        const unsigned gen = old / nloc;
        if (nx == 1u) {
            const unsigned target = (gen + 1u) * nloc;
            if (old + 1u != target) XB_SPIN((int)(xb_ld(&bar[XB_XSUB(bx_)]) - target) < 0, bar);
            asm volatile("s_waitcnt vmcnt(0)" ::: "memory");
        } else
        if (old + 1u == (gen + 1u) * nloc) {
            if (nx > 1u) __builtin_amdgcn_fence(__ATOMIC_RELEASE, "agent");
            asm volatile("s_waitcnt vmcnt(0)" ::: "memory");
            const unsigned og = xb_add(&bar[XB_TOP], 1u);
            const unsigned tg = og / nx;
            if (og + 1u == (tg + 1u) * nx) xb_add(&bar[XB_TOPGEN], 1u);
            else XB_SPIN(xb_ld(&bar[XB_TOPGEN]) == tg, bar);
            __builtin_amdgcn_fence(__ATOMIC_ACQUIRE, "agent");
            xb_add(&bar[XB_XGEN(bx_)], 1u);
            asm volatile("s_waitcnt vmcnt(0)" ::: "memory");
        } else {
            XB_SPIN(xb_ld(&bar[XB_XGEN(bx_)]) == gen, bar);
            __builtin_amdgcn_fence(__ATOMIC_ACQUIRE, "agent");
            asm volatile("s_waitcnt vmcnt(0)" ::: "memory");
        }
    }
    __syncthreads();
}


constexpr int NWAVES = 8;
constexpr int BATCH = 8, T = 2048, D = 1024, H = 16, HD = 64, FF = 4096, DEPTH = 4;
constexpr int M = BATCH * T;
constexpr int QKV_A = 1536, QKVF_B = 3088, NQKV_B = 3072;
constexpr size_t MiB = 1u << 20;
constexpr size_t WS_CTL = 0, CTL_ZERO_BYTES = 160 * 1024;
constexpr size_t WS_SSQ = 1 * MiB;
constexpr size_t WS_CT = 1 * MiB + 512 * 1024;
constexpr size_t WS_CL = 2 * MiB;
constexpr size_t WS_WF = 3 * MiB;
constexpr size_t WS_W = 4 * MiB;
constexpr size_t WS_XB = 94 * MiB;
constexpr size_t WS_BLK = 128 * MiB, BLK_BYTES = 16 * MiB;
constexpr size_t BLK_K = 4 * MiB, BLK_V = 8 * MiB, BLK_SPARE = 12 * MiB;
constexpr size_t WS_END = 256 * MiB;
__host__ __device__ constexpr size_t layer_w_base(int l) { return WS_W + (size_t)(l == 0 ? 0 : l == 1 ? 21 : l == 2 ? 45 : 66) * MiB; }
__host__ __device__ constexpr size_t layer_qkv_bytes(int l) { return (size_t)((l & 1) ? 6 : 3) * MiB; }
static_assert(layer_w_base(3) + 24 * MiB == WS_XB && WS_XB + 32 * MiB <= WS_BLK && WS_BLK + 8 * BLK_BYTES == WS_END, "ws map");
constexpr int CW_BAR = 4096;
static_assert((size_t)(CW_BAR + 9 * 3456) * 4 <= CTL_ZERO_BYTES && CTL_ZERO_BYTES <= WS_SSQ, "control words inside the per-call memset");
constexpr int RING_OFF = 0, RING_BYTES = 131072;
constexpr int LDSCTL_OFF = RING_BYTES, MISC_OFF = LDSCTL_OFF + 320;
constexpr int LDS_BYTES = 147456;
static_assert(att::LDS_BYTES <= RING_BYTES, "attention scratch inside the ring region");

__device__ __forceinline__ float wave_sum(float v) {
#pragma unroll
    for (int o = 1; o < 64; o <<= 1) v += __shfl_xor(v, o);
    return v;
}
struct TItem { const float* W; const float* gain; bf16* WT; int K, ldw, k0, n0; };
template <bool NT = false> __device__ __forceinline__ void p0_item_load(const TItem& it, f32x4 (&v)[8], float (&g)[8], int lane) {
    const int kq = lane >> 3, c4 = (lane & 7) * 4;
#pragma unroll
    for (int i = 0; i < 8; ++i) { const int kk = i * 8 + kq; v[i] = NT ? __builtin_nontemporal_load((const GAS f32x4*)(it.W + (size_t)(it.k0 + kk) * it.ldw + it.n0 + c4)) : *(const GAS f32x4*)(it.W + (size_t)(it.k0 + kk) * it.ldw + it.n0 + c4); g[i] = it.gain ? it.gain[it.k0 + kk] : 1.0f; }
}
template <bool NT = false> __device__ __forceinline__ void p0_item_store(const TItem& it, const f32x4 (&v)[8], const float (&g)[8], LAS float* scr, int lane) {
    const int kq = lane >> 3, c4 = (lane & 7) * 4;
#pragma unroll
    for (int i = 0; i < 8; ++i) { LAS float* d = scr + (i * 8 + kq) * 33 + c4; d[0] = v[i].x * g[i]; d[1] = v[i].y * g[i]; d[2] = v[i].z * g[i]; d[3] = v[i].w * g[i]; }
    LDS_WAIT(); asm volatile("" ::: "memory");
    const int c = lane & 7;
#pragma unroll
    for (int j = 0; j < 4; ++j) { const int n = (lane >> 3) + 8 * j; const LAS float* s = scr + (8 * c) * 33 + n;
        v4u o; o.x = pk2(s[0 * 33], s[1 * 33]); o.y = pk2(s[2 * 33], s[3 * 33]); o.z = pk2(s[4 * 33], s[5 * 33]); o.w = pk2(s[6 * 33], s[7 * 33]);
        if (NT) __builtin_nontemporal_store(o, (GAS v4u*)(it.WT + (size_t)(it.n0 + n) * it.K + it.k0 + 8 * c)); else *(GAS v4u*)(it.WT + (size_t)(it.n0 + n) * it.K + it.k0 + 8 * c) = o; }
    LDS_WAIT(); asm volatile("" ::: "memory");
}

struct Args { const float* in[15]; float* out; unsigned char* ws; };

#define ARGIN(k) ([&]() -> const float* { int k_ = (k); asm volatile("" : "+s"(k_)); return args.in[k_]; }())
enum { A_X = 0, A_RELB = 1, A_NMIX = 2, A_NMLP = 3, A_WQKVA = 4, A_BQKVA = 5, A_SINKS = 6, A_WOA = 7, A_BOA = 8, A_WQKVFB = 9, A_BFB = 10, A_WOB = 11, A_WUP = 12, A_WDOWN = 13, A_NFIN = 14 };
static_assert(pg8::EP_SSQ == WS_SSQ && pg8::EP_XB == WS_XB && pg8::EP_BLK == WS_BLK && pg8::EP_BLKB == BLK_BYTES && pg8::EP_KOFF == BLK_K && pg8::EP_VOFF == BLK_V, "epilogue workspace offsets");
__global__ void __launch_bounds__(NWAVES * 64, 2) mk_fwd(Args args) {
    extern __shared__ __attribute__((aligned(16))) unsigned char lds[];
    LAS unsigned char* const L = (LAS unsigned char*)lds;
    const int tid = threadIdx.x, lane = tid & 63, wave = __builtin_amdgcn_readfirstlane(tid >> 6);
    const int G = gridDim.x; const int bx = blockIdx.x; const int vcu = (G % 8 == 0) ? (bx % 8) * (G / 8) + bx / 8 : bx;
    unsigned char* const ws = args.ws;
    for (int u = tid; u < (LDS_BYTES - LDSCTL_OFF) / 4; u += NWAVES * 64) ((LAS unsigned*)(L + LDSCTL_OFF))[u] = 0u;
    __syncthreads();
    XcdBarrier bar = xcd_barrier_post((unsigned*)((gu32*)(ws + WS_CTL) + CW_BAR), (volatile LAS unsigned*)(L + MISC_OFF) + 8, (unsigned)G);
    XcdBarrier gbar = xcd_barrier_post((unsigned*)((gu32*)(ws + WS_CTL) + CW_BAR) + (1 + (vcu >> 5)) * XCD_BAR_WORDS, (volatile LAS unsigned*)(L + MISC_OFF) + 10, 32u);
#define GROUP_BAR() do { xcd_barrier(gbar); if (DBL == 4) xcd_barrier(gbar); } while (0)
#ifndef DBL
#define DBL (-1)
#endif
#define GRID_BAR() do { xcd_barrier(bar); if (DBL == 4) xcd_barrier(bar); } while (0)
    const int gw = vcu * NWAVES + wave, NGW = G * NWAVES;

    constexpr int I_QA = (D / 64) * (QKV_A / 32), I_QB = (D / 64) * (NQKV_B / 32), I_O = (D / 64) * (D / 32), I_U = (D / 64) * (FF / 32), I_D = (FF / 64) * (D / 32);
    constexpr int I_LA = I_QA + I_O + I_U + I_D, I_LB = I_QB + I_O + I_U + I_D, NITEMS = 2 * (I_LA + I_LB);
    constexpr int CW_CONV = 1024;
    for (int rep_ = 0; rep_ < (DBL == 0 ? 2 : 1); ++rep_) {
        LAS float* scr = (LAS float*)(L + RING_OFF + wave * 16384);
#define P0_DECODE(it_, T_) do { int r = (it_), l = 0; \
            for (; l < DEPTH; ++l) { const int n_ = (l & 1) ? I_LB : I_LA; if (r < n_) break; r -= n_; } \
            const int j = l >> 1; const bool isb = (l & 1) != 0; unsigned char* wb = ws + layer_w_base(l); const int iq = isb ? I_QB : I_QA; int N_; \
            if (r < iq) { if (isb) { T_.W = ARGIN(A_WQKVFB) + (size_t)j * D * QKVF_B; N_ = NQKV_B; T_.ldw = QKVF_B; } else { T_.W = ARGIN(A_WQKVA) + (size_t)j * D * QKV_A; N_ = QKV_A; T_.ldw = QKV_A; } T_.gain = ARGIN(A_NMIX) + l * D; T_.K = D; } \
            else { r -= iq; wb += layer_qkv_bytes(l); \
              if (r < I_O) { T_.W = ARGIN(isb ? A_WOB : A_WOA) + (size_t)j * D * D; N_ = D; T_.ldw = D; T_.gain = nullptr; T_.K = D; } \
              else { r -= I_O; wb += 2 * MiB; \
                if (r < I_U) { T_.W = ARGIN(A_WUP) + (size_t)l * D * FF; N_ = FF; T_.ldw = FF; T_.gain = ARGIN(A_NMLP) + l * D; T_.K = D; } \
                else { r -= I_U; wb += 8 * MiB; T_.W = ARGIN(A_WDOWN) + (size_t)l * FF * D; N_ = D; T_.ldw = D; T_.gain = nullptr; T_.K = FF; } } } \
            T_.WT = (bf16*)wb; const int nblk_ = N_ / 32; T_.k0 = 64 * (r / nblk_); T_.n0 = 32 * (r % nblk_); } while (0)
#define P0_RUN(IT0_, IT1_, GW_, NGW_) do { f32x4 va[8], vb[8]; float ga[8], gb[8]; TItem ta, tb; const int it1_ = (IT1_), ngw_ = (NGW_); \
            int it = (IT0_) + (GW_); \
            if (it < it1_) { P0_DECODE(it, ta); p0_item_load<true>(ta, va, ga, lane); } \
            for (; it < it1_; it += 2 * ngw_) { \
                const bool hb = it + ngw_ < it1_; \
                if (hb) { P0_DECODE(it + ngw_, tb); p0_item_load<true>(tb, vb, gb, lane); } \
                p0_item_store(ta, va, ga, scr, lane); \
                const bool ha = it + 2 * ngw_ < it1_; \
                if (ha) { P0_DECODE(it + 2 * ngw_, ta); p0_item_load<true>(ta, va, ga, lane); } \
                if (hb) p0_item_store(tb, vb, gb, scr, lane); } } while (0)
#define P0_RUN1(IT0_, IT1_, GW_, NGW_) do { f32x4 va[8]; float ga[8]; TItem ta; const int it1_ = (IT1_), ngw_ = (NGW_); \
            for (int it = (IT0_) + (GW_); it < it1_; it += ngw_) { P0_DECODE(it, ta); p0_item_load<true>(ta, va, ga, lane); p0_item_store<false>(ta, va, ga, scr, lane); } } while (0)
        P0_RUN(0, I_QA, gw, NGW);
        { const float* nm = ARGIN(A_NMIX); const float* wq = ARGIN(A_WQKVFB); bf16* WF = (bf16*)(ws + WS_WF);
          for (int e = gw * 64 + lane; e < 2 * 16 * D; e += NGW * 64) { const int j = e / (16 * D), hh = (e / D) % 16, k = e % D;
            WF[e] = (bf16)f2bf(nm[(2 * j + 1) * D + k] * wq[(size_t)j * D * QKVF_B + (size_t)k * QKVF_B + NQKV_B + hh]); } }
        { const float* x_in = ARGIN(A_X); bf16* XB = (bf16*)(ws + WS_XB); float* SSQ = (float*)(ws + WS_SSQ) + (size_t)4 * M;
          for (int m = gw; m < M; m += NGW) {
            const GAS f32x4* xr = (const GAS f32x4*)(x_in + (size_t)m * D) + lane; GAS unsigned long long* o8 = (GAS unsigned long long*)(XB + (size_t)m * D) + lane;
            float s = 0.f;
#pragma unroll
            for (int jj = 0; jj < 4; ++jj) { const f32x4 v = __builtin_nontemporal_load(xr + 64 * jj); s += (v.x * v.x + v.y * v.y) + (v.z * v.z + v.w * v.w);
                o8[64 * jj] = (unsigned long long)pk2(v.x, v.y) | ((unsigned long long)pk2(v.z, v.w) << 32); }
            s = wave_sum(s);
            if (lane == 0) *(f32x4*)(SSQ + 4 * (size_t)m) = (f32x4){s, 0.f, 0.f, 0.f};
          } }
    }
    GRID_BAR();

#ifdef STAGGER_TICKS
    { const unsigned long long t0_ = __builtin_amdgcn_s_memrealtime(), dl_ = (unsigned long long)(vcu >> 5) * STAGGER_TICKS;
      while (__builtin_amdgcn_s_memrealtime() - t0_ < dl_) __builtin_amdgcn_s_sleep(8); }
#endif
    for (int l = 0; l < DEPTH; ++l) {
        for (int half = 0; half < 2; ++half) {
            const int j = l >> 1; const bool isb = (l & 1) != 0;
            unsigned char* ws = args.ws; asm volatile("" : "+s"(ws));
#define CONV_POLL(k_) do { if (threadIdx.x == 0) { unsigned* cv = (unsigned*)((gu32*)(ws + WS_CTL) + CW_CONV + 64 * (k_)); unsigned* tb_ = (unsigned*)((gu32*)(ws + WS_CTL) + CW_BAR); \
                    XB_SPIN(xb_ld(cv) < 128u, tb_); } } while (0)
            {
                const int N = half ? FF : (isb ? NQKV_B : QKV_A);
                const bf16* Wl = (const bf16*)(ws + layer_w_base(l) + (half ? layer_qkv_bytes(l) + 2 * MiB : 0));
                pg8::Gemm g{(const bf16*)(ws + WS_XB), Wl, M, N, D, (size_t)T * D * 2}; pg8::StaticOrder S; S.init(M, N, G, bx);
                pg8::EpiProj E; E.ws = ws; E.bias = (!half && !isb) ? ARGIN(A_BQKVA) + j * QKV_A : nullptr; E.mode = half ? 2 : (isb ? 1 : 0);
#ifndef NO_G1
                for (int rep_ = 0; rep_ < (DBL == 1 ? 2 : 1); ++rep_)
                pg8::gemm_phase<pg8::EpiProj, pg8::StaticOrder, true, true>(L + RING_OFF, g, S, E);
#endif
            }
            if (!half && !isb && bx >= 128) {
                int tq = threadIdx.x; asm volatile("" : "+v"(tq)); const int lane = tq & 63, wave = __builtin_amdgcn_readfirstlane(tq >> 6);
                LAS float* scr = (LAS float*)(L + RING_OFF + wave * 16384);
                const int it0 = l == 0 ? I_QA : I_LA + I_LB + I_QA, it1 = l == 0 ? I_LA + I_LB + I_QA : NITEMS;
                for (int rep_ = 0; rep_ < (DBL == 9 ? 2 : 1); ++rep_)
                P0_RUN1(it0, it1, (bx - 128) * NWAVES + wave, 128 * NWAVES);
                asm volatile("s_waitcnt vmcnt(0)" ::: "memory"); __syncthreads();
                if (threadIdx.x == 0) { __builtin_amdgcn_fence(__ATOMIC_RELEASE, "agent"); asm volatile("s_waitcnt vmcnt(0)" ::: "memory");
                    xb_add((unsigned*)((gu32*)(ws + WS_CTL) + CW_CONV + 64 * (l >> 1)), 1u); }
            }
            if (!half) {
                if (isb) {
                    int tid = threadIdx.x; asm volatile("" : "+v"(tid)); const int lane = tid & 63;
                    const int R0 = 64 * vcu; const int fr = lane & 15, fq = lane >> 4;
                    for (int rep_ = 0; rep_ < (DBL == 6 ? 2 : 1); ++rep_) if (R0 < M) { if (rep_) { LDS_WAIT(); __builtin_amdgcn_s_barrier(); }
                    const bf16* XB = (const bf16*)(ws + WS_XB); const bf16* WF = (const bf16*)(ws + WS_WF); const float* SSQ = (const float*)(ws + WS_SSQ) + (size_t)4 * M;
                    float* CT = (float*)(ws + WS_CT); float* CL = (float*)(ws + WS_CL); const float* bfb = ARGIN(A_BFB) + j * 16;
                    pg8::f32x4 fa[4];
#pragma unroll
                    for (int gI = 0; gI < 4; ++gI) fa[gI] = (pg8::f32x4){0.f, 0.f, 0.f, 0.f};
                    const bf16* wf = WF + (size_t)j * 16 * D + (size_t)fr * D + 128 * wave + 8 * fq;
                    const bf16* xa = XB + (size_t)(R0 + fr) * D + 128 * wave + 8 * fq;
#pragma unroll
                    for (int ks = 0; ks < 4; ++ks) { const bf16x8 bfr = *(const bf16x8*)(wf + 32 * ks);
#pragma unroll
                        for (int gI = 0; gI < 4; ++gI) { const bf16x8 afr = *(const bf16x8*)(xa + (size_t)(16 * gI) * D + 32 * ks); fa[gI] = __builtin_amdgcn_mfma_f32_16x16x32_bf16(afr, bfr, fa[gI], 0, 0, 0); } }
                    LAS float* part = (LAS float*)(L + RING_OFF);
                    LAS float* lf = (LAS float*)(L + RING_OFF + 32768);
#pragma unroll
                    for (int gI = 0; gI < 4; ++gI)
#pragma unroll
                        for (int e = 0; e < 4; ++e) part[(wave * 64 + 16 * gI + 4 * fq + e) * 16 + fr] = fa[gI][e];
                    LDS_WAIT(); __builtin_amdgcn_s_barrier(); asm volatile("" ::: "memory");
                    for (int e = tid; e < 1024; e += NWAVES * 64) { const int row = e >> 4, hh = e & 15; float s = 0.f;
#pragma unroll
                        for (int w = 0; w < 8; ++w) s += part[(w * 64 + row) * 16 + hh];
                        const float z = s * pg8::row_rstd(SSQ, R0 + row) + bfb[hh];
                        lf[hh * 64 + row] = (fminf(z, 0.f) - log1pf(__expf(-fabsf(z)))) * att::LOG2E; }
                    LDS_WAIT(); __builtin_amdgcn_s_barrier(); asm volatile("" ::: "memory");
                    const int bb = R0 / T, t0 = R0 % T;
#pragma unroll
                    for (int q = 0; q < 2; ++q) { const int hh = 2 * wave + q; const float v = lf[hh * 64 + lane]; float inc = v;
#pragma unroll
                        for (int s = 1; s < 64; s <<= 1) { const float uu = __shfl_up(inc, s); if (lane >= s) inc += uu; }
                        CL[(size_t)(bb * 16 + hh) * T + t0 + lane] = inc;
                        if (lane == 63) CT[(size_t)(bb * 16 + hh) * 32 + (t0 >> 6)] = inc; }
                    }
                }
                GROUP_BAR();
                {
                    att::AttnAux ax; ax.rel_bias = ARGIN(A_RELB); ax.sinks = ARGIN(A_SINKS) + j * 16; ax.CL = (const float*)(ws + WS_CL); ax.CT = (const float*)(ws + WS_CT);
                    const int bh = vcu >> 1; unsigned char* const blk = ws + WS_BLK + (size_t)(bh >> 4) * BLK_BYTES;
                    bf16* const QB_ = (bf16*)blk; const bf16* const KB_ = (const bf16*)(blk + BLK_K); const bf16* const VB_ = (const bf16*)(blk + BLK_V);
                    const int nrep_ = (DBL == 2 || (DBL == 7 && !isb) || (DBL == 8 && isb)) ? 2 : 1;
                    for (int rep_ = 0; rep_ < nrep_; ++rep_) { bf16* const OB_ = (rep_ + 1 < nrep_) ? (bf16*)(blk + BLK_SPARE) : QB_;
                    if (!isb) {
#ifndef NO_SWA
                        att::attn_swa_sweep(bh & 15, vcu & 1, QB_, KB_, VB_, OB_, (LAS char*)(L + RING_OFF), ax);
#endif
                    } else
                    for (int i = 0; i < 4; ++i) {
                        if (isb) { const int s = vcu & 1; const int qb = s == 0 ? (i == 0 ? 7 : i == 1 ? 0 : i == 2 ? 5 : 2) : (i == 0 ? 6 : i == 1 ? 1 : i == 2 ? 4 : 3);

#ifndef NO_FOX
                            att::attn_unit_v2<1, 24>(bh >> 4, bh & 15, qb, QB_, KB_, VB_, OB_, (LAS char*)(L + RING_OFF), ax, i == 0);
#endif
                        }
                        else {
#ifndef NO_SWA
                            att::attn_unit_v1<0>(bh >> 4, bh & 15, (vcu & 1) * 4 + i, QB_, KB_, VB_, OB_, (LAS char*)(L + RING_OFF), ax);
#endif
                        }
                    } }
                }
                if (!isb) CONV_POLL(l >> 1);
                GROUP_BAR();
            } else GROUP_BAR();
            {
                const bf16* Wl = (const bf16*)(ws + layer_w_base(l) + layer_qkv_bytes(l) + (half ? 10 * MiB : 0));
                pg8::Gemm g{(const bf16*)(ws + WS_BLK), Wl, M, D, half ? FF : D, BLK_BYTES}; pg8::StaticOrder S; S.init(M, D, G, bx);
                const bool fin = half && l == DEPTH - 1;
                pg8::EpiRes E; E.ws = ws; E.bias = (!half && !isb) ? ARGIN(A_BOA) + j * D : nullptr; E.sq = half; E.fout = fin ? args.out : nullptr; E.fgain = ARGIN(A_NFIN); E.fbar = &gbar;
#ifndef NO_G2
                pg8::gemm_phase<pg8::EpiRes, pg8::StaticOrder, false, true>(L + RING_OFF, g, S, E);
#endif
            }
            if (half && l + 1 < DEPTH) CONV_POLL(l + 1 == 3 ? 1 : 0);
            if (!(half && l == DEPTH - 1)) GROUP_BAR();
        }
    }
#undef P0_RUN
#undef P0_RUN1
#undef P0_DECODE
#undef CONV_POLL
}

extern "C" void kernel_launch(void* const* d_in, const int* in_sizes, int n_in, void* d_out, int out_size, void* d_ws, size_t ws_size, hipStream_t stream) {
    static int grid = 0;
    if (grid == 0) {
        if (n_in != 15 || in_sizes[0] != M * D || out_size != M * D || ws_size < WS_END) { fprintf(stderr, "kernel_launch: unexpected shapes / workspace (n_in %d, in0 %d, out %d, ws %zu); nothing launched\n", n_in, n_in > 0 ? in_sizes[0] : -1, out_size, ws_size); grid = -1; return; }
        int dev = 0, cus = 0, per_cu = 0;
        if (hipGetDevice(&dev) != hipSuccess || hipDeviceGetAttribute(&cus, hipDeviceAttributeMultiprocessorCount, dev) != hipSuccess) { grid = -1; return; }
        if (hipFuncSetAttribute((const void*)mk_fwd, hipFuncAttributeMaxDynamicSharedMemorySize, LDS_BYTES) != hipSuccess) { fprintf(stderr, "kernel_launch: hipFuncSetAttribute failed\n"); grid = -1; return; }
        if (hipOccupancyMaxActiveBlocksPerMultiprocessor(&per_cu, (const void*)mk_fwd, NWAVES * 64, LDS_BYTES) != hipSuccess || per_cu < 1) { fprintf(stderr, "kernel_launch: occupancy query says %d blocks per CU\n", per_cu); }
        (void)hipGetLastError();
        grid = cus;
        if (grid != 256) { fprintf(stderr, "kernel_launch: built for a 256-CU device, found %d CUs; nothing launched\n", cus); grid = -1; return; }
    }
    if (grid < 0) return;
    if (hipMemsetAsync((char*)d_ws + WS_CTL, 0, CTL_ZERO_BYTES, stream) != hipSuccess) return;
    Args a{};
    for (int i = 0; i < 15; ++i) a.in[i] = (const float*)d_in[i];
    a.out = (float*)d_out; a.ws = (unsigned char*)d_ws;
    hipLaunchKernelGGL(mk_fwd, dim3(grid), dim3(NWAVES * 64), LDS_BYTES, stream, a);
}
```

```cpp
#include <hip/hip_runtime.h>
#include <cstdio>
#include <cstdint>
struct XcdBarrier; __device__ __forceinline__ void xcd_barrier(const XcdBarrier& b);
namespace pg8 {
#define PG8_LAS __attribute__((address_space(3)))
typedef unsigned short bf16_t;
typedef short bf16x8 __attribute__((ext_vector_type(8)));
typedef float f32x4 __attribute__((ext_vector_type(4)));
typedef unsigned u32x4 __attribute__((ext_vector_type(4)));
constexpr int BM = 256, BK = 64, HALF = 128, HTB = HALF * BK * 2  , STAGE_BYTES = 8 * HTB, NXCD = 8, WGM = 8;

__host__ __device__ __forceinline__ int lds_byte(int r, int c) { const int st = (r >> 4) * 2 + (c >> 5), rr = r & 15, cc = c & 31, ob = rr * 64 + cc * 2; return st * 1024 + (ob ^ (((ob >> 9) & 1) << 5)); }
__host__ __device__ __forceinline__ void stage_rc(int b, int& R, int& C) { const int st = b / 1024, sb = b % 1024, swz = sb ^ (((sb >> 9) & 1) << 5); R = (st >> 1) * 16 + swz / 64; C = (st & 1) * 32 + (swz % 64) / 2; }
__host__ __device__ __forceinline__ int perm32(int rho) { const int n = rho >> 4, i = rho & 15; return 8 * (i >> 2) + 4 * n + (i & 3); }

struct Unit { int pm, pn; };
struct Gemm { const bf16_t* A; const bf16_t* Bt; int M, N, K; size_t a_bstride; };

struct StaticOrder {
    int nM, nN, nwg, G, c;
    __host__ __device__ void init(int M, int N, int G_, int c_) { nM = M / BM; nN = N / BM; nwg = nM * nN; G = G_; c = c_; }
    __host__ __device__ bool next(int i, Unit& u) const {
        const long L = (long)i * G + c; if (L >= nwg) return false;
        int wgid = (int)L; { const int q = nwg / NXCD, r = nwg % NXCD, xcd = wgid % NXCD, off = wgid / NXCD; wgid = (xcd < r ? xcd * (q + 1) : r * (q + 1) + (xcd - r) * q) + off; }
        const int nig = WGM * nN, gid = wgid / nig, fm = gid * WGM, gsz = (nM - fm) < WGM ? (nM - fm) : WGM;
        u.pm = fm + ((wgid % nig) % gsz); u.pn = (wgid % nig) / gsz; return true;
    }
    __device__ __forceinline__ void a_ready(const Unit&) const {}
    __device__ __forceinline__ void done(const Unit&) const {}
};

constexpr float RMS_EPS = 1e-6f;
constexpr size_t EP_SSQ = (size_t)1 << 20, EP_XB = (size_t)94 << 20, EP_BLK = (size_t)128 << 20, EP_BLKB = (size_t)16 << 20, EP_KOFF = (size_t)4 << 20, EP_VOFF = (size_t)8 << 20;
constexpr float EP_C2 = 0.125f * 1.4426950408889634f;
typedef unsigned u32x2 __attribute__((ext_vector_type(2)));
__device__ __forceinline__ unsigned cvt_pk_bf16(float lo, float hi) { unsigned r; asm volatile("v_cvt_pk_bf16_f32 %0, %1, %2" : "=v"(r) : "v"(lo), "v"(hi)); return r; }
__device__ __forceinline__ float row_rstd(const float* ssq, int row) { const f32x4 s = *(const f32x4*)(ssq + 4 * (size_t)row); return 1.0f / sqrtf(((s[0] + s[1]) + (s[2] + s[3])) * (1.0f / 1024.0f) + RMS_EPS); }

struct EpiProj {
    static constexpr bool PERM = true, AFTER_DRAIN = false;
    unsigned char* ws; const float* bias; int mode;
    __device__ __forceinline__ void operator()(const f32x4 (&acc)[2][2][4][2], const Unit& u, int wr, int wc, int fr, int fq) const {
        const int row0 = u.pm * BM + wr * 64 + fr, lrow0 = (u.pm & 7) * BM + wr * 64 + fr;
        unsigned char* blk = ws + EP_BLK + (size_t)(u.pm >> 3) * EP_BLKB;
        const float* ssq = (const float*)(ws + EP_SSQ) + (mode == 2 ? (size_t)0 : (size_t)4 * 16384); bf16_t* Q = (bf16_t*)blk; bf16_t* Kp = (bf16_t*)(blk + EP_KOFF); bf16_t* Vp = (bf16_t*)(blk + EP_VOFF);
        const int nq = mode == 2 ? 16 : 4, nk = mode == 0 ? 1 : 4, ldq = mode == 2 ? 4096 : 1024, ldk = mode == 0 ? 256 : 1024, act = mode == 2 ? 1 : 0; const float scale0 = mode == 2 ? 1.0f : EP_C2;
        bf16_t* base; int ld, ct; float sc = 1.f;
        if (u.pn < nq) { base = Q; ld = ldq; ct = u.pn; sc = scale0; } else if (u.pn < nq + nk) { base = Kp; ld = ldk; ct = u.pn - nq; } else { base = Vp; ld = ldk; ct = u.pn - nq - nk; }
        const int col0 = ct * BM + wc * 64 + 8 * fq, bcol0 = u.pn * BM + wc * 64 + 8 * fq;
        f32x4 bv[2][2];
#pragma unroll
        for (int bj = 0; bj < 2; ++bj)
#pragma unroll
            for (int n = 0; n < 2; ++n) bv[bj][n] = bias ? *(const f32x4*)(bias + bcol0 + bj * 32 + 4 * n) : (f32x4){0.f, 0.f, 0.f, 0.f};
        float rs[2][4];
#pragma unroll
        for (int ai = 0; ai < 2; ++ai) {
#pragma unroll
            for (int m = 0; m < 4; ++m) rs[ai][m] = row_rstd(ssq, row0 + ai * HALF + m * 16);
            asm volatile("" ::: "memory"); }
#pragma unroll
        for (int ai = 0; ai < 2; ++ai)
#pragma unroll
            for (int m = 0; m < 4; ++m) { bf16_t* rowp = base + (size_t)(lrow0 + ai * HALF + m * 16) * ld + col0; const float r = rs[ai][m];
#pragma unroll
                for (int bj = 0; bj < 2; ++bj) { f32x4 v0 = acc[ai][bj][m][0] * r + bv[bj][0], v1 = acc[ai][bj][m][1] * r + bv[bj][1];
                    if (act == 1) {
#pragma unroll
                        for (int e = 0; e < 4; ++e) { const float a = fmaxf(v0[e], 0.f), b = fmaxf(v1[e], 0.f); v0[e] = a * a; v1[e] = b * b; } }
                    v0 = v0 * sc; v1 = v1 * sc; u32x4 w; w.x = cvt_pk_bf16(v0[0], v0[1]); w.y = cvt_pk_bf16(v0[2], v0[3]); w.z = cvt_pk_bf16(v1[0], v1[1]); w.w = cvt_pk_bf16(v1[2], v1[3]);
                    *(u32x4*)(rowp + bj * 32) = w; } }
    }
};

struct EpiRes {
    static constexpr bool PERM = true, AFTER_DRAIN = true;
    unsigned char* ws; const float* bias; int sq;
    float* fout; const float* fgain; const XcdBarrier* fbar;
    __device__ __forceinline__ void fused(f32x4 (&acc)[2][2][4][2], const Unit& u, int wr, int wc, int fr, int fq, PG8_LAS unsigned char* lds, int wid, int lane) const {
        bf16_t* xb = (bf16_t*)(ws + EP_XB); float* ssq = (float*)(ws + EP_SSQ) + (sq ? (size_t)4 * 16384 : 0);
        PG8_LAS float* P = (PG8_LAS float*)lds;
        const int col0 = u.pn * BM + wc * 64 + 8 * fq;
        f32x4 bv[2][2];
#pragma unroll
        for (int bj = 0; bj < 2; ++bj)
#pragma unroll
            for (int n = 0; n < 2; ++n) bv[bj][n] = bias ? *(const f32x4*)(bias + col0 + bj * 32 + 4 * n) : (f32x4){0.f, 0.f, 0.f, 0.f};
#pragma unroll
        for (int ai = 0; ai < 2; ++ai)
#pragma unroll
            for (int m = 0; m < 4; ++m) { const int r = ai * HALF + wr * 64 + m * 16 + fr; const size_t off = (size_t)(u.pm * BM + r) * 1024 + col0; float s = 0.f;
#pragma unroll
                for (int bj = 0; bj < 2; ++bj) { const u32x4 b = *(const u32x4*)(xb + off + bj * 32);
                    f32x4 o0 = acc[ai][bj][m][0] + bv[bj][0], o1 = acc[ai][bj][m][1] + bv[bj][1];
                    o0[0] += __uint_as_float(b.x << 16); o0[1] += __uint_as_float(b.x & 0xffff0000u); o0[2] += __uint_as_float(b.y << 16); o0[3] += __uint_as_float(b.y & 0xffff0000u);
                    o1[0] += __uint_as_float(b.z << 16); o1[1] += __uint_as_float(b.z & 0xffff0000u); o1[2] += __uint_as_float(b.w << 16); o1[3] += __uint_as_float(b.w & 0xffff0000u);
                    u32x4 w; w.x = cvt_pk_bf16(o0[0], o0[1]); w.y = cvt_pk_bf16(o0[2], o0[3]); w.z = cvt_pk_bf16(o1[0], o1[1]); w.w = cvt_pk_bf16(o1[2], o1[3]);
                    if (fout) { acc[ai][bj][m][0] = o0; acc[ai][bj][m][1] = o1; } else *(u32x4*)(xb + off + bj * 32) = w;
                    s += ((o0[0] * o0[0] + o0[1] * o0[1]) + (o0[2] * o0[2] + o0[3] * o0[3])) + ((o1[0] * o1[0] + o1[1] * o1[1]) + (o1[2] * o1[2] + o1[3] * o1[3])); }
                s += __shfl_xor(s, 16); s += __shfl_xor(s, 32);
                if (fq == 0) P[r * 4 + wc] = s;
                if (m == 3) asm volatile("" ::: "memory"); }
        asm volatile("s_waitcnt lgkmcnt(0)" ::: "memory"); __builtin_amdgcn_s_barrier(); asm volatile("" ::: "memory");
        const int tid = wid * 64 + lane;
        if (tid < 256) { const f32x4 p = *(const PG8_LAS f32x4*)(P + tid * 4); ssq[(size_t)(u.pm * BM + tid) * 4 + u.pn] = (p[0] + p[1]) + (p[2] + p[3]); }
        if (fout) {
            xcd_barrier(*fbar);
            f32x4 gv[2][2];
#pragma unroll
            for (int bj = 0; bj < 2; ++bj)
#pragma unroll
                for (int n = 0; n < 2; ++n) gv[bj][n] = *(const f32x4*)(fgain + col0 + bj * 32 + 4 * n);
#pragma unroll
            for (int ai = 0; ai < 2; ++ai)
#pragma unroll
                for (int m = 0; m < 4; ++m) { const int row = u.pm * BM + ai * HALF + wr * 64 + m * 16 + fr; const float rs = row_rstd(ssq, row); float* orow = fout + (size_t)row * 1024 + col0;
#pragma unroll
                    for (int bj = 0; bj < 2; ++bj)
#pragma unroll
                        for (int n = 0; n < 2; ++n) *(f32x4*)(orow + bj * 32 + 4 * n) = (acc[ai][bj][m][n] * rs) * gv[bj][n]; }
        }
    }
};

template <class Epi, class Sched, bool ALIGN_EPI = false, bool SP2 = false>
__device__ __forceinline__ void gemm_phase(PG8_LAS unsigned char* lds, const Gemm g, const Sched& S, const Epi& E) {
    int tid_ = threadIdx.x; asm volatile("" : "+v"(tid_));
    const int tid = tid_, wid = __builtin_amdgcn_readfirstlane(tid >> 6), lane = tid & 63, wr = wid >> 2, wc = wid & 3, fr = lane & 15, fq = lane >> 4;
    const int K = g.K, nt = K / BK;
    unsigned voffA[2], voffB[2];
#pragma unroll
    for (int i = 0; i < 2; ++i) { int R, C; stage_rc(tid * 16 + i * 8192, R, C); const int Rb = Epi::PERM ? ((R & ~31) + perm32(R & 31)) : R;
        voffA[i] = (unsigned)(R * K + C) * 2u; voffB[i] = (unsigned)(((Rb >> 5) * 64 + (Rb & 31)) * K + C) * 2u; }
    const size_t kstep = (size_t)(BK * 2);
    const size_t hstep = (size_t)HALF * K * 2;
    const size_t tstep = 2 * hstep;
    const size_t hstepB = (size_t)32 * K * 2;
    const unsigned ldsw = (unsigned)wid * 1024u;
    const int aoff = lds_byte(wr * 64 + fr, fq * 8), boff = lds_byte(wc * 32 + fr, fq * 8);
#define PG8_SA(b, h) (((b) * 2 + (h)) * HTB)
#define PG8_SB(b, h) ((4 + (b) * 2 + (h)) * HTB)
#define PG8_STAGE(bufoff, gbase, voff) do { _Pragma("unroll") for (int _i = 0; _i < 2; ++_i) \
        __builtin_amdgcn_global_load_lds((const unsigned*)((const char*)(gbase) + (voff)[_i]), (PG8_LAS unsigned*)(lds + (bufoff) + ldsw + _i * 8192), 16, 0, 0); } while (0)
#define PG8_LDA(dst, b, h) do { _Pragma("unroll") for (int m = 0; m < 4; ++m) _Pragma("unroll") for (int k = 0; k < 2; ++k) dst[m][k] = *(const PG8_LAS bf16x8*)(lds + PG8_SA(b, h) + aoff + m * 2048 + k * 1024); } while (0)
#define PG8_LDB(dst, b, h) do { _Pragma("unroll") for (int n = 0; n < 2; ++n) _Pragma("unroll") for (int k = 0; k < 2; ++k) dst[n][k] = *(const PG8_LAS bf16x8*)(lds + PG8_SB(b, h) + boff + n * 2048 + k * 1024); } while (0)
#define PG8_MMA(ai, bj, At, Bt) do { __builtin_amdgcn_s_setprio(1); _Pragma("unroll") for (int m = 0; m < 4; ++m) _Pragma("unroll") for (int n = 0; n < 2; ++n) _Pragma("unroll") for (int k = 0; k < 2; ++k) \
        acc[ai][bj][m][n] = __builtin_amdgcn_mfma_f32_16x16x32_bf16(Bt[n][k], At[m][k], acc[ai][bj][m][n], 0, 0, 0); __builtin_amdgcn_s_setprio(0); } while (0)
#define PG8_WAIT_V(n) asm volatile("s_waitcnt vmcnt(" #n ")" ::: "memory")
#define PG8_WAIT_L(n) asm volatile("s_waitcnt lgkmcnt(" #n ")" ::: "memory")
#define PG8_BAR __builtin_amdgcn_s_barrier()
#define PG8_SCHED __builtin_amdgcn_sched_barrier(0)
    Unit cur, nxt; int ui = 0;
    if (!S.next(0, cur)) return;
    f32x4 acc[2][2][4][2];
#pragma unroll
    for (int a = 0; a < 2; ++a)
#pragma unroll
        for (int b = 0; b < 2; ++b)
#pragma unroll
            for (int m = 0; m < 4; ++m)
#pragma unroll
                for (int n = 0; n < 2; ++n) acc[a][b][m][n] = (f32x4){0.f, 0.f, 0.f, 0.f};
    bf16x8 At[4][2], B0[2][2], B1[2][2];
    const char* cA = (const char*)g.A + (size_t)(cur.pm >> 3) * g.a_bstride + (size_t)(cur.pm & 7) * tstep; const char* cB = (const char*)g.Bt + (size_t)cur.pn * tstep;
    S.a_ready(cur);
    if constexpr (SP2) {
        PG8_STAGE(PG8_SB(0, 0), cB, voffB); PG8_STAGE(PG8_SB(0, 1), cB + hstepB, voffB); PG8_STAGE(PG8_SA(0, 0), cA, voffA); PG8_STAGE(PG8_SA(0, 1), cA + hstep, voffA);
        if (wr == 1) PG8_BAR;
        PG8_WAIT_V(2); PG8_BAR;
        PG8_STAGE(PG8_SB(1, 0), cB + kstep, voffB); PG8_STAGE(PG8_SA(1, 0), cA + kstep, voffA); PG8_STAGE(PG8_SB(1, 1), cB + hstepB + kstep, voffB);
        PG8_WAIT_V(6); PG8_BAR;
    } else {
        PG8_STAGE(PG8_SB(0, 0), cB, voffB); PG8_STAGE(PG8_SA(0, 0), cA, voffA); PG8_STAGE(PG8_SB(0, 1), cB + hstepB, voffB); PG8_STAGE(PG8_SA(0, 1), cA + hstep, voffA);
        if (wr == 1) PG8_BAR;
        PG8_WAIT_V(4); PG8_BAR;
        PG8_STAGE(PG8_SB(1, 0), cB + kstep, voffB); PG8_STAGE(PG8_SA(1, 0), cA + kstep, voffA); PG8_STAGE(PG8_SB(1, 1), cB + hstepB + kstep, voffB);
        PG8_WAIT_V(6); PG8_BAR;
    }
    for (;;) {
        const bool has_next = S.next(ui + 1, nxt);
        const char* nA = has_next ? (const char*)g.A + (size_t)(nxt.pm >> 3) * g.a_bstride + (size_t)(nxt.pm & 7) * tstep : cA; const char* nB = has_next ? (const char*)g.Bt + (size_t)nxt.pn * tstep : cB;
        for (int t = 0; t < nt; t += 2) {
            const bool last = (t == nt - 2);
            const char* a1 = cA + (size_t)(t + 1) * kstep;
            const char* a2 = last ? nA : cA + (size_t)(t + 2) * kstep; const char* b2 = last ? nB : cB + (size_t)(t + 2) * kstep;
            const char* a3 = a2 + kstep; const char* b3 = b2 + kstep;
            if (last && has_next) S.a_ready(nxt);
            if constexpr (SP2) {
            PG8_LDB(B0, 0, 0); PG8_LDB(B1, 0, 1); PG8_SCHED; PG8_LDA(At, 0, 0); PG8_STAGE(PG8_SA(1, 1), a1 + hstep, voffA);
            PG8_WAIT_V(8); PG8_WAIT_L(0); PG8_BAR; PG8_MMA(0, 0, At, B0); PG8_MMA(0, 1, At, B1); PG8_BAR; PG8_SCHED;
            PG8_LDA(At, 0, 1); PG8_STAGE(PG8_SB(0, 0), b2, voffB); PG8_STAGE(PG8_SB(0, 1), b2 + hstepB, voffB); PG8_STAGE(PG8_SA(0, 0), a2, voffA);
            PG8_WAIT_V(8); PG8_WAIT_L(0); PG8_BAR; PG8_MMA(1, 0, At, B0); PG8_MMA(1, 1, At, B1); PG8_BAR; PG8_SCHED;
            PG8_LDB(B0, 1, 0); PG8_LDB(B1, 1, 1); PG8_SCHED; PG8_LDA(At, 1, 0); PG8_STAGE(PG8_SA(0, 1), a2 + hstep, voffA);
            PG8_WAIT_V(8); PG8_WAIT_L(0); PG8_BAR; PG8_MMA(0, 0, At, B0); PG8_MMA(0, 1, At, B1); PG8_BAR; PG8_SCHED;
            PG8_LDA(At, 1, 1); PG8_STAGE(PG8_SB(1, 0), b3, voffB); PG8_STAGE(PG8_SB(1, 1), b3 + hstepB, voffB); PG8_STAGE(PG8_SA(1, 0), a3, voffA);
            PG8_WAIT_V(8); PG8_WAIT_L(0); PG8_BAR; PG8_MMA(1, 0, At, B0); PG8_MMA(1, 1, At, B1); PG8_BAR; PG8_SCHED;
            } else {
            PG8_LDB(B0, 0, 0); PG8_SCHED; PG8_LDA(At, 0, 0); PG8_STAGE(PG8_SA(1, 1), a1 + hstep, voffA);
            PG8_WAIT_L(8); PG8_BAR; PG8_WAIT_L(0); PG8_MMA(0, 0, At, B0); PG8_BAR; PG8_SCHED;
            PG8_LDB(B1, 0, 1); PG8_STAGE(PG8_SB(0, 0), b2, voffB);
            PG8_BAR; PG8_WAIT_L(0); PG8_MMA(0, 1, At, B1); PG8_BAR;
            PG8_LDA(At, 0, 1); PG8_STAGE(PG8_SA(0, 0), a2, voffA);
            PG8_BAR; PG8_WAIT_L(0); PG8_MMA(1, 0, At, B0); PG8_BAR; PG8_SCHED;
            PG8_STAGE(PG8_SB(0, 1), b2 + hstepB, voffB);
            PG8_WAIT_V(6); PG8_BAR; PG8_MMA(1, 1, At, B1); PG8_BAR;
            PG8_LDB(B0, 1, 0); PG8_SCHED; PG8_LDA(At, 1, 0); PG8_STAGE(PG8_SA(0, 1), a2 + hstep, voffA);
            PG8_WAIT_L(8); PG8_BAR; PG8_WAIT_L(0); PG8_MMA(0, 0, At, B0); PG8_BAR; PG8_SCHED;
            PG8_LDB(B1, 1, 1); PG8_STAGE(PG8_SB(1, 0), b3, voffB);
            PG8_BAR; PG8_WAIT_L(0); PG8_MMA(0, 1, At, B1); PG8_BAR;
            PG8_LDA(At, 1, 1); PG8_STAGE(PG8_SA(1, 0), a3, voffA);
            PG8_BAR; PG8_WAIT_L(0); PG8_MMA(1, 0, At, B0); PG8_BAR; PG8_SCHED;
            PG8_STAGE(PG8_SB(1, 1), b3 + hstepB, voffB);
            PG8_WAIT_V(6); PG8_BAR; PG8_MMA(1, 1, At, B1); PG8_BAR;
            }
        }
        if constexpr (ALIGN_EPI) { if (wr == 0) PG8_BAR; }
        if constexpr (!Epi::AFTER_DRAIN) { E(acc, cur, wr, wc, fr, fq); S.done(cur); }
        if (!has_next) break;
#pragma unroll
        for (int a = 0; a < 2; ++a)
#pragma unroll
            for (int b = 0; b < 2; ++b)
#pragma unroll
                for (int m = 0; m < 4; ++m)
#pragma unroll
                    for (int n = 0; n < 2; ++n) acc[a][b][m][n] = (f32x4){0.f, 0.f, 0.f, 0.f};
        cur = nxt; cA = nA; cB = nB; ++ui;
        if constexpr (ALIGN_EPI) { if (wr == 1) PG8_BAR; }
    }
    PG8_WAIT_V(0);
    if constexpr (!ALIGN_EPI) { if (wr == 0) PG8_BAR; }
    PG8_BAR;
    if constexpr (Epi::AFTER_DRAIN) { E.fused(acc, cur, wr, wc, fr, fq, lds, wid, lane); S.done(cur); }
#undef PG8_SA
#undef PG8_SB
#undef PG8_STAGE
#undef PG8_LDA
#undef PG8_LDB
#undef PG8_MMA
#undef PG8_WAIT_V
#undef PG8_WAIT_L
#undef PG8_BAR
#undef PG8_SCHED
}
}
#include <cmath>
namespace att {
typedef unsigned short bf16;
using bf16x8 = __attribute__((ext_vector_type(8))) short;
using s16x4 = __attribute__((ext_vector_type(4))) short;
using f32x16 = __attribute__((ext_vector_type(16))) float;
using f32x4 = __attribute__((ext_vector_type(4))) float;
using u32x4 = __attribute__((ext_vector_type(4))) unsigned;
#define ALAS __attribute__((address_space(3)))
constexpr int SEQ = 2048, D = 64, DM = 1024, NW = 8, QBLK = 32, QB = QBLK * NW, KVBLK = 64, NQB = SEQ / QB;
constexpr int NSLOT = 3, SLOTB = 8192;
constexpr int LDS_K = 0, LDS_V = NSLOT * SLOTB, LDS_WS = 2 * NSLOT * SLOTB, LDS_OST = LDS_WS + NW * 64 * 4, LDS_E = LDS_OST + NW * 4096  , LDS_TAB = LDS_E + 2048 * 4  , LDS_OFFS = LDS_TAB + 640 * 4, LDS_KX = LDS_OFFS + 512  , LDS_BYTES = LDS_KX + 2048 * 8 + 16;
constexpr float LOG2E = 1.4426950408889634f;
constexpr float C2 = 0.125f * LOG2E;
__device__ __forceinline__ int crow(int r, int hi) { return (r & 3) + 8 * (r >> 2) + 4 * hi; }
#define SBAR() __builtin_amdgcn_sched_barrier(0)
__device__ __forceinline__ void glds16(const void* gsrc, unsigned lds_dst) { unsigned keep;
  asm volatile("s_mov_b32 %0, m0\n\ts_mov_b32 m0, %2\n\ts_nop 0\n\tglobal_load_lds_dwordx4 %1, off\n\ts_mov_b32 m0, %0" : "=&s"(keep) : "v"(gsrc), "s"(lds_dst) : "memory"); }
typedef float f32x2_t __attribute__((ext_vector_type(2))); typedef __bf16 bf16x2_t __attribute__((ext_vector_type(2)));
__device__ __forceinline__ unsigned cvtpk_s(float lo, float hi) { f32x2_t v = {lo, hi}; bf16x2_t b = __builtin_convertvector(v, bf16x2_t); return __builtin_bit_cast(unsigned, b); }
#define WAIT_BAR(N) asm volatile("s_waitcnt vmcnt(" #N ") lgkmcnt(0)\n\ts_barrier" ::: "memory")
typedef ALAS const char* lds_cptr;
typedef short v4i16_t __attribute__((ext_vector_type(4)));
#define MX3(a, b, c) __builtin_fmaxf(__builtin_fmaxf((a), (b)), (c))
__device__ __forceinline__ float rowmax(const f32x16& p0, const f32x16& p1) {
  float a = MX3(p0[0], p0[1], p1[0]), b = MX3(p0[2], p0[3], p1[1]); a = MX3(a, p1[2], p1[3]);
#pragma unroll
  for (int r = 4; r < 16; r += 4) { a = MX3(a, p0[r], p0[r + 1]); b = MX3(b, p0[r + 2], p0[r + 3]); a = MX3(a, p1[r], p1[r + 1]); b = MX3(b, p1[r + 2], p1[r + 3]); }
  float m = __builtin_fmaxf(a, b); auto rr = __builtin_amdgcn_permlane32_swap(__float_as_uint(m), __float_as_uint(m), false, false);
  return __builtin_fmaxf(__uint_as_float(rr[0]), __uint_as_float(rr[1])); }
__device__ __forceinline__ void qkt(f32x16& p0, f32x16& p1, lds_cptr Kslot, const bf16x8* qr, const f32x16& cin, int r32, int hi) {
  lds_cptr kb = Kslot + hi * 1024 + r32 * 16;
#pragma unroll
  for (int d0 = 0; d0 < 4; ++d0) {
    const bf16x8 b0 = *(const ALAS bf16x8*)(kb + d0 * 2048);
    const bf16x8 b1 = *(const ALAS bf16x8*)(kb + d0 * 2048 + 512);
    if (d0 == 0) { p0 = __builtin_amdgcn_mfma_f32_32x32x16_bf16(b0, qr[0], cin, 0, 0, 0); p1 = __builtin_amdgcn_mfma_f32_32x32x16_bf16(b1, qr[0], cin, 0, 0, 0); }
    else { p0 = __builtin_amdgcn_mfma_f32_32x32x16_bf16(b0, qr[d0], p0, 0, 0, 0); p1 = __builtin_amdgcn_mfma_f32_32x32x16_bf16(b1, qr[d0], p1, 0, 0, 0); } }
}
__device__ __forceinline__ void pv(f32x16* o, int vb, bf16x8 pa0, bf16x8 pa1, bf16x8 pa2, bf16x8 pa3) {
#pragma unroll
  for (int d0 = 0; d0 < 2; ++d0) { s16x4 lo[4], hi[4];
#pragma unroll
    for (int ks = 0; ks < 4; ++ks) {
      asm volatile("ds_read_b64_tr_b16 %0,%1 offset:%c2" : "=&v"(lo[ks]) : "v"(vb), "i"(d0 * 4096 + ks * 1024) : "memory");
      asm volatile("ds_read_b64_tr_b16 %0,%1 offset:%c2" : "=&v"(hi[ks]) : "v"(vb), "i"(d0 * 4096 + ks * 1024 + 512) : "memory"); }
    asm volatile("s_waitcnt lgkmcnt(0)" ::: "memory"); SBAR();
#define PK(k) (bf16x8){lo[k][0], lo[k][1], lo[k][2], lo[k][3], hi[k][0], hi[k][1], hi[k][2], hi[k][3]}
    o[d0] = __builtin_amdgcn_mfma_f32_32x32x16_bf16(pa0, PK(0), o[d0], 0, 0, 0);
    o[d0] = __builtin_amdgcn_mfma_f32_32x32x16_bf16(pa1, PK(1), o[d0], 0, 0, 0);
    o[d0] = __builtin_amdgcn_mfma_f32_32x32x16_bf16(pa2, PK(2), o[d0], 0, 0, 0);
    o[d0] = __builtin_amdgcn_mfma_f32_32x32x16_bf16(pa3, PK(3), o[d0], 0, 0, 0);
#undef PK
  }
}
__device__ __forceinline__ int t5_bucket(int d) {
  if (d < 16) return d;
  const int b = 16 + (int)(__logf((float)d * (1.0f / 16.0f)) * (16.0f / 2.0794415416798357f));
  return b < 31 ? b : 31;
}
struct AttnAux { const float* rel_bias; const float* sinks; const float* CL; const float* CT; };

template <int MODE> __device__ __forceinline__ void attn_unit_v1(int b, int h, int qb, const bf16* Q, const bf16* __restrict__ K, const bf16* __restrict__ V, bf16* O, ALAS char* shm, const AttnAux& ax) {
  constexpr int KP = MODE == 0 ? 256 : 1024;
  int tid_ = threadIdx.x; asm volatile("" : "+v"(tid_));
  const int tid = tid_, lane = tid & 63, r32 = lane & 31, hi = lane >> 5; const int wid = __builtin_amdgcn_readfirstlane(tid >> 6);
  const int kvh = MODE == 0 ? (h >> 2) : h;
  const long rowbase = 0; const int q0 = qb * QB;
  const bf16* Qw = Q + (rowbase + q0 + wid * QBLK) * DM + h * D;
  const bf16* Kh = K + rowbase * KP + kvh * D, *Vh = V + rowbase * KP + kvh * D;
  const unsigned lds0 = (unsigned)(uintptr_t)shm;
  ALAS float* wsf = (ALAS float*)(shm + LDS_WS) + wid * 64;
  ALAS float* Ef = (ALAS float*)(shm + LDS_E);
  ALAS float* TAB = (ALAS float*)(shm + LDS_TAB);
  ALAS float* OFFS = (ALAS float*)(shm + LDS_OFFS);
  const bf16* ksrc = Kh + (long)lane * KP + wid * 8;
  const bf16* vsrc = Vh + (long)(16 * (wid & 3) + (lane >> 2)) * KP + (wid >> 2) * 32 + (lane & 3) * 8;
  const unsigned kdst = lds0 + LDS_K + wid * 1024, vdst = lds0 + LDS_V + wid * 1024;
#define DMA_K(t, slot) glds16(ksrc + (long)(t) * KVBLK * KP, (unsigned)__builtin_amdgcn_readfirstlane(kdst + (slot)))
#define DMA_V(t, slot) glds16(vsrc + (long)(t) * KVBLK * KP, (unsigned)__builtin_amdgcn_readfirstlane(vdst + (slot)))
  const int vb0 = (int)(lds0 + LDS_V) + ((lane >> 4) & 1) * 32 + (lane & 3) * 8 + (4 * hi + ((lane & 15) >> 2)) * 64;
  const lds_cptr Kbase = (lds_cptr)shm + LDS_K;
  const int t_lo = MODE == 0 ? (qb > 0 ? 4 * qb - 2 : 0) : 0, t_hi = 4 * qb + 3;
  bf16x8 qr[4];
#pragma unroll
  for (int d0 = 0; d0 < 4; ++d0) qr[d0] = *reinterpret_cast<const bf16x8*>(&Qw[(long)r32 * DM + d0 * 16 + hi * 8]);
  float mhat, l_reg; f32x16 o[2]; o[0] = f32x16{}; o[1] = f32x16{};
  const int qg = q0 + wid * QBLK + r32;
  bf16x8 qx = bf16x8{};
  if (MODE == 0) {
    { const int dist = tid - 256; float v = -INFINITY;
      if (dist >= 0 && dist < 128) v = ax.rel_bias[t5_bucket(dist) * 16 + h] * LOG2E;
      TAB[tid] = v; if (tid < 128) TAB[512 + tid] = -INFINITY; }
    mhat = ax.sinks[h] * LOG2E; l_reg = hi == 0 ? 1.0f : 0.0f;
  } else {
    if (wid == 0) { float v = (lane <= t_hi) ? ax.CT[(size_t)(b * 16 + h) * 32 + (lane & 31)] : 0.f; if (lane >= 32) v = 0.f; float inc = v;
#pragma unroll
      for (int s = 1; s < 32; s <<= 1) { const float uu = __shfl_up(inc, s); if (lane >= s) inc += uu; }
      if (lane < 32) OFFS[lane] = inc - v; }
    asm volatile("s_waitcnt lgkmcnt(0)\n\ts_barrier" ::: "memory");
    const float* cl = ax.CL + (size_t)(b * 16 + h) * SEQ;
    for (int k = tid; k < (t_hi + 1) * 64; k += 512) Ef[k] = -(cl[k] + OFFS[k >> 6]);
    mhat = -INFINITY; l_reg = 0.f;
    if (hi == 0) { qx[0] = 0x3F80; qx[1] = 0x3F80; qx[2] = 0x3F80; }
  }
  f32x16 zero16 = f32x16{}; asm volatile("" : "+v"(zero16));
  DMA_K(t_lo, 0); DMA_V(t_lo, 0);
  for (int t = t_lo; t <= t_hi; ++t) {
    const int sl = ((t - t_lo) & 1) * SLOTB;
    WAIT_BAR(0);
    if (t < t_hi) { DMA_K(t + 1, sl ^ SLOTB); DMA_V(t + 1, sl ^ SLOTB); }
    if (MODE == 0) {
      const int qw = q0 + wid * QBLK;
      if (64 * t > qw + 31 || 64 * t + 63 < qw - 127) continue;
    }
    f32x16 p0, p1;
    qkt(p0, p1, Kbase + sl, qr, zero16, r32, hi);
    if (MODE == 1) {
      bf16x8 kx0 = bf16x8{}, kx1 = bf16x8{};
      const float e0 = Ef[64 * t + r32], e1 = Ef[64 * t + 32 + r32];
      if (hi == 0) {
        { const unsigned a = cvtpk_s(e0, 0.f) & 0xffffu; const float r1 = e0 - __uint_as_float(a << 16); const unsigned bb = cvtpk_s(r1, 0.f) & 0xffffu; const float r2 = r1 - __uint_as_float(bb << 16); const unsigned c = cvtpk_s(r2, 0.f) & 0xffffu;
          kx0[0] = (short)a; kx0[1] = (short)bb; kx0[2] = (short)c; }
        { const unsigned a = cvtpk_s(e1, 0.f) & 0xffffu; const float r1 = e1 - __uint_as_float(a << 16); const unsigned bb = cvtpk_s(r1, 0.f) & 0xffffu; const float r2 = r1 - __uint_as_float(bb << 16); const unsigned c = cvtpk_s(r2, 0.f) & 0xffffu;
          kx1[0] = (short)a; kx1[1] = (short)bb; kx1[2] = (short)c; }
      }
      p0 = __builtin_amdgcn_mfma_f32_32x32x16_bf16(kx0, qx, p0, 0, 0, 0); p1 = __builtin_amdgcn_mfma_f32_32x32x16_bf16(kx1, qx, p1, 0, 0, 0);
      if (t >= 4 * qb) {
        const int kb = 64 * t + 4 * hi;
#pragma unroll
        for (int r = 0; r < 16; ++r) { const int kv = kb + (r & 3) + 8 * (r >> 2); if (kv > qg) p0[r] = -INFINITY; if (kv + 32 > qg) p1[r] = -INFINITY; }
      }
    } else {
      const int ib = 256 + qg - 64 * t - 4 * hi;
#pragma unroll
      for (int g = 0; g < 4; ++g) { const int idx = ib - 8 * g; f32x4 t0 = {TAB[idx], TAB[idx - 1], TAB[idx - 2], TAB[idx - 3]}, t1 = {TAB[idx - 32], TAB[idx - 33], TAB[idx - 34], TAB[idx - 35]};
        asm volatile("" : "+v"(t0), "+v"(t1));
#pragma unroll
        for (int e = 0; e < 4; ++e) { p0[4 * g + e] += t0[e]; p1[4 * g + e] += t1[e]; } }
    }
    const float rm = rowmax(p0, p1);
    const float mn = __builtin_fmaxf(mhat, rm), f = __builtin_amdgcn_exp2f(mhat - mn); mhat = mn;
    float sacc = 0.f;
#pragma unroll
    for (int r = 0; r < 16; ++r) { p0[r] = __builtin_amdgcn_exp2f(p0[r] - mn); p1[r] = __builtin_amdgcn_exp2f(p1[r] - mn); sacc += p0[r] + p1[r]; }
    l_reg = l_reg * f + sacc;
    if (hi == 0) wsf[r32] = f;
    asm volatile("s_waitcnt lgkmcnt(0)" ::: "memory");
#pragma unroll
    for (int d_ = 0; d_ < 2; ++d_)
#pragma unroll
      for (int r = 0; r < 16; ++r) o[d_][r] *= wsf[crow(r, hi)];
    u32x4 pw0, pw1, pw2, pw3;
#define PKW(P, B) cvtpk_s(P[B], P[B + 1])
    pw0 = (u32x4){PKW(p0, 0), PKW(p0, 2), PKW(p0, 4), PKW(p0, 6)}; pw1 = (u32x4){PKW(p0, 8), PKW(p0, 10), PKW(p0, 12), PKW(p0, 14)};
    pw2 = (u32x4){PKW(p1, 0), PKW(p1, 2), PKW(p1, 4), PKW(p1, 6)}; pw3 = (u32x4){PKW(p1, 8), PKW(p1, 10), PKW(p1, 12), PKW(p1, 14)};
#undef PKW
    SBAR(); pv(o, vb0 + sl, __builtin_bit_cast(bf16x8, pw0), __builtin_bit_cast(bf16x8, pw1), __builtin_bit_cast(bf16x8, pw2), __builtin_bit_cast(bf16x8, pw3));
  }
  { auto rr = __builtin_amdgcn_permlane32_swap(__float_as_uint(l_reg), __float_as_uint(l_reg), false, false); l_reg = __uint_as_float(rr[0]) + __uint_as_float(rr[1]); }
  if (hi == 0) wsf[32 + r32] = l_reg;
  asm volatile("s_waitcnt lgkmcnt(0)" ::: "memory");
  float rli[16];
#pragma unroll
  for (int r = 0; r < 16; ++r) rli[r] = __builtin_amdgcn_rcpf(wsf[32 + crow(r, hi)]);
  bf16* Ow = O + (rowbase + q0 + wid * QBLK) * DM + h * D;
  { ALAS bf16* stg = (ALAS bf16*)(shm + LDS_OST) + wid * 2048;
#pragma unroll
    for (int r = 0; r < 16; ++r) { const int orow = crow(r, hi);
#pragma unroll
      for (int d0 = 0; d0 < 2; ++d0) stg[orow * 64 + d0 * 32 + r32] = (bf16)(cvtpk_s(o[d0][r] * rli[r], 0.f) & 0xffffu); }
    asm volatile("s_waitcnt lgkmcnt(0)" ::: "memory");
#pragma unroll
    for (int i = 0; i < 4; ++i) { const int row = i * 8 + (lane >> 3), ch = lane & 7; const u32x4 v = *(const ALAS u32x4*)(stg + row * 64 + ch * 8); *(u32x4*)(Ow + (long)row * DM + ch * 8) = v; } }
  asm volatile("s_waitcnt lgkmcnt(0)\n\ts_barrier" ::: "memory");
#undef DMA_K
#undef DMA_V
}

__device__ __forceinline__ void attn_swa_sweep(int h, int half, const bf16* Q, const bf16* __restrict__ K, const bf16* __restrict__ V, bf16* O, ALAS char* shm, const AttnAux& ax) {
  constexpr int KP = 256, NS = 4, NPAIR = 9;
  constexpr int S_K = 0, S_V = NS * SLOTB, S_WS = 2 * NS * SLOTB, S_QST = S_WS + NW * 64 * 4, S_OST = S_QST + NW * 4096, S_TAB = S_OST + NW * 1024;
  static_assert(S_TAB + 640 * 4 <= 131072, "sweep scratch inside the 128 KiB ring region");
  int tid_ = threadIdx.x; asm volatile("" : "+v"(tid_));
  const int tid = tid_, lane = tid & 63, r32 = lane & 31, hi = lane >> 5; const int wid = __builtin_amdgcn_readfirstlane(tid >> 6);
  const int kvh = h >> 2, R0 = 1024 * half, T0 = R0 / 64 - 2;
  const int j0 = (wid & 1) | ((wid & 2) << 1) | ((wid & 4) >> 1), a0 = j0 >> 2; const bool kodd = ((j0 >> 1) & 1) != 0;
  const bf16* Kh = K + kvh * D, *Vh = V + kvh * D;
  const unsigned lds0 = (unsigned)(uintptr_t)shm;
  ALAS float* wsf = (ALAS float*)(shm + S_WS) + wid * 64;
  ALAS float* TAB = (ALAS float*)(shm + S_TAB);
  const bf16* ksrc = Kh + (long)lane * KP + wid * 8;
  const bf16* vsrc = Vh + (long)(16 * (wid & 3) + (lane >> 2)) * KP + (wid >> 2) * 32 + (lane & 3) * 8;
  const unsigned kdst = lds0 + S_K + wid * 1024, vdst = lds0 + S_V + wid * 1024;
#define DMA_KV(s_) do { const int t__ = T0 + (s_) < 0 ? 0 : T0 + (s_); const int sl__ = ((s_) & (NS - 1)) * SLOTB; glds16(ksrc + (long)t__ * KVBLK * KP, (unsigned)__builtin_amdgcn_readfirstlane(kdst + sl__)); \
                        glds16(vsrc + (long)t__ * KVBLK * KP, (unsigned)__builtin_amdgcn_readfirstlane(vdst + sl__)); } while (0)
  const int vb0 = (int)(lds0 + S_V) + ((lane >> 4) & 1) * 32 + (lane & 3) * 8 + (4 * hi + ((lane & 15) >> 2)) * 64;
  const lds_cptr Kbase = (lds_cptr)shm + S_K;
  const bf16* qsrc = Q + (long)(R0 + 32 * j0 + (lane >> 3)) * DM + h * D + (((lane & 7) ^ ((lane >> 3) & 7)) * 8);
  const unsigned qdst = lds0 + S_QST + wid * 4096;
#define QDMA(blk) do { const bf16* q__ = qsrc + (long)(blk) * 256 * DM; \
    glds16(q__, (unsigned)__builtin_amdgcn_readfirstlane(qdst)); glds16(q__ + 8 * DM, (unsigned)__builtin_amdgcn_readfirstlane(qdst + 1024)); \
    glds16(q__ + 16 * DM, (unsigned)__builtin_amdgcn_readfirstlane(qdst + 2048)); glds16(q__ + 24 * DM, (unsigned)__builtin_amdgcn_readfirstlane(qdst + 3072)); } while (0)
  const lds_cptr qrd = (lds_cptr)shm + S_QST + wid * 4096 + r32 * 128;
  asm volatile("s_waitcnt lgkmcnt(0)\n\ts_barrier" ::: "memory");
  QDMA(0); DMA_KV(0); DMA_KV(1);
  { const int dist = tid - 256; float v = -INFINITY;
    if (dist >= 0 && dist < 128) v = ax.rel_bias[t5_bucket(dist) * 16 + h] * LOG2E;
    TAB[tid] = v; if (tid < 128) TAB[512 + tid] = -INFINITY; }
  const float sink2 = ax.sinks[h] * LOG2E;
  bf16* Ow = O + (long)(R0 + 32 * j0) * DM + h * D;
  bf16x8 qr[4]; qr[0] = bf16x8{}; qr[1] = bf16x8{}; qr[2] = bf16x8{}; qr[3] = bf16x8{};
  float mhat = 0.f, l_reg = 0.f; f32x16 o[2]; o[0] = f32x16{}; o[1] = f32x16{}; int qg = 0;
  f32x16 zero16 = f32x16{}; asm volatile("" : "+v"(zero16));
  for (int P = 0; P <= NPAIR; ++P) {
    if (P < NPAIR) {
      asm volatile("s_waitcnt vmcnt(0) lgkmcnt(0)\n\ts_barrier" ::: "memory");
      if (P + 1 < NPAIR) { DMA_KV(2 * P + 2); DMA_KV(2 * P + 3); }
    }
    const int q = P - a0;
    if (q < 0 || q > 8) continue;
    const bool second = (q & 1) != 0;
    if (!second) {
      if (q >= 2) {
        const int u = (q >> 1) - 1;
        { auto rr = __builtin_amdgcn_permlane32_swap(__float_as_uint(l_reg), __float_as_uint(l_reg), false, false); l_reg = __uint_as_float(rr[0]) + __uint_as_float(rr[1]); }
        if (hi == 0) wsf[32 + r32] = l_reg;
        asm volatile("s_waitcnt lgkmcnt(0)" ::: "memory");
        ALAS bf16* stg = (ALAS bf16*)(shm + S_OST) + wid * 512;
        bf16* Ob = Ow + (long)u * 256 * DM + (long)(lane >> 3) * DM + (lane & 7) * 8;
#pragma unroll
        for (int i = 0; i < 4; ++i) {
#pragma unroll
          for (int rr = 0; rr < 4; ++rr) { const int r = 4 * i + rr; const float rl = __builtin_amdgcn_rcpf(wsf[32 + crow(r, hi)]);
#pragma unroll
            for (int d0 = 0; d0 < 2; ++d0) stg[(rr + 4 * hi) * 64 + d0 * 32 + r32] = (bf16)(cvtpk_s(o[d0][r] * rl, 0.f) & 0xffffu); }
          asm volatile("s_waitcnt lgkmcnt(0)" ::: "memory");
          const u32x4 v = *(const ALAS u32x4*)(stg + lane * 8);
          asm volatile("s_waitcnt lgkmcnt(0)" ::: "memory");
          *(u32x4*)(Ob + (long)(8 * i) * DM) = v;
        }
      }
      if (q == 8) continue;
      const int u = q >> 1;
#pragma unroll
      for (int d0 = 0; d0 < 4; ++d0) qr[d0] = *(const ALAS bf16x8*)(qrd + (((2 * d0 + hi) ^ (r32 & 7)) * 16));
      asm volatile("s_waitcnt lgkmcnt(0)" ::: "memory");
      if (u < 3) QDMA(u + 1);
      mhat = sink2; l_reg = hi == 0 ? 1.0f : 0.0f; o[0] = f32x16{}; o[1] = f32x16{};
      qg = R0 + 32 * (j0 + 8 * u) + r32;
    }
    for (int e = 0; e < 2; ++e) {
      if (e == 0 ? (kodd && !second) : (!kodd && second)) continue;
      const int s = 2 * P + e, t = T0 + s;
      if (t < 0) continue;
      const int sl = (s & (NS - 1)) * SLOTB;
      f32x16 p0, p1;
      { const int ib = 256 + qg - 64 * t - 4 * hi;
#pragma unroll
        for (int g = 0; g < 4; ++g) { const int idx = ib - 8 * g; f32x4 t0 = {TAB[idx], TAB[idx - 1], TAB[idx - 2], TAB[idx - 3]}, t1 = {TAB[idx - 32], TAB[idx - 33], TAB[idx - 34], TAB[idx - 35]};
          asm volatile("" : "+v"(t0), "+v"(t1));
#pragma unroll
          for (int ee = 0; ee < 4; ++ee) { p0[4 * g + ee] = t0[ee] - mhat; p1[4 * g + ee] = t1[ee] - mhat; } } }
      { lds_cptr kb = Kbase + sl + hi * 1024 + r32 * 16;
#pragma unroll
        for (int d0 = 0; d0 < 4; ++d0) { const bf16x8 b0 = *(const ALAS bf16x8*)(kb + d0 * 2048), b1 = *(const ALAS bf16x8*)(kb + d0 * 2048 + 512);
          p0 = __builtin_amdgcn_mfma_f32_32x32x16_bf16(b0, qr[d0], p0, 0, 0, 0); p1 = __builtin_amdgcn_mfma_f32_32x32x16_bf16(b1, qr[d0], p1, 0, 0, 0); } }
      const float rm = rowmax(p0, p1);
      const bool mv = rm > 8.0f;
      if (__builtin_expect(__any(mv), 0)) {
        const float dl = mv ? rm : 0.f, f = __builtin_amdgcn_exp2f(-dl); mhat += dl;
#pragma unroll
        for (int r = 0; r < 16; ++r) { p0[r] -= dl; p1[r] -= dl; }
        l_reg *= f;
        if (hi == 0) wsf[r32] = f;
        asm volatile("s_waitcnt lgkmcnt(0)" ::: "memory");
#pragma unroll
        for (int d_ = 0; d_ < 2; ++d_)
#pragma unroll
          for (int r = 0; r < 16; ++r) o[d_][r] *= wsf[crow(r, hi)];
      }
      float sa0 = 0.f, sa1 = 0.f;
#pragma unroll
      for (int r = 0; r < 16; ++r) { p0[r] = __builtin_amdgcn_exp2f(p0[r]); p1[r] = __builtin_amdgcn_exp2f(p1[r]); sa0 += p0[r]; sa1 += p1[r]; }
      l_reg += sa0 + sa1;
      u32x4 pw0, pw1, pw2, pw3;
#define PKW(P_, B) cvtpk_s(P_[B], P_[B + 1])
      pw0 = (u32x4){PKW(p0, 0), PKW(p0, 2), PKW(p0, 4), PKW(p0, 6)}; pw1 = (u32x4){PKW(p0, 8), PKW(p0, 10), PKW(p0, 12), PKW(p0, 14)};
      pw2 = (u32x4){PKW(p1, 0), PKW(p1, 2), PKW(p1, 4), PKW(p1, 6)}; pw3 = (u32x4){PKW(p1, 8), PKW(p1, 10), PKW(p1, 12), PKW(p1, 14)};
#undef PKW
      SBAR(); pv(o, vb0 + sl, __builtin_bit_cast(bf16x8, pw0), __builtin_bit_cast(bf16x8, pw1), __builtin_bit_cast(bf16x8, pw2), __builtin_bit_cast(bf16x8, pw3));
    }
  }
#undef DMA_KV
#undef QDMA
}

__device__ __forceinline__ void kload8(bf16x8* kf, lds_cptr kp) {
  kf[0] = *(const ALAS bf16x8*)(kp);        kf[1] = *(const ALAS bf16x8*)(kp + 512);
  kf[2] = *(const ALAS bf16x8*)(kp + 2048); kf[3] = *(const ALAS bf16x8*)(kp + 2560);
  kf[4] = *(const ALAS bf16x8*)(kp + 4096); kf[5] = *(const ALAS bf16x8*)(kp + 4608);
  kf[6] = *(const ALAS bf16x8*)(kp + 6144); kf[7] = *(const ALAS bf16x8*)(kp + 6656);
}
__device__ __forceinline__ void kload2(bf16x8* kf, lds_cptr kp, int j) { kf[2 * j] = *(const ALAS bf16x8*)(kp + j * 2048); kf[2 * j + 1] = *(const ALAS bf16x8*)(kp + j * 2048 + 512); }
__device__ __forceinline__ s16x4 vtr(lds_cptr p) { return __builtin_bit_cast(s16x4, __builtin_amdgcn_ds_read_tr16_b64_v4i16((ALAS v4i16_t*)p)); }
__device__ __forceinline__ void cmask(f32x16& p0, f32x16& p1, int jb, int qrel, int hi) {
  const int kb = 64 * jb + 4 * hi;
#pragma unroll
  for (int r = 0; r < 16; ++r) { const int kv = kb + (r & 3) + 8 * (r >> 2); if (kv > qrel) p0[r] = -INFINITY; if (kv + 32 > qrel) p1[r] = -INFINITY; }
}
__device__ __forceinline__ bf16x8 kx_frag(float e, int hi) {
  const unsigned a = cvtpk_s(e, 0.f) & 0xffffu; const float r1 = e - __uint_as_float(a << 16);
  const unsigned bb = cvtpk_s(r1, 0.f) & 0xffffu; const float r2 = r1 - __uint_as_float(bb << 16);
  const unsigned c = cvtpk_s(r2, 0.f) & 0xffffu;
  u32x4 w = {hi == 0 ? (a | (bb << 16)) : 0u, hi == 0 ? (c | 0x3F800000u) : 0u, hi == 0 ? 0x3F803F80u : 0u, 0u};
  return __builtin_bit_cast(bf16x8, w);
}
__device__ __forceinline__ bf16x8 qx_frag(float nm, int hi) {
  const unsigned a = cvtpk_s(nm, 0.f) & 0xffffu; const float r1 = nm - __uint_as_float(a << 16);
  const unsigned bb = cvtpk_s(r1, 0.f) & 0xffffu; const float r2 = r1 - __uint_as_float(bb << 16);
  const unsigned c = cvtpk_s(r2, 0.f) & 0xffffu;
  u32x4 w = {hi == 0 ? 0x3F803F80u : 0u, hi == 0 ? (0x3F80u | (a << 16)) : 0u, hi == 0 ? (bb | (c << 16)) : 0u, 0u};
  return __builtin_bit_cast(bf16x8, w);
}

template <int MODE, int THRL> __device__ __forceinline__ void attn_unit_v2(int b, int h, int qb, const bf16* Q, const bf16* __restrict__ K, const bf16* __restrict__ V, bf16* O, ALAS char* shm, const AttnAux& ax, bool stage) {
  constexpr int KP = MODE == 0 ? 256 : 1024;
  int tid_ = threadIdx.x; asm volatile("" : "+v"(tid_));
  const int tid = tid_, lane = tid & 63, r32 = lane & 31, hi = lane >> 5; const int wid = __builtin_amdgcn_readfirstlane(tid >> 6);
  const int kvh = MODE == 0 ? (h >> 2) : h;
  const long rowbase = 0; const int q0 = qb * QB;
  const int tb = MODE == 0 ? (qb > 0 ? 4 * qb - 2 : 0) : 0; const int NT = 4 * qb + 4 - tb;
  const bf16* Qw = Q + (rowbase + q0 + wid * QBLK) * DM + h * D;
  const bf16* Kh = K + (rowbase + (long)tb * KVBLK) * KP + kvh * D, *Vh = V + (rowbase + (long)tb * KVBLK) * KP + kvh * D;
  const unsigned lds0 = (unsigned)(uintptr_t)shm;
  ALAS float* wsf = (ALAS float*)(shm + LDS_WS) + wid * 64;
  ALAS float* Ef = (ALAS float*)(shm + LDS_E);
  ALAS float* TAB = (ALAS float*)(shm + LDS_TAB);
  ALAS float* OFFS = (ALAS float*)(shm + LDS_OFFS);
  typedef unsigned u32x2_t __attribute__((ext_vector_type(2)));
  ALAS u32x2_t* KX = (ALAS u32x2_t*)(shm + LDS_KX);
  const int kxi = hi == 0 ? r32 : SEQ, kxs = hi == 0 ? 64 : 0, kxh = hi == 0 ? 32 : 0; const unsigned kxc = hi == 0 ? 0x3F803F80u : 0u;
  const bf16* ksrc = Kh + (long)lane * KP + wid * 8;
  const bf16* vsrc = Vh + (long)(16 * (wid & 3) + (lane >> 2)) * KP + (wid >> 2) * 32 + (lane & 3) * 8;
  const unsigned kdst = lds0 + LDS_K + wid * 1024, vdst = lds0 + LDS_V + wid * 1024;
#define DMA_K(t, slot) glds16(ksrc + (long)(t) * KVBLK * KP, (unsigned)__builtin_amdgcn_readfirstlane(kdst + (slot)))
#define DMA_V(t, slot) glds16(vsrc + (long)(t) * KVBLK * KP, (unsigned)__builtin_amdgcn_readfirstlane(vdst + (slot)))
  const int vb0 = (int)(lds0 + LDS_V) + ((lane >> 4) & 1) * 32 + (lane & 3) * 8 + (4 * hi + ((lane & 15) >> 2)) * 64;
  const lds_cptr shm3 = (lds_cptr)shm; const lds_cptr kp0 = shm3 + LDS_K + hi * 1024 + r32 * 16; const lds_cptr vp0 = shm3 + LDS_V + ((lane >> 4) & 1) * 32 + (lane & 3) * 8 + (4 * hi + ((lane & 15) >> 2)) * 64;
  bf16x8 kf[8];
  DMA_K(0, 0); DMA_V(0, 0); DMA_K(1, SLOTB);
  bf16x8 qr[4];
#pragma unroll
  for (int d0 = 0; d0 < 4; ++d0) qr[d0] = *reinterpret_cast<const bf16x8*>(&Qw[(long)r32 * DM + d0 * 16 + hi * 8]);
  const int qrel = wid * QBLK + r32, qg = q0 + qrel;
  bf16x8 qx = bf16x8{};
  if (MODE == 0) {
    for (int i = tid; i < 640; i += 512) { const int dist = i - 256; float v = -INFINITY;
      if (dist >= 0 && dist < 128) v = ax.rel_bias[t5_bucket(dist) * 16 + h] * LOG2E;
      TAB[i] = v; }
  } else if (stage) {
    if (wid == 0) { float v = ax.CT[(size_t)(b * 16 + h) * 32 + (lane & 31)]; if (lane >= 32) v = 0.f; float inc = v;
#pragma unroll
      for (int s = 1; s < 32; s <<= 1) { const float uu = __shfl_up(inc, s); if (lane >= s) inc += uu; }
      if (lane < 32) OFFS[lane] = inc - v; }
    asm volatile("s_waitcnt lgkmcnt(0)\n\ts_barrier" ::: "memory");
    const float* cl = ax.CL + (size_t)(b * 16 + h) * SEQ;
    for (int k = tid; k < SEQ; k += 512) { const float e = -(cl[k] + OFFS[k >> 6]); Ef[k] = e;
      const unsigned a = cvtpk_s(e, 0.f) & 0xffffu; const float r1 = e - __uint_as_float(a << 16);
      const unsigned bb = cvtpk_s(r1, 0.f) & 0xffffu; const float r2 = r1 - __uint_as_float(bb << 16);
      const unsigned c = cvtpk_s(r2, 0.f) & 0xffffu;
      KX[k] = (u32x2_t){a | (bb << 16), c | 0x3F800000u}; }
    if (tid == 0) KX[SEQ] = (u32x2_t){0u, 0u};
  }
  DMA_K(2, 2 * SLOTB);
  WAIT_BAR(3);
  float mhat, l_reg; f32x16 o[2]; o[0] = f32x16{}; o[1] = f32x16{};
  if (MODE == 0) { mhat = ax.sinks[h] * LOG2E; l_reg = hi == 0 ? 1.0f : 0.0f; }
  else { mhat = Ef[qg]; l_reg = 0.f; }
  f32x16 negm = f32x16{};
  if (MODE == 0) {
#pragma unroll
    for (int r = 0; r < 16; ++r) negm[r] = -mhat;
    asm volatile("" : "+v"(negm)); }
  else qx = qx_frag(-mhat, hi);
  bool resc = false;
  u32x2_t ec0 = {0u, 0u}, ec1 = {0u, 0u};
#define MASKB(C0, C1, t) do { if (MODE == 0) { const int ib_ = 256 + qg - 64 * (tb + (t)) - 4 * hi; \
      _Pragma("unroll") for (int r = 0; r < 16; ++r) { const int idx_ = ib_ - ((r & 3) + 8 * (r >> 2)); C0[r] += TAB[idx_]; C1[r] += TAB[idx_ - 32]; } } \
    else { const int jb_ = (t) - (NT - 4); if (jb_ >= 0) cmask(C0, C1, jb_, qrel, hi); } } while (0)
#define DECIDE(C0, C1) do { float a = MX3(C0[0], C0[1], C1[0]), b_ = MX3(C0[2], C0[3], C1[1]); a = MX3(a, C1[2], C1[3]); \
      _Pragma("unroll") for (int r = 4; r < 16; r += 4) { a = MX3(a, C0[r], C0[r + 1]); b_ = MX3(b_, C0[r + 2], C0[r + 3]); a = MX3(a, C1[r], C1[r + 1]); b_ = MX3(b_, C1[r + 2], C1[r + 3]); } \
      float rm = __builtin_fmaxf(a, b_); { auto rr = __builtin_amdgcn_permlane32_swap(__float_as_uint(rm), __float_as_uint(rm), false, false); rm = __builtin_fmaxf(__uint_as_float(rr[0]), __uint_as_float(rr[1])); } \
      resc = false; \
      if (__builtin_expect(__any(rm > (float)THRL), 0)) { const float dl = __builtin_fmaxf(rm, 0.f); mhat += dl; \
        _Pragma("unroll") for (int r = 0; r < 16; ++r) { C0[r] -= dl; C1[r] -= dl; } \
        if (MODE == 0) { _Pragma("unroll") for (int r = 0; r < 16; ++r) negm[r] = -mhat; asm volatile("" : "+v"(negm)); } else qx = qx_frag(-mhat, hi); \
        const float f = __builtin_amdgcn_exp2f(-dl); l_reg *= f; if (hi == 0) wsf[r32] = f; resc = true; } } while (0)
#define RESC() do { if (resc) { asm volatile("s_waitcnt lgkmcnt(0)" ::: "memory"); \
      _Pragma("unroll") for (int d_ = 0; d_ < 2; ++d_) _Pragma("unroll") for (int r = 0; r < 16; ++r) o[d_][r] *= wsf[crow(r, hi)]; } } while (0)
  f32x16 pA0, pA1, pB0, pB1;
  int sl_prev = 0, sl_cur = 0, sl_next = SLOTB;
#define ROT() do { sl_prev = sl_cur; sl_cur = sl_next; sl_next = (sl_next == (NSLOT - 1) * SLOTB) ? 0 : sl_next + SLOTB; } while (0)
  if (MODE == 0) qkt(pA0, pA1, shm3 + LDS_K, qr, negm, r32, hi); else qkt(pA0, pA1, shm3 + LDS_K, qr, f32x16{}, r32, hi);
#define KXF(e) __builtin_bit_cast(bf16x8, (u32x4){(e)[0], (e)[1], kxc, 0u})
  if (MODE == 1) { const u32x2_t e0 = KX[kxi + kxs * tb], e1 = KX[kxi + kxs * tb + kxh];
    pA0 = __builtin_amdgcn_mfma_f32_32x32x16_bf16(KXF(e0), qx, pA0, 0, 0, 0); pA1 = __builtin_amdgcn_mfma_f32_32x32x16_bf16(KXF(e1), qx, pA1, 0, 0, 0);
    ec0 = KX[kxi + kxs * (tb + 1)]; ec1 = KX[kxi + kxs * (tb + 1) + kxh]; }
  MASKB(pA0, pA1, 0);
  DECIDE(pA0, pA1);
#pragma unroll
  for (int r = 0; r < 16; ++r) { pA0[r] = __builtin_amdgcn_exp2f(pA0[r]); pA1[r] = __builtin_amdgcn_exp2f(pA1[r]); }
  WAIT_BAR(0);
  DMA_K(3, 0); DMA_V(1, SLOTB);
  ROT();
  kload8(kf, kp0 + sl_cur);
  WAIT_BAR(2);
  s16x4 vlo[8], vhi[8]; u32x4 pw0, pw1, pw2, pw3;
#define PKW(P, B) cvtpk_s(P[B], P[B + 1])
#define PAF(k) __builtin_bit_cast(bf16x8, pw##k)
#define VFR(i) (bf16x8){vlo[i][0], vlo[i][1], vlo[i][2], vlo[i][3], vhi[i][0], vhi[i][1], vhi[i][2], vhi[i][3]}
#define PIN(x) asm volatile("" : "+v"(x))
#define GAPA(MF, A0, A1, A2, A3, W0, W1, PW) do { MF; sacc += A0; sacc += A1; sacc += A2; sacc += A3; PIN(sacc); W0; W1; PIN(PW); SBAR(); } while (0)
#define EX(v) __builtin_amdgcn_exp2f(v)
#define GAPB(MF, X, B) do { MF; X[B] = EX(X[B]); X[B + 1] = EX(X[B + 1]); X[B + 2] = EX(X[B + 2]); X[B + 3] = EX(X[B + 3]); PIN(X); SBAR(); } while (0)
#define VRD(i) do { vlo[i] = vtr(vp_ + (((i) >> 2) * 4096 + ((i) & 3) * 1024)); vhi[i] = vtr(vp_ + (((i) >> 2) * 4096 + ((i) & 3) * 1024 + 512)); } while (0)
#define KRD(G, j) do { if (G) { kload2(kf, kp0 + sl_next, j); SBAR(); } } while (0)
#define MF32(a, b, c) __builtin_amdgcn_mfma_f32_32x32x16_bf16(a, b, c, 0, 0, 0)
#define CIN (MODE == 0 ? negm : f32x16{})
#define STEP(C0, C1, P0, P1, t, GK, GV, GL) do { SBAR(); \
    const lds_cptr vp_ = vp0 + sl_prev; \
    VRD(0); SBAR(); float sacc = (P0[0] + P0[1]); \
    GAPA(C0 = MF32(kf[0], qr[0], CIN), P0[2], P0[3], P0[4], P0[5],     pw0[0] = PKW(P0, 0), pw0[1] = PKW(P0, 2), pw0); \
    VRD(4); SBAR(); GAPA(C1 = MF32(kf[1], qr[0], CIN), P0[6], P0[7], P0[8], P0[9],     pw0[2] = PKW(P0, 4), pw0[3] = PKW(P0, 6), pw0); \
    VRD(1); SBAR(); GAPA(C0 = MF32(kf[2], qr[1], C0),   P0[10], P0[11], P0[12], P0[13], pw1[0] = PKW(P0, 8), pw1[1] = PKW(P0, 10), pw1); \
    VRD(5); SBAR(); GAPA(C1 = MF32(kf[3], qr[1], C1),   P0[14], P0[15], P1[0], P1[1],   pw1[2] = PKW(P0, 12), pw1[3] = PKW(P0, 14), pw1); \
    VRD(2); SBAR(); GAPA(C0 = MF32(kf[4], qr[2], C0),   P1[2], P1[3], P1[4], P1[5],     pw2[0] = PKW(P1, 0), pw2[1] = PKW(P1, 2), pw2); \
    VRD(6); SBAR(); GAPA(C1 = MF32(kf[5], qr[2], C1),   P1[6], P1[7], P1[8], P1[9],     pw2[2] = PKW(P1, 4), pw2[3] = PKW(P1, 6), pw2); \
    VRD(3); SBAR(); GAPA(C0 = MF32(kf[6], qr[3], C0),   P1[10], P1[11], P1[12], P1[13], pw3[0] = PKW(P1, 8), pw3[1] = PKW(P1, 10), pw3); \
    VRD(7); SBAR(); GAPA(C1 = MF32(kf[7], qr[3], C1),   P1[14], P1[15], 0.f, 0.f,       pw3[2] = PKW(P1, 12), pw3[3] = PKW(P1, 14), pw3); \
    if (MODE == 1) { C0 = MF32(KXF(ec0), qx, C0); C1 = MF32(KXF(ec1), qx, C1); SBAR(); } \
    l_reg += sacc; \
    if (GK) { DMA_K((t) + 3, sl_cur); } if (GV) { DMA_V((t) + 1, sl_next); } \
    MASKB(C0, C1, t); \
    DECIDE(C0, C1); \
    SBAR(); \
    GAPB(o[0] = MF32(PAF(0), VFR(0), o[0]), C0, 0); \
    GAPB(o[1] = MF32(PAF(0), VFR(4), o[1]), C0, 4); \
    KRD(GL, 0); GAPB(o[0] = MF32(PAF(1), VFR(1), o[0]), C0, 8); \
    KRD(GL, 1); GAPB(o[1] = MF32(PAF(1), VFR(5), o[1]), C0, 12); \
    KRD(GL, 2); GAPB(o[0] = MF32(PAF(2), VFR(2), o[0]), C1, 0); \
    KRD(GL, 3); GAPB(o[1] = MF32(PAF(2), VFR(6), o[1]), C1, 4); \
    GAPB(o[0] = MF32(PAF(3), VFR(3), o[0]), C1, 8); \
    GAPB(o[1] = MF32(PAF(3), VFR(7), o[1]), C1, 12); \
    if (MODE == 1 && (GL)) { ec0 = KX[kxi + kxs * (tb + (t) + 1)]; ec1 = KX[kxi + kxs * (tb + (t) + 1) + kxh]; } \
    } while (0)
  int t = 1;
  if (MODE == 1) {
    for (; t + 5 < NT; t += 2) {
      STEP(pB0, pB1, pA0, pA1, t, true, true, true);     WAIT_BAR(2); RESC(); ROT();
      STEP(pA0, pA1, pB0, pB1, t + 1, true, true, true); WAIT_BAR(2); RESC(); ROT();
    }
  }
#define ENDW(tt) do { if ((tt) + 3 < NT) { WAIT_BAR(2); } else if ((tt) + 2 < NT) { WAIT_BAR(1); } else { WAIT_BAR(0); } } while (0)
  for (; t + 1 < NT; t += 2) {
    STEP(pB0, pB1, pA0, pA1, t, (t + 3 < NT), (t + 1 < NT), (t + 1 < NT));       ENDW(t);     RESC(); ROT();
    STEP(pA0, pA1, pB0, pB1, t + 1, (t + 4 < NT), (t + 2 < NT), (t + 2 < NT));   ENDW(t + 1); RESC(); ROT();
  }
  STEP(pB0, pB1, pA0, pA1, NT - 1, false, false, false); RESC();
  { float sacc = pB0[0] + pB0[1];
#pragma unroll
    for (int r = 2; r < 16; ++r) sacc += pB0[r];
#pragma unroll
    for (int r = 0; r < 16; ++r) sacc += pB1[r];
    l_reg += sacc;
    pw0 = (u32x4){PKW(pB0, 0), PKW(pB0, 2), PKW(pB0, 4), PKW(pB0, 6)}; pw1 = (u32x4){PKW(pB0, 8), PKW(pB0, 10), PKW(pB0, 12), PKW(pB0, 14)};
    pw2 = (u32x4){PKW(pB1, 0), PKW(pB1, 2), PKW(pB1, 4), PKW(pB1, 6)}; pw3 = (u32x4){PKW(pB1, 8), PKW(pB1, 10), PKW(pB1, 12), PKW(pB1, 14)};
    SBAR(); pv(o, vb0 + sl_cur, PAF(0), PAF(1), PAF(2), PAF(3)); }
  { auto rr = __builtin_amdgcn_permlane32_swap(__float_as_uint(l_reg), __float_as_uint(l_reg), false, false); l_reg = __uint_as_float(rr[0]) + __uint_as_float(rr[1]); }
  if (hi == 0) wsf[32 + r32] = l_reg;
  asm volatile("s_waitcnt lgkmcnt(0)" ::: "memory");
  float rli[16];
#pragma unroll
  for (int r = 0; r < 16; ++r) rli[r] = __builtin_amdgcn_rcpf(wsf[32 + crow(r, hi)]);
  bf16* Ow = O + (rowbase + q0 + wid * QBLK) * DM + h * D;
  { ALAS bf16* stg = (ALAS bf16*)(shm + LDS_OST) + wid * 2048;
#pragma unroll
    for (int r = 0; r < 16; ++r) { const int orow = crow(r, hi);
#pragma unroll
      for (int d0 = 0; d0 < 2; ++d0) stg[orow * 64 + d0 * 32 + r32] = (bf16)(cvtpk_s(o[d0][r] * rli[r], 0.f) & 0xffffu); }
    asm volatile("s_waitcnt lgkmcnt(0)" ::: "memory");
#pragma unroll
    for (int i = 0; i < 4; ++i) { const int row = i * 8 + (lane >> 3), ch = lane & 7; const u32x4 v = *(const ALAS u32x4*)(stg + row * 64 + ch * 8); *(u32x4*)(Ow + (long)row * DM + ch * 8) = v; } }
  asm volatile("s_waitcnt lgkmcnt(0)\n\ts_barrier" ::: "memory");
#undef DMA_K
#undef DMA_V
#undef MASKB
#undef DECIDE
#undef RESC
#undef ROT
#undef PKW
#undef PAF
#undef VFR
#undef PIN
#undef GAPA
#undef EX
#undef GAPB
#undef VRD
#undef KRD
#undef MF32
#undef CIN
#undef KXF
#undef STEP
#undef ENDW
}
}
#define GAS __attribute__((address_space(1)))
#define LAS __attribute__((address_space(3)))
typedef unsigned short bf16;
typedef unsigned v4u __attribute__((ext_vector_type(4)));
typedef float f32x4 __attribute__((ext_vector_type(4)));
typedef short bf16x8 __attribute__((ext_vector_type(8)));
typedef GAS unsigned gu32;
typedef GAS unsigned long long gu64;
#define RLX_AGENT __ATOMIC_RELAXED, __HIP_MEMORY_SCOPE_AGENT
#define LDS_WAIT() asm volatile("s_waitcnt lgkmcnt(0)" ::: "memory")
#define VM_WAIT() asm volatile("s_waitcnt vmcnt(0)" ::: "memory")
__device__ __forceinline__ unsigned long long rt() { return __builtin_amdgcn_s_memrealtime(); }
__device__ __forceinline__ unsigned f2bf(float f) { unsigned u = __builtin_bit_cast(unsigned, f); return (u + 0x7fffu + ((u >> 16) & 1u)) >> 16; }
__device__ __forceinline__ unsigned pk2(float lo, float hi) { return f2bf(lo) | (f2bf(hi) << 16); }

#define XB_TMO      128
#define XB_XCNT(j)  (256  + 64 * (j))
#define XB_XSUB(j)  (1280 + 64 * (j))
#define XB_XGEN(j)  (2304 + 64 * (j))
#define XB_TOP      3328
#define XB_TOPGEN   3392
#define XCD_BAR_WORDS 3456
#define XB_SPIN_CAP (1u << 18)

__device__ __forceinline__ unsigned xb_ld(unsigned* p)              { return __hip_atomic_load(p, __ATOMIC_RELAXED, __HIP_MEMORY_SCOPE_AGENT); }
__device__ __forceinline__ unsigned xb_add(unsigned* p, unsigned v) { return __hip_atomic_fetch_add(p, v, __ATOMIC_RELAXED, __HIP_MEMORY_SCOPE_AGENT); }
__device__ __forceinline__ unsigned xb_xcc_id() { return (unsigned)__builtin_amdgcn_s_getreg((3 << 11) | 20) & 0xFu; }
#define XB_SPIN(cond, bar) do { unsigned _sp = 0; while (cond) { __builtin_amdgcn_s_sleep(1); \
    if ((++_sp & 255u) == 0u) { if (xb_ld(&(bar)[XB_TMO])) break; if (_sp > XB_SPIN_CAP) { atomicAdd(&(bar)[XB_TMO], 1u); break; } } } } while (0)

struct XcdBarrier {
    unsigned* bar; unsigned x; unsigned G;
    volatile LAS unsigned* st;
};

__device__ __forceinline__ XcdBarrier xcd_barrier_post(unsigned* bar, volatile LAS unsigned* st, unsigned G) {
    XcdBarrier b; b.bar = bar; b.x = xb_xcc_id(); b.st = st; b.G = G;
    if (threadIdx.x == 0) (void)xb_add(&bar[XB_XCNT(b.x)], 1u);
    return b;
}
__device__ __forceinline__ void xcd_barrier_complete(unsigned* bar, unsigned x, unsigned& nloc, unsigned& nx, const unsigned G) {
    unsigned sum, cnt, mine, sp = 0u;
    for (;;) {
        sum = 0u; cnt = 0u; mine = 0u;
#pragma unroll
        for (unsigned j = 0; j < 16; ++j) { const unsigned c = xb_ld(&bar[XB_XCNT(j)]); sum += c; cnt += (c > 0u) ? 1u : 0u; mine = (j == x) ? c : mine; }
        if (sum == G) break;
        __builtin_amdgcn_s_sleep(1);
        if ((++sp & 255u) == 0u) { if (xb_ld(&bar[XB_TMO])) break; if (sp > XB_SPIN_CAP) { atomicAdd(&bar[XB_TMO], 1u); break; } }
    }
    nloc = mine > 0u ? mine : 1u; nx = cnt > 0u ? cnt : 1u;
}

__device__ __forceinline__ void xcd_barrier(const XcdBarrier& b) {
    asm volatile("s_waitcnt vmcnt(0)" ::: "memory");
    __syncthreads();
    if (threadIdx.x == 0) {
        unsigned* bar = b.bar; asm volatile("" : "+s"(bar));
        __builtin_amdgcn_s_waitcnt(0);
        unsigned nloc = b.st[0], nx = b.st[1];
        unsigned bx_ = b.x; asm volatile("" : "+s"(bx_));
        if (nloc == 0u) { xcd_barrier_complete(bar, bx_, nloc, nx, b.G); b.st[0] = nloc; b.st[1] = nx; }
        if (nx == 1u) asm volatile("buffer_inv sc1" ::: "memory");
        const unsigned old = xb_add(&bar[XB_XSUB(bx_)], 1u);
        const unsigned gen = old / nloc;
        if (nx == 1u) {
            const unsigned target = (gen + 1u) * nloc;
            if (old + 1u != target) XB_SPIN((int)(xb_ld(&bar[XB_XSUB(bx_)]) - target) < 0, bar);
            asm volatile("s_waitcnt vmcnt(0)" ::: "memory");
        } else
        if (old + 1u == (gen + 1u) * nloc) {
            if (nx > 1u) __builtin_amdgcn_fence(__ATOMIC_RELEASE, "agent");
            asm volatile("s_waitcnt vmcnt(0)" ::: "memory");
            const unsigned og = xb_add(&bar[XB_TOP], 1u);
            const unsigned tg = og / nx;
            if (og + 1u == (tg + 1u) * nx) xb_add(&bar[XB_TOPGEN], 1u);
            else XB_SPIN(xb_ld(&bar[XB_TOPGEN]) == tg, bar);
            __builtin_amdgcn_fence(__ATOMIC_ACQUIRE, "agent");
            xb_add(&bar[XB_XGEN(bx_)], 1u);
            asm volatile("s_waitcnt vmcnt(0)" ::: "memory");
        } else {
            XB_SPIN(xb_ld(&bar[XB_XGEN(bx_)]) == gen, bar);
            __builtin_amdgcn_fence(__ATOMIC_ACQUIRE, "agent");
            asm volatile("s_waitcnt vmcnt(0)" ::: "memory");
        }
    }
    __syncthreads();
}


constexpr int NWAVES = 8;
constexpr int BATCH = 8, T = 2048, D = 1024, H = 16, HD = 64, FF = 4096, DEPTH = 4;
constexpr int M = BATCH * T;
constexpr int QKV_A = 1536, QKVF_B = 3088, NQKV_B = 3072;
constexpr size_t MiB = 1u << 20;
constexpr size_t WS_CTL = 0, CTL_ZERO_BYTES = 160 * 1024;
constexpr size_t WS_SSQ = 1 * MiB;
constexpr size_t WS_CT = 1 * MiB + 512 * 1024;
constexpr size_t WS_CL = 2 * MiB;
constexpr size_t WS_WF = 3 * MiB;
constexpr size_t WS_W = 4 * MiB;
constexpr size_t WS_XB = 94 * MiB;
constexpr size_t WS_BLK = 128 * MiB, BLK_BYTES = 16 * MiB;
constexpr size_t BLK_K = 4 * MiB, BLK_V = 8 * MiB, BLK_SPARE = 12 * MiB;
constexpr size_t WS_END = 256 * MiB;
__host__ __device__ constexpr size_t layer_w_base(int l) { return WS_W + (size_t)(l == 0 ? 0 : l == 1 ? 21 : l == 2 ? 45 : 66) * MiB; }
__host__ __device__ constexpr size_t layer_qkv_bytes(int l) { return (size_t)((l & 1) ? 6 : 3) * MiB; }
static_assert(layer_w_base(3) + 24 * MiB == WS_XB && WS_XB + 32 * MiB <= WS_BLK && WS_BLK + 8 * BLK_BYTES == WS_END, "ws map");
constexpr int CW_BAR = 4096;
static_assert((size_t)(CW_BAR + 9 * 3456) * 4 <= CTL_ZERO_BYTES && CTL_ZERO_BYTES <= WS_SSQ, "control words inside the per-call memset");
constexpr int RING_OFF = 0, RING_BYTES = 131072;
constexpr int LDSCTL_OFF = RING_BYTES, MISC_OFF = LDSCTL_OFF + 320;
constexpr int LDS_BYTES = 147456;
static_assert(att::LDS_BYTES <= RING_BYTES, "attention scratch inside the ring region");

__device__ __forceinline__ float wave_sum(float v) {
#pragma unroll
    for (int o = 1; o < 64; o <<= 1) v += __shfl_xor(v, o);
    return v;
}
struct TItem { const float* W; const float* gain; bf16* WT; int K, ldw, k0, n0; };
template <bool NT = false> __device__ __forceinline__ void p0_item_load(const TItem& it, f32x4 (&v)[8], float (&g)[8], int lane) {
    const int kq = lane >> 3, c4 = (lane & 7) * 4;
#pragma unroll
    for (int i = 0; i < 8; ++i) { const int kk = i * 8 + kq; v[i] = NT ? __builtin_nontemporal_load((const GAS f32x4*)(it.W + (size_t)(it.k0 + kk) * it.ldw + it.n0 + c4)) : *(const GAS f32x4*)(it.W + (size_t)(it.k0 + kk) * it.ldw + it.n0 + c4); g[i] = it.gain ? it.gain[it.k0 + kk] : 1.0f; }
}
template <bool NT = false> __device__ __forceinline__ void p0_item_store(const TItem& it, const f32x4 (&v)[8], const float (&g)[8], LAS float* scr, int lane) {
    const int kq = lane >> 3, c4 = (lane & 7) * 4;
#pragma unroll
    for (int i = 0; i < 8; ++i) { LAS float* d = scr + (i * 8 + kq) * 33 + c4; d[0] = v[i].x * g[i]; d[1] = v[i].y * g[i]; d[2] = v[i].z * g[i]; d[3] = v[i].w * g[i]; }
    LDS_WAIT(); asm volatile("" ::: "memory");
    const int c = lane & 7;
#pragma unroll
    for (int j = 0; j < 4; ++j) { const int n = (lane >> 3) + 8 * j; const LAS float* s = scr + (8 * c) * 33 + n;
        v4u o; o.x = pk2(s[0 * 33], s[1 * 33]); o.y = pk2(s[2 * 33], s[3 * 33]); o.z = pk2(s[4 * 33], s[5 * 33]); o.w = pk2(s[6 * 33], s[7 * 33]);
        if (NT) __builtin_nontemporal_store(o, (GAS v4u*)(it.WT + (size_t)(it.n0 + n) * it.K + it.k0 + 8 * c)); else *(GAS v4u*)(it.WT + (size_t)(it.n0 + n) * it.K + it.k0 + 8 * c) = o; }
    LDS_WAIT(); asm volatile("" ::: "memory");
}

struct Args { const float* in[15]; float* out; unsigned char* ws; };

#define ARGIN(k) ([&]() -> const float* { int k_ = (k); asm volatile("" : "+s"(k_)); return args.in[k_]; }())
enum { A_X = 0, A_RELB = 1, A_NMIX = 2, A_NMLP = 3, A_WQKVA = 4, A_BQKVA = 5, A_SINKS = 6, A_WOA = 7, A_BOA = 8, A_WQKVFB = 9, A_BFB = 10, A_WOB = 11, A_WUP = 12, A_WDOWN = 13, A_NFIN = 14 };
static_assert(pg8::EP_SSQ == WS_SSQ && pg8::EP_XB == WS_XB && pg8::EP_BLK == WS_BLK && pg8::EP_BLKB == BLK_BYTES && pg8::EP_KOFF == BLK_K && pg8::EP_VOFF == BLK_V, "epilogue workspace offsets");
__global__ void __launch_bounds__(NWAVES * 64, 2) mk_fwd(Args args) {
    extern __shared__ __attribute__((aligned(16))) unsigned char lds[];
    LAS unsigned char* const L = (LAS unsigned char*)lds;
    const int tid = threadIdx.x, lane = tid & 63, wave = __builtin_amdgcn_readfirstlane(tid >> 6);
    const int G = gridDim.x; const int bx = blockIdx.x; const int vcu = (G % 8 == 0) ? (bx % 8) * (G / 8) + bx / 8 : bx;
    unsigned char* const ws = args.ws;
    for (int u = tid; u < (LDS_BYTES - LDSCTL_OFF) / 4; u += NWAVES * 64) ((LAS unsigned*)(L + LDSCTL_OFF))[u] = 0u;
    __syncthreads();
    XcdBarrier bar = xcd_barrier_post((unsigned*)((gu32*)(ws + WS_CTL) + CW_BAR), (volatile LAS unsigned*)(L + MISC_OFF) + 8, (unsigned)G);
    XcdBarrier gbar = xcd_barrier_post((unsigned*)((gu32*)(ws + WS_CTL) + CW_BAR) + (1 + (vcu >> 5)) * XCD_BAR_WORDS, (volatile LAS unsigned*)(L + MISC_OFF) + 10, 32u);
#define GROUP_BAR() do { xcd_barrier(gbar); if (DBL == 4) xcd_barrier(gbar); } while (0)
#ifndef DBL
#define DBL (-1)
#endif
#define GRID_BAR() do { xcd_barrier(bar); if (DBL == 4) xcd_barrier(bar); } while (0)
    const int gw = vcu * NWAVES + wave, NGW = G * NWAVES;

    constexpr int I_QA = (D / 64) * (QKV_A / 32), I_QB = (D / 64) * (NQKV_B / 32), I_O = (D / 64) * (D / 32), I_U = (D / 64) * (FF / 32), I_D = (FF / 64) * (D / 32);
    constexpr int I_LA = I_QA + I_O + I_U + I_D, I_LB = I_QB + I_O + I_U + I_D, NITEMS = 2 * (I_LA + I_LB);
    constexpr int CW_CONV = 1024;
    for (int rep_ = 0; rep_ < (DBL == 0 ? 2 : 1); ++rep_) {
        LAS float* scr = (LAS float*)(L + RING_OFF + wave * 16384);
#define P0_DECODE(it_, T_) do { int r = (it_), l = 0; \
            for (; l < DEPTH; ++l) { const int n_ = (l & 1) ? I_LB : I_LA; if (r < n_) break; r -= n_; } \
            const int j = l >> 1; const bool isb = (l & 1) != 0; unsigned char* wb = ws + layer_w_base(l); const int iq = isb ? I_QB : I_QA; int N_; \
            if (r < iq) { if (isb) { T_.W = ARGIN(A_WQKVFB) + (size_t)j * D * QKVF_B; N_ = NQKV_B; T_.ldw = QKVF_B; } else { T_.W = ARGIN(A_WQKVA) + (size_t)j * D * QKV_A; N_ = QKV_A; T_.ldw = QKV_A; } T_.gain = ARGIN(A_NMIX) + l * D; T_.K = D; } \
            else { r -= iq; wb += layer_qkv_bytes(l); \
              if (r < I_O) { T_.W = ARGIN(isb ? A_WOB : A_WOA) + (size_t)j * D * D; N_ = D; T_.ldw = D; T_.gain = nullptr; T_.K = D; } \
              else { r -= I_O; wb += 2 * MiB; \
                if (r < I_U) { T_.W = ARGIN(A_WUP) + (size_t)l * D * FF; N_ = FF; T_.ldw = FF; T_.gain = ARGIN(A_NMLP) + l * D; T_.K = D; } \
                else { r -= I_U; wb += 8 * MiB; T_.W = ARGIN(A_WDOWN) + (size_t)l * FF * D; N_ = D; T_.ldw = D; T_.gain = nullptr; T_.K = FF; } } } \
            T_.WT = (bf16*)wb; const int nblk_ = N_ / 32; T_.k0 = 64 * (r / nblk_); T_.n0 = 32 * (r % nblk_); } while (0)
#define P0_RUN(IT0_, IT1_, GW_, NGW_) do { f32x4 va[8], vb[8]; float ga[8], gb[8]; TItem ta, tb; const int it1_ = (IT1_), ngw_ = (NGW_); \
            int it = (IT0_) + (GW_); \
            if (it < it1_) { P0_DECODE(it, ta); p0_item_load<true>(ta, va, ga, lane); } \
            for (; it < it1_; it += 2 * ngw_) { \
                const bool hb = it + ngw_ < it1_; \
                if (hb) { P0_DECODE(it + ngw_, tb); p0_item_load<true>(tb, vb, gb, lane); } \
                p0_item_store(ta, va, ga, scr, lane); \
                const bool ha = it + 2 * ngw_ < it1_; \
                if (ha) { P0_DECODE(it + 2 * ngw_, ta); p0_item_load<true>(ta, va, ga, lane); } \
                if (hb) p0_item_store(tb, vb, gb, scr, lane); } } while (0)
#define P0_RUN1(IT0_, IT1_, GW_, NGW_) do { f32x4 va[8]; float ga[8]; TItem ta; const int it1_ = (IT1_), ngw_ = (NGW_); \
            for (int it = (IT0_) + (GW_); it < it1_; it += ngw_) { P0_DECODE(it, ta); p0_item_load<true>(ta, va, ga, lane); p0_item_store<false>(ta, va, ga, scr, lane); } } while (0)
        P0_RUN(0, I_QA, gw, NGW);
        { const float* nm = ARGIN(A_NMIX); const float* wq = ARGIN(A_WQKVFB); bf16* WF = (bf16*)(ws + WS_WF);
          for (int e = gw * 64 + lane; e < 2 * 16 * D; e += NGW * 64) { const int j = e / (16 * D), hh = (e / D) % 16, k = e % D;
            WF[e] = (bf16)f2bf(nm[(2 * j + 1) * D + k] * wq[(size_t)j * D * QKVF_B + (size_t)k * QKVF_B + NQKV_B + hh]); } }
        { const float* x_in = ARGIN(A_X); bf16* XB = (bf16*)(ws + WS_XB); float* SSQ = (float*)(ws + WS_SSQ) + (size_t)4 * M;
          for (int m = gw; m < M; m += NGW) {
            const GAS f32x4* xr = (const GAS f32x4*)(x_in + (size_t)m * D) + lane; GAS unsigned long long* o8 = (GAS unsigned long long*)(XB + (size_t)m * D) + lane;
            float s = 0.f;
#pragma unroll
            for (int jj = 0; jj < 4; ++jj) { const f32x4 v = __builtin_nontemporal_load(xr + 64 * jj); s += (v.x * v.x + v.y * v.y) + (v.z * v.z + v.w * v.w);
                o8[64 * jj] = (unsigned long long)pk2(v.x, v.y) | ((unsigned long long)pk2(v.z, v.w) << 32); }
            s = wave_sum(s);
            if (lane == 0) *(f32x4*)(SSQ + 4 * (size_t)m) = (f32x4){s, 0.f, 0.f, 0.f};
          } }
    }
    GRID_BAR();

#ifdef STAGGER_TICKS
    { const unsigned long long t0_ = __builtin_amdgcn_s_memrealtime(), dl_ = (unsigned long long)(vcu >> 5) * STAGGER_TICKS;
      while (__builtin_amdgcn_s_memrealtime() - t0_ < dl_) __builtin_amdgcn_s_sleep(8); }
#endif
    for (int l = 0; l < DEPTH; ++l) {
        for (int half = 0; half < 2; ++half) {
            const int j = l >> 1; const bool isb = (l & 1) != 0;
            unsigned char* ws = args.ws; asm volatile("" : "+s"(ws));
#define CONV_POLL(k_) do { if (threadIdx.x == 0) { unsigned* cv = (unsigned*)((gu32*)(ws + WS_CTL) + CW_CONV + 64 * (k_)); unsigned* tb_ = (unsigned*)((gu32*)(ws + WS_CTL) + CW_BAR); \
                    XB_SPIN(xb_ld(cv) < 128u, tb_); } } while (0)
            {
                const int N = half ? FF : (isb ? NQKV_B : QKV_A);
                const bf16* Wl = (const bf16*)(ws + layer_w_base(l) + (half ? layer_qkv_bytes(l) + 2 * MiB : 0));
                pg8::Gemm g{(const bf16*)(ws + WS_XB), Wl, M, N, D, (size_t)T * D * 2}; pg8::StaticOrder S; S.init(M, N, G, bx);
                pg8::EpiProj E; E.ws = ws; E.bias = (!half && !isb) ? ARGIN(A_BQKVA) + j * QKV_A : nullptr; E.mode = half ? 2 : (isb ? 1 : 0);
#ifndef NO_G1
                for (int rep_ = 0; rep_ < (DBL == 1 ? 2 : 1); ++rep_)
                pg8::gemm_phase<pg8::EpiProj, pg8::StaticOrder, true, true>(L + RING_OFF, g, S, E);
#endif
            }
            if (!half && !isb && bx >= 128) {
                int tq = threadIdx.x; asm volatile("" : "+v"(tq)); const int lane = tq & 63, wave = __builtin_amdgcn_readfirstlane(tq >> 6);
                LAS float* scr = (LAS float*)(L + RING_OFF + wave * 16384);
                const int it0 = l == 0 ? I_QA : I_LA + I_LB + I_QA, it1 = l == 0 ? I_LA + I_LB + I_QA : NITEMS;
                for (int rep_ = 0; rep_ < (DBL == 9 ? 2 : 1); ++rep_)
                P0_RUN1(it0, it1, (bx - 128) * NWAVES + wave, 128 * NWAVES);
                asm volatile("s_waitcnt vmcnt(0)" ::: "memory"); __syncthreads();
                if (threadIdx.x == 0) { __builtin_amdgcn_fence(__ATOMIC_RELEASE, "agent"); asm volatile("s_waitcnt vmcnt(0)" ::: "memory");
                    xb_add((unsigned*)((gu32*)(ws + WS_CTL) + CW_CONV + 64 * (l >> 1)), 1u); }
            }
            if (!half) {
                if (isb) {
                    int tid = threadIdx.x; asm volatile("" : "+v"(tid)); const int lane = tid & 63;
                    const int R0 = 64 * vcu; const int fr = lane & 15, fq = lane >> 4;
                    for (int rep_ = 0; rep_ < (DBL == 6 ? 2 : 1); ++rep_) if (R0 < M) { if (rep_) { LDS_WAIT(); __builtin_amdgcn_s_barrier(); }
                    const bf16* XB = (const bf16*)(ws + WS_XB); const bf16* WF = (const bf16*)(ws + WS_WF); const float* SSQ = (const float*)(ws + WS_SSQ) + (size_t)4 * M;
                    float* CT = (float*)(ws + WS_CT); float* CL = (float*)(ws + WS_CL); const float* bfb = ARGIN(A_BFB) + j * 16;
                    pg8::f32x4 fa[4];
#pragma unroll
                    for (int gI = 0; gI < 4; ++gI) fa[gI] = (pg8::f32x4){0.f, 0.f, 0.f, 0.f};
                    const bf16* wf = WF + (size_t)j * 16 * D + (size_t)fr * D + 128 * wave + 8 * fq;
                    const bf16* xa = XB + (size_t)(R0 + fr) * D + 128 * wave + 8 * fq;
#pragma unroll
                    for (int ks = 0; ks < 4; ++ks) { const bf16x8 bfr = *(const bf16x8*)(wf + 32 * ks);
#pragma unroll
                        for (int gI = 0; gI < 4; ++gI) { const bf16x8 afr = *(const bf16x8*)(xa + (size_t)(16 * gI) * D + 32 * ks); fa[gI] = __builtin_amdgcn_mfma_f32_16x16x32_bf16(afr, bfr, fa[gI], 0, 0, 0); } }
                    LAS float* part = (LAS float*)(L + RING_OFF);
                    LAS float* lf = (LAS float*)(L + RING_OFF + 32768);
#pragma unroll
                    for (int gI = 0; gI < 4; ++gI)
#pragma unroll
                        for (int e = 0; e < 4; ++e) part[(wave * 64 + 16 * gI + 4 * fq + e) * 16 + fr] = fa[gI][e];
                    LDS_WAIT(); __builtin_amdgcn_s_barrier(); asm volatile("" ::: "memory");
                    for (int e = tid; e < 1024; e += NWAVES * 64) { const int row = e >> 4, hh = e & 15; float s = 0.f;
#pragma unroll
                        for (int w = 0; w < 8; ++w) s += part[(w * 64 + row) * 16 + hh];
                        const float z = s * pg8::row_rstd(SSQ, R0 + row) + bfb[hh];
                        lf[hh * 64 + row] = (fminf(z, 0.f) - log1pf(__expf(-fabsf(z)))) * att::LOG2E; }
                    LDS_WAIT(); __builtin_amdgcn_s_barrier(); asm volatile("" ::: "memory");
                    const int bb = R0 / T, t0 = R0 % T;
#pragma unroll
                    for (int q = 0; q < 2; ++q) { const int hh = 2 * wave + q; const float v = lf[hh * 64 + lane]; float inc = v;
#pragma unroll
                        for (int s = 1; s < 64; s <<= 1) { const float uu = __shfl_up(inc, s); if (lane >= s) inc += uu; }
                        CL[(size_t)(bb * 16 + hh) * T + t0 + lane] = inc;
                        if (lane == 63) CT[(size_t)(bb * 16 + hh) * 32 + (t0 >> 6)] = inc; }
                    }
                }
                GROUP_BAR();
                {
                    att::AttnAux ax; ax.rel_bias = ARGIN(A_RELB); ax.sinks = ARGIN(A_SINKS) + j * 16; ax.CL = (const float*)(ws + WS_CL); ax.CT = (const float*)(ws + WS_CT);
                    const int bh = vcu >> 1; unsigned char* const blk = ws + WS_BLK + (size_t)(bh >> 4) * BLK_BYTES;
                    bf16* const QB_ = (bf16*)blk; const bf16* const KB_ = (const bf16*)(blk + BLK_K); const bf16* const VB_ = (const bf16*)(blk + BLK_V);
                    const int nrep_ = (DBL == 2 || (DBL == 7 && !isb) || (DBL == 8 && isb)) ? 2 : 1;
                    for (int rep_ = 0; rep_ < nrep_; ++rep_) { bf16* const OB_ = (rep_ + 1 < nrep_) ? (bf16*)(blk + BLK_SPARE) : QB_;
                    if (!isb) {
#ifndef NO_SWA
                        att::attn_swa_sweep(bh & 15, vcu & 1, QB_, KB_, VB_, OB_, (LAS char*)(L + RING_OFF), ax);
#endif
                    } else
                    for (int i = 0; i < 4; ++i) {
                        if (isb) { const int s = vcu & 1; const int qb = s == 0 ? (i == 0 ? 7 : i == 1 ? 0 : i == 2 ? 5 : 2) : (i == 0 ? 6 : i == 1 ? 1 : i == 2 ? 4 : 3);

#ifndef NO_FOX
                            att::attn_unit_v2<1, 24>(bh >> 4, bh & 15, qb, QB_, KB_, VB_, OB_, (LAS char*)(L + RING_OFF), ax, i == 0);
#endif
                        }
                        else {
#ifndef NO_SWA
                            att::attn_unit_v1<0>(bh >> 4, bh & 15, (vcu & 1) * 4 + i, QB_, KB_, VB_, OB_, (LAS char*)(L + RING_OFF), ax);
#endif
                        }
                    } }
                }
                if (!isb) CONV_POLL(l >> 1);
                GROUP_BAR();
            } else GROUP_BAR();
            {
                const bf16* Wl = (const bf16*)(ws + layer_w_base(l) + layer_qkv_bytes(l) + (half ? 10 * MiB : 0));
                pg8::Gemm g{(const bf16*)(ws + WS_BLK), Wl, M, D, half ? FF : D, BLK_BYTES}; pg8::StaticOrder S; S.init(M, D, G, bx);
                const bool fin = half && l == DEPTH - 1;
                pg8::EpiRes E; E.ws = ws; E.bias = (!half && !isb) ? ARGIN(A_BOA) + j * D : nullptr; E.sq = half; E.fout = fin ? args.out : nullptr; E.fgain = ARGIN(A_NFIN); E.fbar = &gbar;
#ifndef NO_G2
                pg8::gemm_phase<pg8::EpiRes, pg8::StaticOrder, false, true>(L + RING_OFF, g, S, E);
#endif
            }
            if (half && l + 1 < DEPTH) CONV_POLL(l + 1 == 3 ? 1 : 0);
            if (!(half && l == DEPTH - 1)) GROUP_BAR();
        }
    }
#undef P0_RUN
#undef P0_RUN1
#undef P0_DECODE
#undef CONV_POLL
}

extern "C" void kernel_launch(void* const* d_in, const int* in_sizes, int n_in, void* d_out, int out_size, void* d_ws, size_t ws_size, hipStream_t stream) {
    static int grid = 0;
    if (grid == 0) {
        if (n_in != 15 || in_sizes[0] != M * D || out_size != M * D || ws_size < WS_END) { fprintf(stderr, "kernel_launch: unexpected shapes / workspace (n_in %d, in0 %d, out %d, ws %zu); nothing launched\n", n_in, n_in > 0 ? in_sizes[0] : -1, out_size, ws_size); grid = -1; return; }
        int dev = 0, cus = 0, per_cu = 0;
        if (hipGetDevice(&dev) != hipSuccess || hipDeviceGetAttribute(&cus, hipDeviceAttributeMultiprocessorCount, dev) != hipSuccess) { grid = -1; return; }
        if (hipFuncSetAttribute((const void*)mk_fwd, hipFuncAttributeMaxDynamicSharedMemorySize, LDS_BYTES) != hipSuccess) { fprintf(stderr, "kernel_launch: hipFuncSetAttribute failed\n"); grid = -1; return; }
        if (hipOccupancyMaxActiveBlocksPerMultiprocessor(&per_cu, (const void*)mk_fwd, NWAVES * 64, LDS_BYTES) != hipSuccess || per_cu < 1) { fprintf(stderr, "kernel_launch: occupancy query says %d blocks per CU\n", per_cu); }
        (void)hipGetLastError();
        grid = cus;
        if (grid != 256) { fprintf(stderr, "kernel_launch: built for a 256-CU device, found %d CUs; nothing launched\n", cus); grid = -1; return; }
    }
    if (grid < 0) return;
    if (hipMemsetAsync((char*)d_ws + WS_CTL, 0, CTL_ZERO_BYTES, stream) != hipSuccess) return;
    Args a{};
    for (int i = 0; i < 15; ++i) a.in[i] = (const float*)d_in[i];
    a.out = (float*)d_out; a.ws = (unsigned char*)d_ws;
    hipLaunchKernelGGL(mk_fwd, dim3(grid), dim3(NWAVES * 64), LDS_BYTES, stream, a);
}
```

```cpp
#include <hip/hip_runtime.h>
#include <cstdio>
#include <cstdint>
struct XcdBarrier; __device__ __forceinline__ void xcd_barrier(const XcdBarrier& b);
namespace pg8 {
#define PG8_LAS __attribute__((address_space(3)))
typedef unsigned short bf16_t;
typedef short bf16x8 __attribute__((ext_vector_type(8)));
typedef float f32x4 __attribute__((ext_vector_type(4)));
typedef unsigned u32x4 __attribute__((ext_vector_type(4)));
constexpr int BM = 256, BK = 64, HALF = 128, HTB = HALF * BK * 2  , STAGE_BYTES = 8 * HTB, NXCD = 8, WGM = 8;

__host__ __device__ __forceinline__ int lds_byte(int r, int c) { const int st = (r >> 4) * 2 + (c >> 5), rr = r & 15, cc = c & 31, ob = rr * 64 + cc * 2; return st * 1024 + (ob ^ (((ob >> 9) & 1) << 5)); }
__host__ __device__ __forceinline__ void stage_rc(int b, int& R, int& C) { const int st = b / 1024, sb = b % 1024, swz = sb ^ (((sb >> 9) & 1) << 5); R = (st >> 1) * 16 + swz / 64; C = (st & 1) * 32 + (swz % 64) / 2; }
__host__ __device__ __forceinline__ int perm32(int rho) { const int n = rho >> 4, i = rho & 15; return 8 * (i >> 2) + 4 * n + (i & 3); }

struct Unit { int pm, pn; };
struct Gemm { const bf16_t* A; const bf16_t* Bt; int M, N, K; size_t a_bstride; };

struct StaticOrder {
    int nM, nN, nwg, G, c;
    __host__ __device__ void init(int M, int N, int G_, int c_) { nM = M / BM; nN = N / BM; nwg = nM * nN; G = G_; c = c_; }
    __host__ __device__ bool next(int i, Unit& u) const {
        const long L = (long)i * G + c; if (L >= nwg) return false;
        int wgid = (int)L; { const int q = nwg / NXCD, r = nwg % NXCD, xcd = wgid % NXCD, off = wgid / NXCD; wgid = (xcd < r ? xcd * (q + 1) : r * (q + 1) + (xcd - r) * q) + off; }
        const int nig = WGM * nN, gid = wgid / nig, fm = gid * WGM, gsz = (nM - fm) < WGM ? (nM - fm) : WGM;
        u.pm = fm + ((wgid % nig) % gsz); u.pn = (wgid % nig) / gsz; return true;
    }
    __device__ __forceinline__ void a_ready(const Unit&) const {}
    __device__ __forceinline__ void done(const Unit&) const {}
};

constexpr float RMS_EPS = 1e-6f;
constexpr size_t EP_SSQ = (size_t)1 << 20, EP_XB = (size_t)94 << 20, EP_BLK = (size_t)128 << 20, EP_BLKB = (size_t)16 << 20, EP_KOFF = (size_t)4 << 20, EP_VOFF = (size_t)8 << 20;
constexpr float EP_C2 = 0.125f * 1.4426950408889634f;
typedef unsigned u32x2 __attribute__((ext_vector_type(2)));
__device__ __forceinline__ unsigned cvt_pk_bf16(float lo, float hi) { unsigned r; asm volatile("v_cvt_pk_bf16_f32 %0, %1, %2" : "=v"(r) : "v"(lo), "v"(hi)); return r; }
__device__ __forceinline__ float row_rstd(const float* ssq, int row) { const f32x4 s = *(const f32x4*)(ssq + 4 * (size_t)row); return 1.0f / sqrtf(((s[0] + s[1]) + (s[2] + s[3])) * (1.0f / 1024.0f) + RMS_EPS); }

struct EpiProj {
    static constexpr bool PERM = true, AFTER_DRAIN = false;
    unsigned char* ws; const float* bias; int mode;
    __device__ __forceinline__ void operator()(const f32x4 (&acc)[2][2][4][2], const Unit& u, int wr, int wc, int fr, int fq) const {
        const int row0 = u.pm * BM + wr * 64 + fr, lrow0 = (u.pm & 7) * BM + wr * 64 + fr;
        unsigned char* blk = ws + EP_BLK + (size_t)(u.pm >> 3) * EP_BLKB;
        const float* ssq = (const float*)(ws + EP_SSQ) + (mode == 2 ? (size_t)0 : (size_t)4 * 16384); bf16_t* Q = (bf16_t*)blk; bf16_t* Kp = (bf16_t*)(blk + EP_KOFF); bf16_t* Vp = (bf16_t*)(blk + EP_VOFF);
        const int nq = mode == 2 ? 16 : 4, nk = mode == 0 ? 1 : 4, ldq = mode == 2 ? 4096 : 1024, ldk = mode == 0 ? 256 : 1024, act = mode == 2 ? 1 : 0; const float scale0 = mode == 2 ? 1.0f : EP_C2;
        bf16_t* base; int ld, ct; float sc = 1.f;
        if (u.pn < nq) { base = Q; ld = ldq; ct = u.pn; sc = scale0; } else if (u.pn < nq + nk) { base = Kp; ld = ldk; ct = u.pn - nq; } else { base = Vp; ld = ldk; ct = u.pn - nq - nk; }
        const int col0 = ct * BM + wc * 64 + 8 * fq, bcol0 = u.pn * BM + wc * 64 + 8 * fq;
        f32x4 bv[2][2];
#pragma unroll
        for (int bj = 0; bj < 2; ++bj)
#pragma unroll
            for (int n = 0; n < 2; ++n) bv[bj][n] = bias ? *(const f32x4*)(bias + bcol0 + bj * 32 + 4 * n) : (f32x4){0.f, 0.f, 0.f, 0.f};
        float rs[2][4];
#pragma unroll
        for (int ai = 0; ai < 2; ++ai) {
#pragma unroll
            for (int m = 0; m < 4; ++m) rs[ai][m] = row_rstd(ssq, row0 + ai * HALF + m * 16);
            asm volatile("" ::: "memory"); }
#pragma unroll
        for (int ai = 0; ai < 2; ++ai)
#pragma unroll
            for (int m = 0; m < 4; ++m) { bf16_t* rowp = base + (size_t)(lrow0 + ai * HALF + m * 16) * ld + col0; const float r = rs[ai][m];
#pragma unroll
                for (int bj = 0; bj < 2; ++bj) { f32x4 v0 = acc[ai][bj][m][0] * r + bv[bj][0], v1 = acc[ai][bj][m][1] * r + bv[bj][1];
                    if (act == 1) {
#pragma unroll
                        for (int e = 0; e < 4; ++e) { const float a = fmaxf(v0[e], 0.f), b = fmaxf(v1[e], 0.f); v0[e] = a * a; v1[e] = b * b; } }
                    v0 = v0 * sc; v1 = v1 * sc; u32x4 w; w.x = cvt_pk_bf16(v0[0], v0[1]); w.y = cvt_pk_bf16(v0[2], v0[3]); w.z = cvt_pk_bf16(v1[0], v1[1]); w.w = cvt_pk_bf16(v1[2], v1[3]);
                    *(u32x4*)(rowp + bj * 32) = w; } }
    }
};

struct EpiRes {
    static constexpr bool PERM = true, AFTER_DRAIN = true;
    unsigned char* ws; const float* bias; int sq;
    float* fout; const float* fgain; const XcdBarrier* fbar;
    __device__ __forceinline__ void fused(f32x4 (&acc)[2][2][4][2], const Unit& u, int wr, int wc, int fr, int fq, PG8_LAS unsigned char* lds, int wid, int lane) const {
        bf16_t* xb = (bf16_t*)(ws + EP_XB); float* ssq = (float*)(ws + EP_SSQ) + (sq ? (size_t)4 * 16384 : 0);
        PG8_LAS float* P = (PG8_LAS float*)lds;
        const int col0 = u.pn * BM + wc * 64 + 8 * fq;
        f32x4 bv[2][2];
#pragma unroll
        for (int bj = 0; bj < 2; ++bj)
#pragma unroll
            for (int n = 0; n < 2; ++n) bv[bj][n] = bias ? *(const f32x4*)(bias + col0 + bj * 32 + 4 * n) : (f32x4){0.f, 0.f, 0.f, 0.f};
#pragma unroll
        for (int ai = 0; ai < 2; ++ai)
#pragma unroll
            for (int m = 0; m < 4; ++m) { const int r = ai * HALF + wr * 64 + m * 16 + fr; const size_t off = (size_t)(u.pm * BM + r) * 1024 + col0; float s = 0.f;
#pragma unroll
                for (int bj = 0; bj < 2; ++bj) { const u32x4 b = *(const u32x4*)(xb + off + bj * 32);
                    f32x4 o0 = acc[ai][bj][m][0] + bv[bj][0], o1 = acc[ai][bj][m][1] + bv[bj][1];
                    o0[0] += __uint_as_float(b.x << 16); o0[1] += __uint_as_float(b.x & 0xffff0000u); o0[2] += __uint_as_float(b.y << 16); o0[3] += __uint_as_float(b.y & 0xffff0000u);
                    o1[0] += __uint_as_float(b.z << 16); o1[1] += __uint_as_float(b.z & 0xffff0000u); o1[2] += __uint_as_float(b.w << 16); o1[3] += __uint_as_float(b.w & 0xffff0000u);
                    u32x4 w; w.x = cvt_pk_bf16(o0[0], o0[1]); w.y = cvt_pk_bf16(o0[2], o0[3]); w.z = cvt_pk_bf16(o1[0], o1[1]); w.w = cvt_pk_bf16(o1[2], o1[3]);
                    if (fout) { acc[ai][bj][m][0] = o0; acc[ai][bj][m][1] = o1; } else *(u32x4*)(xb + off + bj * 32) = w;
                    s += ((o0[0] * o0[0] + o0[1] * o0[1]) + (o0[2] * o0[2] + o0[3] * o0[3])) + ((o1[0] * o1[0] + o1[1] * o1[1]) + (o1[2] * o1[2] + o1[3] * o1[3])); }
                s += __shfl_xor(s, 16); s += __shfl_xor(s, 32);
                if (fq == 0) P[r * 4 + wc] = s;
                if (m == 3) asm volatile("" ::: "memory"); }
        asm volatile("s_waitcnt lgkmcnt(0)" ::: "memory"); __builtin_amdgcn_s_barrier(); asm volatile("" ::: "memory");
        const int tid = wid * 64 + lane;
        if (tid < 256) { const f32x4 p = *(const PG8_LAS f32x4*)(P + tid * 4); ssq[(size_t)(u.pm * BM + tid) * 4 + u.pn] = (p[0] + p[1]) + (p[2] + p[3]); }
        if (fout) {
            xcd_barrier(*fbar);
            f32x4 gv[2][2];
#pragma unroll
            for (int bj = 0; bj < 2; ++bj)
#pragma unroll
                for (int n = 0; n < 2; ++n) gv[bj][n] = *(const f32x4*)(fgain + col0 + bj * 32 + 4 * n);
#pragma unroll
            for (int ai = 0; ai < 2; ++ai)
#pragma unroll
                for (int m = 0; m < 4; ++m) { const int row = u.pm * BM + ai * HALF + wr * 64 + m * 16 + fr; const float rs = row_rstd(ssq, row); float* orow = fout + (size_t)row * 1024 + col0;
#pragma unroll
                    for (int bj = 0; bj < 2; ++bj)
#pragma unroll
                        for (int n = 0; n < 2; ++n) *(f32x4*)(orow + bj * 32 + 4 * n) = (acc[ai][bj][m][n] * rs) * gv[bj][n]; }
        }
    }
};

template <class Epi, class Sched, bool ALIGN_EPI = false, bool SP2 = false>
__device__ __forceinline__ void gemm_phase(PG8_LAS unsigned char* lds, const Gemm g, const Sched& S, const Epi& E) {
    int tid_ = threadIdx.x; asm volatile("" : "+v"(tid_));
    const int tid = tid_, wid = __builtin_amdgcn_readfirstlane(tid >> 6), lane = tid & 63, wr = wid >> 2, wc = wid & 3, fr = lane & 15, fq = lane >> 4;
    const int K = g.K, nt = K / BK;
    unsigned voffA[2], voffB[2];
#pragma unroll
    for (int i = 0; i < 2; ++i) { int R, C; stage_rc(tid * 16 + i * 8192, R, C); const int Rb = Epi::PERM ? ((R & ~31) + perm32(R & 31)) : R;
        voffA[i] = (unsigned)(R * K + C) * 2u; voffB[i] = (unsigned)(((Rb >> 5) * 64 + (Rb & 31)) * K + C) * 2u; }
    const size_t kstep = (size_t)(BK * 2);
    const size_t hstep = (size_t)HALF * K * 2;
    const size_t tstep = 2 * hstep;
    const size_t hstepB = (size_t)32 * K * 2;
    const unsigned ldsw = (unsigned)wid * 1024u;
    const int aoff = lds_byte(wr * 64 + fr, fq * 8), boff = lds_byte(wc * 32 + fr, fq * 8);
#define PG8_SA(b, h) (((b) * 2 + (h)) * HTB)
#define PG8_SB(b, h) ((4 + (b) * 2 + (h)) * HTB)
#define PG8_STAGE(bufoff, gbase, voff) do { _Pragma("unroll") for (int _i = 0; _i < 2; ++_i) \
        __builtin_amdgcn_global_load_lds((const unsigned*)((const char*)(gbase) + (voff)[_i]), (PG8_LAS unsigned*)(lds + (bufoff) + ldsw + _i * 8192), 16, 0, 0); } while (0)
#define PG8_LDA(dst, b, h) do { _Pragma("unroll") for (int m = 0; m < 4; ++m) _Pragma("unroll") for (int k = 0; k < 2; ++k) dst[m][k] = *(const PG8_LAS bf16x8*)(lds + PG8_SA(b, h) + aoff + m * 2048 + k * 1024); } while (0)
#define PG8_LDB(dst, b, h) do { _Pragma("unroll") for (int n = 0; n < 2; ++n) _Pragma("unroll") for (int k = 0; k < 2; ++k) dst[n][k] = *(const PG8_LAS bf16x8*)(lds + PG8_SB(b, h) + boff + n * 2048 + k * 1024); } while (0)
#define PG8_MMA(ai, bj, At, Bt) do { __builtin_amdgcn_s_setprio(1); _Pragma("unroll") for (int m = 0; m < 4; ++m) _Pragma("unroll") for (int n = 0; n < 2; ++n) _Pragma("unroll") for (int k = 0; k < 2; ++k) \
        acc[ai][bj][m][n] = __builtin_amdgcn_mfma_f32_16x16x32_bf16(Bt[n][k], At[m][k], acc[ai][bj][m][n], 0, 0, 0); __builtin_amdgcn_s_setprio(0); } while (0)
#define PG8_WAIT_V(n) asm volatile("s_waitcnt vmcnt(" #n ")" ::: "memory")
#define PG8_WAIT_L(n) asm volatile("s_waitcnt lgkmcnt(" #n ")" ::: "memory")
#define PG8_BAR __builtin_amdgcn_s_barrier()
#define PG8_SCHED __builtin_amdgcn_sched_barrier(0)
    Unit cur, nxt; int ui = 0;
    if (!S.next(0, cur)) return;
    f32x4 acc[2][2][4][2];
#pragma unroll
    for (int a = 0; a < 2; ++a)
#pragma unroll
        for (int b = 0; b < 2; ++b)
#pragma unroll
            for (int m = 0; m < 4; ++m)
#pragma unroll
                for (int n = 0; n < 2; ++n) acc[a][b][m][n] = (f32x4){0.f, 0.f, 0.f, 0.f};
    bf16x8 At[4][2], B0[2][2], B1[2][2];
    const char* cA = (const char*)g.A + (size_t)(cur.pm >> 3) * g.a_bstride + (size_t)(cur.pm & 7) * tstep; const char* cB = (const char*)g.Bt + (size_t)cur.pn * tstep;
    S.a_ready(cur);
    if constexpr (SP2) {
        PG8_STAGE(PG8_SB(0, 0), cB, voffB); PG8_STAGE(PG8_SB(0, 1), cB + hstepB, voffB); PG8_STAGE(PG8_SA(0, 0), cA, voffA); PG8_STAGE(PG8_SA(0, 1), cA + hstep, voffA);
        if (wr == 1) PG8_BAR;
        PG8_WAIT_V(2); PG8_BAR;
        PG8_STAGE(PG8_SB(1, 0), cB + kstep, voffB); PG8_STAGE(PG8_SA(1, 0), cA + kstep, voffA); PG8_STAGE(PG8_SB(1, 1), cB + hstepB + kstep, voffB);
        PG8_WAIT_V(6); PG8_BAR;
    } else {
        PG8_STAGE(PG8_SB(0, 0), cB, voffB); PG8_STAGE(PG8_SA(0, 0), cA, voffA); PG8_STAGE(PG8_SB(0, 1), cB + hstepB, voffB); PG8_STAGE(PG8_SA(0, 1), cA + hstep, voffA);
        if (wr == 1) PG8_BAR;
        PG8_WAIT_V(4); PG8_BAR;
        PG8_STAGE(PG8_SB(1, 0), cB + kstep, voffB); PG8_STAGE(PG8_SA(1, 0), cA + kstep, voffA); PG8_STAGE(PG8_SB(1, 1), cB + hstepB + kstep, voffB);
        PG8_WAIT_V(6); PG8_BAR;
    }
    for (;;) {
        const bool has_next = S.next(ui + 1, nxt);
        const char* nA = has_next ? (const char*)g.A + (size_t)(nxt.pm >> 3) * g.a_bstride + (size_t)(nxt.pm & 7) * tstep : cA; const char* nB = has_next ? (const char*)g.Bt + (size_t)nxt.pn * tstep : cB;
        for (int t = 0; t < nt; t += 2) {
            const bool last = (t == nt - 2);
            const char* a1 = cA + (size_t)(t + 1) * kstep;
            const char* a2 = last ? nA : cA + (size_t)(t + 2) * kstep; const char* b2 = last ? nB : cB + (size_t)(t + 2) * kstep;
            const char* a3 = a2 + kstep; const char* b3 = b2 + kstep;
            if (last && has_next) S.a_ready(nxt);
            if constexpr (SP2) {
            PG8_LDB(B0, 0, 0); PG8_LDB(B1, 0, 1); PG8_SCHED; PG8_LDA(At, 0, 0); PG8_STAGE(PG8_SA(1, 1), a1 + hstep, voffA);
            PG8_WAIT_V(8); PG8_WAIT_L(0); PG8_BAR; PG8_MMA(0, 0, At, B0); PG8_MMA(0, 1, At, B1); PG8_BAR; PG8_SCHED;
            PG8_LDA(At, 0, 1); PG8_STAGE(PG8_SB(0, 0), b2, voffB); PG8_STAGE(PG8_SB(0, 1), b2 + hstepB, voffB); PG8_STAGE(PG8_SA(0, 0), a2, voffA);
            PG8_WAIT_V(8); PG8_WAIT_L(0); PG8_BAR; PG8_MMA(1, 0, At, B0); PG8_MMA(1, 1, At, B1); PG8_BAR; PG8_SCHED;
            PG8_LDB(B0, 1, 0); PG8_LDB(B1, 1, 1); PG8_SCHED; PG8_LDA(At, 1, 0); PG8_STAGE(PG8_SA(0, 1), a2 + hstep, voffA);
            PG8_WAIT_V(8); PG8_WAIT_L(0); PG8_BAR; PG8_MMA(0, 0, At, B0); PG8_MMA(0, 1, At, B1); PG8_BAR; PG8_SCHED;
            PG8_LDA(At, 1, 1); PG8_STAGE(PG8_SB(1, 0), b3, voffB); PG8_STAGE(PG8_SB(1, 1), b3 + hstepB, voffB); PG8_STAGE(PG8_SA(1, 0), a3, voffA);
            PG8_WAIT_V(8); PG8_WAIT_L(0); PG8_BAR; PG8_MMA(1, 0, At, B0); PG8_MMA(1, 1, At, B1); PG8_BAR; PG8_SCHED;
            } else {
            PG8_LDB(B0, 0, 0); PG8_SCHED; PG8_LDA(At, 0, 0); PG8_STAGE(PG8_SA(1, 1), a1 + hstep, voffA);
            PG8_WAIT_L(8); PG8_BAR; PG8_WAIT_L(0); PG8_MMA(0, 0, At, B0); PG8_BAR; PG8_SCHED;
            PG8_LDB(B1, 0, 1); PG8_STAGE(PG8_SB(0, 0), b2, voffB);
            PG8_BAR; PG8_WAIT_L(0); PG8_MMA(0, 1, At, B1); PG8_BAR;
            PG8_LDA(At, 0, 1); PG8_STAGE(PG8_SA(0, 0), a2, voffA);
            PG8_BAR; PG8_WAIT_L(0); PG8_MMA(1, 0, At, B0); PG8_BAR; PG8_SCHED;
            PG8_STAGE(PG8_SB(0, 1), b2 + hstepB, voffB);
            PG8_WAIT_V(6); PG8_BAR; PG8_MMA(1, 1, At, B1); PG8_BAR;
            PG8_LDB(B0, 1, 0); PG8_SCHED; PG8_LDA(At, 1, 0); PG8_STAGE(PG8_SA(0, 1), a2 + hstep, voffA);
            PG8_WAIT_L(8); PG8_BAR; PG8_WAIT_L(0); PG8_MMA(0, 0, At, B0); PG8_BAR; PG8_SCHED;
            PG8_LDB(B1, 1, 1); PG8_STAGE(PG8_SB(1, 0), b3, voffB);
            PG8_BAR; PG8_WAIT_L(0); PG8_MMA(0, 1, At, B1); PG8_BAR;
            PG8_LDA(At, 1, 1); PG8_STAGE(PG8_SA(1, 0), a3, voffA);
            PG8_BAR; PG8_WAIT_L(0); PG8_MMA(1, 0, At, B0); PG8_BAR; PG8_SCHED;
            PG8_STAGE(PG8_SB(1, 1), b3 + hstepB, voffB);
            PG8_WAIT_V(6); PG8_BAR; PG8_MMA(1, 1, At, B1); PG8_BAR;
            }
        }
        if constexpr (ALIGN_EPI) { if (wr == 0) PG8_BAR; }
        if constexpr (!Epi::AFTER_DRAIN) { E(acc, cur, wr, wc, fr, fq); S.done(cur); }
        if (!has_next) break;
#pragma unroll
        for (int a = 0; a < 2; ++a)
#pragma unroll
            for (int b = 0; b < 2; ++b)
#pragma unroll
                for (int m = 0; m < 4; ++m)
#pragma unroll
                    for (int n = 0; n < 2; ++n) acc[a][b][m][n] = (f32x4){0.f, 0.f, 0.f, 0.f};
        cur = nxt; cA = nA; cB = nB; ++ui;
        if constexpr (ALIGN_EPI) { if (wr == 1) PG8_BAR; }
    }
    PG8_WAIT_V(0);
    if constexpr (!ALIGN_EPI) { if (wr == 0) PG8_BAR; }
    PG8_BAR;
    if constexpr (Epi::AFTER_DRAIN) { E.fused(acc, cur, wr, wc, fr, fq, lds, wid, lane); S.done(cur); }
#undef PG8_SA
#undef PG8_SB
#undef PG8_STAGE
#undef PG8_LDA
#undef PG8_LDB
#undef PG8_MMA
#undef PG8_WAIT_V
#undef PG8_WAIT_L
#undef PG8_BAR
#undef PG8_SCHED
}
}
#include <cmath>
namespace att {
typedef unsigned short bf16;
using bf16x8 = __attribute__((ext_vector_type(8))) short;
using s16x4 = __attribute__((ext_vector_type(4))) short;
using f32x16 = __attribute__((ext_vector_type(16))) float;
using f32x4 = __attribute__((ext_vector_type(4))) float;
using u32x4 = __attribute__((ext_vector_type(4))) unsigned;
#define ALAS __attribute__((address_space(3)))
constexpr int SEQ = 2048, D = 64, DM = 1024, NW = 8, QBLK = 32, QB = QBLK * NW, KVBLK = 64, NQB = SEQ / QB;
constexpr int NSLOT = 3, SLOTB = 8192;
constexpr int LDS_K = 0, LDS_V = NSLOT * SLOTB, LDS_WS = 2 * NSLOT * SLOTB, LDS_OST = LDS_WS + NW * 64 * 4, LDS_E = LDS_OST + NW * 4096  , LDS_TAB = LDS_E + 2048 * 4  , LDS_OFFS = LDS_TAB + 640 * 4, LDS_KX = LDS_OFFS + 512  , LDS_BYTES = LDS_KX + 2048 * 8 + 16;
constexpr float LOG2E = 1.4426950408889634f;
constexpr float C2 = 0.125f * LOG2E;
__device__ __forceinline__ int crow(int r, int hi) { return (r & 3) + 8 * (r >> 2) + 4 * hi; }
#define SBAR() __builtin_amdgcn_sched_barrier(0)
__device__ __forceinline__ void glds16(const void* gsrc, unsigned lds_dst) { unsigned keep;
  asm volatile("s_mov_b32 %0, m0\n\ts_mov_b32 m0, %2\n\ts_nop 0\n\tglobal_load_lds_dwordx4 %1, off\n\ts_mov_b32 m0, %0" : "=&s"(keep) : "v"(gsrc), "s"(lds_dst) : "memory"); }
typedef float f32x2_t __attribute__((ext_vector_type(2))); typedef __bf16 bf16x2_t __attribute__((ext_vector_type(2)));
__device__ __forceinline__ unsigned cvtpk_s(float lo, float hi) { f32x2_t v = {lo, hi}; bf16x2_t b = __builtin_convertvector(v, bf16x2_t); return __builtin_bit_cast(unsigned, b); }
#define WAIT_BAR(N) asm volatile("s_waitcnt vmcnt(" #N ") lgkmcnt(0)\n\ts_barrier" ::: "memory")
typedef ALAS const char* lds_cptr;
typedef short v4i16_t __attribute__((ext_vector_type(4)));
#define MX3(a, b, c) __builtin_fmaxf(__builtin_fmaxf((a), (b)), (c))
__device__ __forceinline__ float rowmax(const f32x16& p0, const f32x16& p1) {
  float a = MX3(p0[0], p0[1], p1[0]), b = MX3(p0[2], p0[3], p1[1]); a = MX3(a, p1[2], p1[3]);
#pragma unroll
  for (int r = 4; r < 16; r += 4) { a = MX3(a, p0[r], p0[r + 1]); b = MX3(b, p0[r + 2], p0[r + 3]); a = MX3(a, p1[r], p1[r + 1]); b = MX3(b, p1[r + 2], p1[r + 3]); }
  float m = __builtin_fmaxf(a, b); auto rr = __builtin_amdgcn_permlane32_swap(__float_as_uint(m), __float_as_uint(m), false, false);
  return __builtin_fmaxf(__uint_as_float(rr[0]), __uint_as_float(rr[1])); }
__device__ __forceinline__ void qkt(f32x16& p0, f32x16& p1, lds_cptr Kslot, const bf16x8* qr, const f32x16& cin, int r32, int hi) {
  lds_cptr kb = Kslot + hi * 1024 + r32 * 16;
#pragma unroll
  for (int d0 = 0; d0 < 4; ++d0) {
    const bf16x8 b0 = *(const ALAS bf16x8*)(kb + d0 * 2048);
    const bf16x8 b1 = *(const ALAS bf16x8*)(kb + d0 * 2048 + 512);
    if (d0 == 0) { p0 = __builtin_amdgcn_mfma_f32_32x32x16_bf16(b0, qr[0], cin, 0, 0, 0); p1 = __builtin_amdgcn_mfma_f32_32x32x16_bf16(b1, qr[0], cin, 0, 0, 0); }
    else { p0 = __builtin_amdgcn_mfma_f32_32x32x16_bf16(b0, qr[d0], p0, 0, 0, 0); p1 = __builtin_amdgcn_mfma_f32_32x32x16_bf16(b1, qr[d0], p1, 0, 0, 0); } }
}
__device__ __forceinline__ void pv(f32x16* o, int vb, bf16x8 pa0, bf16x8 pa1, bf16x8 pa2, bf16x8 pa3) {
#pragma unroll
  for (int d0 = 0; d0 < 2; ++d0) { s16x4 lo[4], hi[4];
#pragma unroll
    for (int ks = 0; ks < 4; ++ks) {
      asm volatile("ds_read_b64_tr_b16 %0,%1 offset:%c2" : "=&v"(lo[ks]) : "v"(vb), "i"(d0 * 4096 + ks * 1024) : "memory");
      asm volatile("ds_read_b64_tr_b16 %0,%1 offset:%c2" : "=&v"(hi[ks]) : "v"(vb), "i"(d0 * 4096 + ks * 1024 + 512) : "memory"); }
    asm volatile("s_waitcnt lgkmcnt(0)" ::: "memory"); SBAR();
#define PK(k) (bf16x8){lo[k][0], lo[k][1], lo[k][2], lo[k][3], hi[k][0], hi[k][1], hi[k][2], hi[k][3]}
    o[d0] = __builtin_amdgcn_mfma_f32_32x32x16_bf16(pa0, PK(0), o[d0], 0, 0, 0);
    o[d0] = __builtin_amdgcn_mfma_f32_32x32x16_bf16(pa1, PK(1), o[d0], 0, 0, 0);
    o[d0] = __builtin_amdgcn_mfma_f32_32x32x16_bf16(pa2, PK(2), o[d0], 0, 0, 0);
    o[d0] = __builtin_amdgcn_mfma_f32_32x32x16_bf16(pa3, PK(3), o[d0], 0, 0, 0);
#undef PK
  }
}
__device__ __forceinline__ int t5_bucket(int d) {
  if (d < 16) return d;
  const int b = 16 + (int)(__logf((float)d * (1.0f / 16.0f)) * (16.0f / 2.0794415416798357f));
  return b < 31 ? b : 31;
}
struct AttnAux { const float* rel_bias; const float* sinks; const float* CL; const float* CT; };

template <int MODE> __device__ __forceinline__ void attn_unit_v1(int b, int h, int qb, const bf16* Q, const bf16* __restrict__ K, const bf16* __restrict__ V, bf16* O, ALAS char* shm, const AttnAux& ax) {
  constexpr int KP = MODE == 0 ? 256 : 1024;
  int tid_ = threadIdx.x; asm volatile("" : "+v"(tid_));
  const int tid = tid_, lane = tid & 63, r32 = lane & 31, hi = lane >> 5; const int wid = __builtin_amdgcn_readfirstlane(tid >> 6);
  const int kvh = MODE == 0 ? (h >> 2) : h;
  const long rowbase = 0; const int q0 = qb * QB;
  const bf16* Qw = Q + (rowbase + q0 + wid * QBLK) * DM + h * D;
  const bf16* Kh = K + rowbase * KP + kvh * D, *Vh = V + rowbase * KP + kvh * D;
  const unsigned lds0 = (unsigned)(uintptr_t)shm;
  ALAS float* wsf = (ALAS float*)(shm + LDS_WS) + wid * 64;
  ALAS float* Ef = (ALAS float*)(shm + LDS_E);
  ALAS float* TAB = (ALAS float*)(shm + LDS_TAB);
  ALAS float* OFFS = (ALAS float*)(shm + LDS_OFFS);
  const bf16* ksrc = Kh + (long)lane * KP + wid * 8;
  const bf16* vsrc = Vh + (long)(16 * (wid & 3) + (lane >> 2)) * KP + (wid >> 2) * 32 + (lane & 3) * 8;
  const unsigned kdst = lds0 + LDS_K + wid * 1024, vdst = lds0 + LDS_V + wid * 1024;
#define DMA_K(t, slot) glds16(ksrc + (long)(t) * KVBLK * KP, (unsigned)__builtin_amdgcn_readfirstlane(kdst + (slot)))
#define DMA_V(t, slot) glds16(vsrc + (long)(t) * KVBLK * KP, (unsigned)__builtin_amdgcn_readfirstlane(vdst + (slot)))
  const int vb0 = (int)(lds0 + LDS_V) + ((lane >> 4) & 1) * 32 + (lane & 3) * 8 + (4 * hi + ((lane & 15) >> 2)) * 64;
  const lds_cptr Kbase = (lds_cptr)shm + LDS_K;
  const int t_lo = MODE == 0 ? (qb > 0 ? 4 * qb - 2 : 0) : 0, t_hi = 4 * qb + 3;
  bf16x8 qr[4];
#pragma unroll
  for (int d0 = 0; d0 < 4; ++d0) qr[d0] = *reinterpret_cast<const bf16x8*>(&Qw[(long)r32 * DM + d0 * 16 + hi * 8]);
  float mhat, l_reg; f32x16 o[2]; o[0] = f32x16{}; o[1] = f32x16{};
  const int qg = q0 + wid * QBLK + r32;
  bf16x8 qx = bf16x8{};
  if (MODE == 0) {
    { const int dist = tid - 256; float v = -INFINITY;
      if (dist >= 0 && dist < 128) v = ax.rel_bias[t5_bucket(dist) * 16 + h] * LOG2E;
      TAB[tid] = v; if (tid < 128) TAB[512 + tid] = -INFINITY; }
    mhat = ax.sinks[h] * LOG2E; l_reg = hi == 0 ? 1.0f : 0.0f;
  } else {
    if (wid == 0) { float v = (lane <= t_hi) ? ax.CT[(size_t)(b * 16 + h) * 32 + (lane & 31)] : 0.f; if (lane >= 32) v = 0.f; float inc = v;
#pragma unroll
      for (int s = 1; s < 32; s <<= 1) { const float uu = __shfl_up(inc, s); if (lane >= s) inc += uu; }
      if (lane < 32) OFFS[lane] = inc - v; }
    asm volatile("s_waitcnt lgkmcnt(0)\n\ts_barrier" ::: "memory");
    const float* cl = ax.CL + (size_t)(b * 16 + h) * SEQ;
    for (int k = tid; k < (t_hi + 1) * 64; k += 512) Ef[k] = -(cl[k] + OFFS[k >> 6]);
    mhat = -INFINITY; l_reg = 0.f;
    if (hi == 0) { qx[0] = 0x3F80; qx[1] = 0x3F80; qx[2] = 0x3F80; }
  }
  f32x16 zero16 = f32x16{}; asm volatile("" : "+v"(zero16));
  DMA_K(t_lo, 0); DMA_V(t_lo, 0);
  for (int t = t_lo; t <= t_hi; ++t) {
    const int sl = ((t - t_lo) & 1) * SLOTB;
    WAIT_BAR(0);
    if (t < t_hi) { DMA_K(t + 1, sl ^ SLOTB); DMA_V(t + 1, sl ^ SLOTB); }
    if (MODE == 0) {
      const int qw = q0 + wid * QBLK;
      if (64 * t > qw + 31 || 64 * t + 63 < qw - 127) continue;
    }
    f32x16 p0, p1;
    qkt(p0, p1, Kbase + sl, qr, zero16, r32, hi);
    if (MODE == 1) {
      bf16x8 kx0 = bf16x8{}, kx1 = bf16x8{};
      const float e0 = Ef[64 * t + r32], e1 = Ef[64 * t + 32 + r32];
      if (hi == 0) {
        { const unsigned a = cvtpk_s(e0, 0.f) & 0xffffu; const float r1 = e0 - __uint_as_float(a << 16); const unsigned bb = cvtpk_s(r1, 0.f) & 0xffffu; const float r2 = r1 - __uint_as_float(bb << 16); const unsigned c = cvtpk_s(r2, 0.f) & 0xffffu;
          kx0[0] = (short)a; kx0[1] = (short)bb; kx0[2] = (short)c; }
        { const unsigned a = cvtpk_s(e1, 0.f) & 0xffffu; const float r1 = e1 - __uint_as_float(a << 16); const unsigned bb = cvtpk_s(r1, 0.f) & 0xffffu; const float r2 = r1 - __uint_as_float(bb << 16); const unsigned c = cvtpk_s(r2, 0.f) & 0xffffu;
          kx1[0] = (short)a; kx1[1] = (short)bb; kx1[2] = (short)c; }
      }
      p0 = __builtin_amdgcn_mfma_f32_32x32x16_bf16(kx0, qx, p0, 0, 0, 0); p1 = __builtin_amdgcn_mfma_f32_32x32x16_bf16(kx1, qx, p1, 0, 0, 0);
      if (t >= 4 * qb) {
        const int kb = 64 * t + 4 * hi;
#pragma unroll
        for (int r = 0; r < 16; ++r) { const int kv = kb + (r & 3) + 8 * (r >> 2); if (kv > qg) p0[r] = -INFINITY; if (kv + 32 > qg) p1[r] = -INFINITY; }
      }
    } else {
      const int ib = 256 + qg - 64 * t - 4 * hi;
#pragma unroll
      for (int g = 0; g < 4; ++g) { const int idx = ib - 8 * g; f32x4 t0 = {TAB[idx], TAB[idx - 1], TAB[idx - 2], TAB[idx - 3]}, t1 = {TAB[idx - 32], TAB[idx - 33], TAB[idx - 34], TAB[idx - 35]};
        asm volatile("" : "+v"(t0), "+v"(t1));
#pragma unroll
        for (int e = 0; e < 4; ++e) { p0[4 * g + e] += t0[e]; p1[4 * g + e] += t1[e]; } }
    }
    const float rm = rowmax(p0, p1);
    const float mn = __builtin_fmaxf(mhat, rm), f = __builtin_amdgcn_exp2f(mhat - mn); mhat = mn;
    float sacc = 0.f;
#pragma unroll
    for (int r = 0; r < 16; ++r) { p0[r] = __builtin_amdgcn_exp2f(p0[r] - mn); p1[r] = __builtin_amdgcn_exp2f(p1[r] - mn); sacc += p0[r] + p1[r]; }
    l_reg = l_reg * f + sacc;
    if (hi == 0) wsf[r32] = f;
    asm volatile("s_waitcnt lgkmcnt(0)" ::: "memory");
#pragma unroll
    for (int d_ = 0; d_ < 2; ++d_)
#pragma unroll
      for (int r = 0; r < 16; ++r) o[d_][r] *= wsf[crow(r, hi)];
    u32x4 pw0, pw1, pw2, pw3;
#define PKW(P, B) cvtpk_s(P[B], P[B + 1])
    pw0 = (u32x4){PKW(p0, 0), PKW(p0, 2), PKW(p0, 4), PKW(p0, 6)}; pw1 = (u32x4){PKW(p0, 8), PKW(p0, 10), PKW(p0, 12), PKW(p0, 14)};
    pw2 = (u32x4){PKW(p1, 0), PKW(p1, 2), PKW(p1, 4), PKW(p1, 6)}; pw3 = (u32x4){PKW(p1, 8), PKW(p1, 10), PKW(p1, 12), PKW(p1, 14)};
#undef PKW
    SBAR(); pv(o, vb0 + sl, __builtin_bit_cast(bf16x8, pw0), __builtin_bit_cast(bf16x8, pw1), __builtin_bit_cast(bf16x8, pw2), __builtin_bit_cast(bf16x8, pw3));
  }
  { auto rr = __builtin_amdgcn_permlane32_swap(__float_as_uint(l_reg), __float_as_uint(l_reg), false, false); l_reg = __uint_as_float(rr[0]) + __uint_as_float(rr[1]); }
  if (hi == 0) wsf[32 + r32] = l_reg;
  asm volatile("s_waitcnt lgkmcnt(0)" ::: "memory");
  float rli[16];
#pragma unroll
  for (int r = 0; r < 16; ++r) rli[r] = __builtin_amdgcn_rcpf(wsf[32 + crow(r, hi)]);
  bf16* Ow = O + (rowbase + q0 + wid * QBLK) * DM + h * D;
  { ALAS bf16* stg = (ALAS bf16*)(shm + LDS_OST) + wid * 2048;
#pragma unroll
    for (int r = 0; r < 16; ++r) { const int orow = crow(r, hi);
#pragma unroll
      for (int d0 = 0; d0 < 2; ++d0) stg[orow * 64 + d0 * 32 + r32] = (bf16)(cvtpk_s(o[d0][r] * rli[r], 0.f) & 0xffffu); }
    asm volatile("s_waitcnt lgkmcnt(0)" ::: "memory");
#pragma unroll
    for (int i = 0; i < 4; ++i) { const int row = i * 8 + (lane >> 3), ch = lane & 7; const u32x4 v = *(const ALAS u32x4*)(stg + row * 64 + ch * 8); *(u32x4*)(Ow + (long)row * DM + ch * 8) = v; } }
  asm volatile("s_waitcnt lgkmcnt(0)\n\ts_barrier" ::: "memory");
#undef DMA_K
#undef DMA_V
}

__device__ __forceinline__ void attn_swa_sweep(int h, int half, const bf16* Q, const bf16* __restrict__ K, const bf16* __restrict__ V, bf16* O, ALAS char* shm, const AttnAux& ax) {
  constexpr int KP = 256, NS = 4, NPAIR = 9;
  constexpr int S_K = 0, S_V = NS * SLOTB, S_WS = 2 * NS * SLOTB, S_QST = S_WS + NW * 64 * 4, S_OST = S_QST + NW * 4096, S_TAB = S_OST + NW * 1024;
  static_assert(S_TAB + 640 * 4 <= 131072, "sweep scratch inside the 128 KiB ring region");
  int tid_ = threadIdx.x; asm volatile("" : "+v"(tid_));
  const int tid = tid_, lane = tid & 63, r32 = lane & 31, hi = lane >> 5; const int wid = __builtin_amdgcn_readfirstlane(tid >> 6);
  const int kvh = h >> 2, R0 = 1024 * half, T0 = R0 / 64 - 2;
  const int j0 = (wid & 1) | ((wid & 2) << 1) | ((wid & 4) >> 1), a0 = j0 >> 2; const bool kodd = ((j0 >> 1) & 1) != 0;
  const bf16* Kh = K + kvh * D, *Vh = V + kvh * D;
  const unsigned lds0 = (unsigned)(uintptr_t)shm;
  ALAS float* wsf = (ALAS float*)(shm + S_WS) + wid * 64;
  ALAS float* TAB = (ALAS float*)(shm + S_TAB);
  const bf16* ksrc = Kh + (long)lane * KP + wid * 8;
  const bf16* vsrc = Vh + (long)(16 * (wid & 3) + (lane >> 2)) * KP + (wid >> 2) * 32 + (lane & 3) * 8;
  const unsigned kdst = lds0 + S_K + wid * 1024, vdst = lds0 + S_V + wid * 1024;
#define DMA_KV(s_) do { const int t__ = T0 + (s_) < 0 ? 0 : T0 + (s_); const int sl__ = ((s_) & (NS - 1)) * SLOTB; glds16(ksrc + (long)t__ * KVBLK * KP, (unsigned)__builtin_amdgcn_readfirstlane(kdst + sl__)); \
                        glds16(vsrc + (long)t__ * KVBLK * KP, (unsigned)__builtin_amdgcn_readfirstlane(vdst + sl__)); } while (0)
  const int vb0 = (int)(lds0 + S_V) + ((lane >> 4) & 1) * 32 + (lane & 3) * 8 + (4 * hi + ((lane & 15) >> 2)) * 64;
  const lds_cptr Kbase = (lds_cptr)shm + S_K;
  const bf16* qsrc = Q + (long)(R0 + 32 * j0 + (lane >> 3)) * DM + h * D + (((lane & 7) ^ ((lane >> 3) & 7)) * 8);
  const unsigned qdst = lds0 + S_QST + wid * 4096;
#define QDMA(blk) do { const bf16* q__ = qsrc + (long)(blk) * 256 * DM; \
    glds16(q__, (unsigned)__builtin_amdgcn_readfirstlane(qdst)); glds16(q__ + 8 * DM, (unsigned)__builtin_amdgcn_readfirstlane(qdst + 1024)); \
    glds16(q__ + 16 * DM, (unsigned)__builtin_amdgcn_readfirstlane(qdst + 2048)); glds16(q__ + 24 * DM, (unsigned)__builtin_amdgcn_readfirstlane(qdst + 3072)); } while (0)
  const lds_cptr qrd = (lds_cptr)shm + S_QST + wid * 4096 + r32 * 128;
  asm volatile("s_waitcnt lgkmcnt(0)\n\ts_barrier" ::: "memory");
  QDMA(0); DMA_KV(0); DMA_KV(1);
  { const int dist = tid - 256; float v = -INFINITY;
    if (dist >= 0 && dist < 128) v = ax.rel_bias[t5_bucket(dist) * 16 + h] * LOG2E;
    TAB[tid] = v; if (tid < 128) TAB[512 + tid] = -INFINITY; }
  const float sink2 = ax.sinks[h] * LOG2E;
  bf16* Ow = O + (long)(R0 + 32 * j0) * DM + h * D;
  bf16x8 qr[4]; qr[0] = bf16x8{}; qr[1] = bf16x8{}; qr[2] = bf16x8{}; qr[3] = bf16x8{};
  float mhat = 0.f, l_reg = 0.f; f32x16 o[2]; o[0] = f32x16{}; o[1] = f32x16{}; int qg = 0;
  f32x16 zero16 = f32x16{}; asm volatile("" : "+v"(zero16));
  for (int P = 0; P <= NPAIR; ++P) {
    if (P < NPAIR) {
      asm volatile("s_waitcnt vmcnt(0) lgkmcnt(0)\n\ts_barrier" ::: "memory");
      if (P + 1 < NPAIR) { DMA_KV(2 * P + 2); DMA_KV(2 * P + 3); }
    }
    const int q = P - a0;
    if (q < 0 || q > 8) continue;
    const bool second = (q & 1) != 0;
    if (!second) {
      if (q >= 2) {
        const int u = (q >> 1) - 1;
        { auto rr = __builtin_amdgcn_permlane32_swap(__float_as_uint(l_reg), __float_as_uint(l_reg), false, false); l_reg = __uint_as_float(rr[0]) + __uint_as_float(rr[1]); }
        if (hi == 0) wsf[32 + r32] = l_reg;
        asm volatile("s_waitcnt lgkmcnt(0)" ::: "memory");
        ALAS bf16* stg = (ALAS bf16*)(shm + S_OST) + wid * 512;
        bf16* Ob = Ow + (long)u * 256 * DM + (long)(lane >> 3) * DM + (lane & 7) * 8;
#pragma unroll
        for (int i = 0; i < 4; ++i) {
#pragma unroll
          for (int rr = 0; rr < 4; ++rr) { const int r = 4 * i + rr; const float rl = __builtin_amdgcn_rcpf(wsf[32 + crow(r, hi)]);
#pragma unroll
            for (int d0 = 0; d0 < 2; ++d0) stg[(rr + 4 * hi) * 64 + d0 * 32 + r32] = (bf16)(cvtpk_s(o[d0][r] * rl, 0.f) & 0xffffu); }
          asm volatile("s_waitcnt lgkmcnt(0)" ::: "memory");
          const u32x4 v = *(const ALAS u32x4*)(stg + lane * 8);
          asm volatile("s_waitcnt lgkmcnt(0)" ::: "memory");
          *(u32x4*)(Ob + (long)(8 * i) * DM) = v;
        }
      }
      if (q == 8) continue;
      const int u = q >> 1;
#pragma unroll
      for (int d0 = 0; d0 < 4; ++d0) qr[d0] = *(const ALAS bf16x8*)(qrd + (((2 * d0 + hi) ^ (r32 & 7)) * 16));
      asm volatile("s_waitcnt lgkmcnt(0)" ::: "memory");
      if (u < 3) QDMA(u + 1);
      mhat = sink2; l_reg = hi == 0 ? 1.0f : 0.0f; o[0] = f32x16{}; o[1] = f32x16{};
      qg = R0 + 32 * (j0 + 8 * u) + r32;
    }
    for (int e = 0; e < 2; ++e) {
      if (e == 0 ? (kodd && !second) : (!kodd && second)) continue;
      const int s = 2 * P + e, t = T0 + s;
      if (t < 0) continue;
      const int sl = (s & (NS - 1)) * SLOTB;
      f32x16 p0, p1;
      { const int ib = 256 + qg - 64 * t - 4 * hi;
#pragma unroll
        for (int g = 0; g < 4; ++g) { const int idx = ib - 8 * g; f32x4 t0 = {TAB[idx], TAB[idx - 1], TAB[idx - 2], TAB[idx - 3]}, t1 = {TAB[idx - 32], TAB[idx - 33], TAB[idx - 34], TAB[idx - 35]};
          asm volatile("" : "+v"(t0), "+v"(t1));
#pragma unroll
          for (int ee = 0; ee < 4; ++ee) { p0[4 * g + ee] = t0[ee] - mhat; p1[4 * g + ee] = t1[ee] - mhat; } } }
      { lds_cptr kb = Kbase + sl + hi * 1024 + r32 * 16;
#pragma unroll
        for (int d0 = 0; d0 < 4; ++d0) { const bf16x8 b0 = *(const ALAS bf16x8*)(kb + d0 * 2048), b1 = *(const ALAS bf16x8*)(kb + d0 * 2048 + 512);
          p0 = __builtin_amdgcn_mfma_f32_32x32x16_bf16(b0, qr[d0], p0, 0, 0, 0); p1 = __builtin_amdgcn_mfma_f32_32x32x16_bf16(b1, qr[d0], p1, 0, 0, 0); } }
      const float rm = rowmax(p0, p1);
      const bool mv = rm > 8.0f;
      if (__builtin_expect(__any(mv), 0)) {
        const float dl = mv ? rm : 0.f, f = __builtin_amdgcn_exp2f(-dl); mhat += dl;
#pragma unroll
        for (int r = 0; r < 16; ++r) { p0[r] -= dl; p1[r] -= dl; }
        l_reg *= f;
        if (hi == 0) wsf[r32] = f;
        asm volatile("s_waitcnt lgkmcnt(0)" ::: "memory");
#pragma unroll
        for (int d_ = 0; d_ < 2; ++d_)
#pragma unroll
          for (int r = 0; r < 16; ++r) o[d_][r] *= wsf[crow(r, hi)];
      }
      float sa0 = 0.f, sa1 = 0.f;
#pragma unroll
      for (int r = 0; r < 16; ++r) { p0[r] = __builtin_amdgcn_exp2f(p0[r]); p1[r] = __builtin_amdgcn_exp2f(p1[r]); sa0 += p0[r]; sa1 += p1[r]; }
      l_reg += sa0 + sa1;
      u32x4 pw0, pw1, pw2, pw3;
#define PKW(P_, B) cvtpk_s(P_[B], P_[B + 1])
      pw0 = (u32x4){PKW(p0, 0), PKW(p0, 2), PKW(p0, 4), PKW(p0, 6)}; pw1 = (u32x4){PKW(p0, 8), PKW(p0, 10), PKW(p0, 12), PKW(p0, 14)};
      pw2 = (u32x4){PKW(p1, 0), PKW(p1, 2), PKW(p1, 4), PKW(p1, 6)}; pw3 = (u32x4){PKW(p1, 8), PKW(p1, 10), PKW(p1, 12), PKW(p1, 14)};
#undef PKW
      SBAR(); pv(o, vb0 + sl, __builtin_bit_cast(bf16x8, pw0), __builtin_bit_cast(bf16x8, pw1), __builtin_bit_cast(bf16x8, pw2), __builtin_bit_cast(bf16x8, pw3));
    }
  }
#undef DMA_KV
#undef QDMA
}

__device__ __forceinline__ void kload8(bf16x8* kf, lds_cptr kp) {
  kf[0] = *(const ALAS bf16x8*)(kp);        kf[1] = *(const ALAS bf16x8*)(kp + 512);
  kf[2] = *(const ALAS bf16x8*)(kp + 2048); kf[3] = *(const ALAS bf16x8*)(kp + 2560);
  kf[4] = *(const ALAS bf16x8*)(kp + 4096); kf[5] = *(const ALAS bf16x8*)(kp + 4608);
  kf[6] = *(const ALAS bf16x8*)(kp + 6144); kf[7] = *(const ALAS bf16x8*)(kp + 6656);
}
__device__ __forceinline__ void kload2(bf16x8* kf, lds_cptr kp, int j) { kf[2 * j] = *(const ALAS bf16x8*)(kp + j * 2048); kf[2 * j + 1] = *(const ALAS bf16x8*)(kp + j * 2048 + 512); }
__device__ __forceinline__ s16x4 vtr(lds_cptr p) { return __builtin_bit_cast(s16x4, __builtin_amdgcn_ds_read_tr16_b64_v4i16((ALAS v4i16_t*)p)); }
__device__ __forceinline__ void cmask(f32x16& p0, f32x16& p1, int jb, int qrel, int hi) {
  const int kb = 64 * jb + 4 * hi;
#pragma unroll
  for (int r = 0; r < 16; ++r) { const int kv = kb + (r & 3) + 8 * (r >> 2); if (kv > qrel) p0[r] = -INFINITY; if (kv + 32 > qrel) p1[r] = -INFINITY; }
}
__device__ __forceinline__ bf16x8 kx_frag(float e, int hi) {
  const unsigned a = cvtpk_s(e, 0.f) & 0xffffu; const float r1 = e - __uint_as_float(a << 16);
  const unsigned bb = cvtpk_s(r1, 0.f) & 0xffffu; const float r2 = r1 - __uint_as_float(bb << 16);
  const unsigned c = cvtpk_s(r2, 0.f) & 0xffffu;
  u32x4 w = {hi == 0 ? (a | (bb << 16)) : 0u, hi == 0 ? (c | 0x3F800000u) : 0u, hi == 0 ? 0x3F803F80u : 0u, 0u};
  return __builtin_bit_cast(bf16x8, w);
}
__device__ __forceinline__ bf16x8 qx_frag(float nm, int hi) {
  const unsigned a = cvtpk_s(nm, 0.f) & 0xffffu; const float r1 = nm - __uint_as_float(a << 16);
  const unsigned bb = cvtpk_s(r1, 0.f) & 0xffffu; const float r2 = r1 - __uint_as_float(bb << 16);
  const unsigned c = cvtpk_s(r2, 0.f) & 0xffffu;
  u32x4 w = {hi == 0 ? 0x3F803F80u : 0u, hi == 0 ? (0x3F80u | (a << 16)) : 0u, hi == 0 ? (bb | (c << 16)) : 0u, 0u};
  return __builtin_bit_cast(bf16x8, w);
}

template <int MODE, int THRL> __device__ __forceinline__ void attn_unit_v2(int b, int h, int qb, const bf16* Q, const bf16* __restrict__ K, const bf16* __restrict__ V, bf16* O, ALAS char* shm, const AttnAux& ax, bool stage) {
  constexpr int KP = MODE == 0 ? 256 : 1024;
  int tid_ = threadIdx.x; asm volatile("" : "+v"(tid_));
  const int tid = tid_, lane = tid & 63, r32 = lane & 31, hi = lane >> 5; const int wid = __builtin_amdgcn_readfirstlane(tid >> 6);
  const int kvh = MODE == 0 ? (h >> 2) : h;
  const long rowbase = 0; const int q0 = qb * QB;
  const int tb = MODE == 0 ? (qb > 0 ? 4 * qb - 2 : 0) : 0; const int NT = 4 * qb + 4 - tb;
  const bf16* Qw = Q + (rowbase + q0 + wid * QBLK) * DM + h * D;
  const bf16* Kh = K + (rowbase + (long)tb * KVBLK) * KP + kvh * D, *Vh = V + (rowbase + (long)tb * KVBLK) * KP + kvh * D;
  const unsigned lds0 = (unsigned)(uintptr_t)shm;
  ALAS float* wsf = (ALAS float*)(shm + LDS_WS) + wid * 64;
  ALAS float* Ef = (ALAS float*)(shm + LDS_E);
  ALAS float* TAB = (ALAS float*)(shm + LDS_TAB);
  ALAS float* OFFS = (ALAS float*)(shm + LDS_OFFS);
  typedef unsigned u32x2_t __attribute__((ext_vector_type(2)));
  ALAS u32x2_t* KX = (ALAS u32x2_t*)(shm + LDS_KX);
  const int kxi = hi == 0 ? r32 : SEQ, kxs = hi == 0 ? 64 : 0, kxh = hi == 0 ? 32 : 0; const unsigned kxc = hi == 0 ? 0x3F803F80u : 0u;
  const bf16* ksrc = Kh + (long)lane * KP + wid * 8;
  const bf16* vsrc = Vh + (long)(16 * (wid & 3) + (lane >> 2)) * KP + (wid >> 2) * 32 + (lane & 3) * 8;
  const unsigned kdst = lds0 + LDS_K + wid * 1024, vdst = lds0 + LDS_V + wid * 1024;
#define DMA_K(t, slot) glds16(ksrc + (long)(t) * KVBLK * KP, (unsigned)__builtin_amdgcn_readfirstlane(kdst + (slot)))
#define DMA_V(t, slot) glds16(vsrc + (long)(t) * KVBLK * KP, (unsigned)__builtin_amdgcn_readfirstlane(vdst + (slot)))
  const int vb0 = (int)(lds0 + LDS_V) + ((lane >> 4) & 1) * 32 + (lane & 3) * 8 + (4 * hi + ((lane & 15) >> 2)) * 64;
  const lds_cptr shm3 = (lds_cptr)shm; const lds_cptr kp0 = shm3 + LDS_K + hi * 1024 + r32 * 16; const lds_cptr vp0 = shm3 + LDS_V + ((lane >> 4) & 1) * 32 + (lane & 3) * 8 + (4 * hi + ((lane & 15) >> 2)) * 64;
  bf16x8 kf[8];
  DMA_K(0, 0); DMA_V(0, 0); DMA_K(1, SLOTB);
  bf16x8 qr[4];
#pragma unroll
  for (int d0 = 0; d0 < 4; ++d0) qr[d0] = *reinterpret_cast<const bf16x8*>(&Qw[(long)r32 * DM + d0 * 16 + hi * 8]);
  const int qrel = wid * QBLK + r32, qg = q0 + qrel;
  bf16x8 qx = bf16x8{};
  if (MODE == 0) {
    for (int i = tid; i < 640; i += 512) { const int dist = i - 256; float v = -INFINITY;
      if (dist >= 0 && dist < 128) v = ax.rel_bias[t5_bucket(dist) * 16 + h] * LOG2E;
      TAB[i] = v; }
  } else if (stage) {
    if (wid == 0) { float v = ax.CT[(size_t)(b * 16 + h) * 32 + (lane & 31)]; if (lane >= 32) v = 0.f; float inc = v;
#pragma unroll
      for (int s = 1; s < 32; s <<= 1) { const float uu = __shfl_up(inc, s); if (lane >= s) inc += uu; }
      if (lane < 32) OFFS[lane] = inc - v; }
    asm volatile("s_waitcnt lgkmcnt(0)\n\ts_barrier" ::: "memory");
    const float* cl = ax.CL + (size_t)(b * 16 + h) * SEQ;
    for (int k = tid; k < SEQ; k += 512) { const float e = -(cl[k] + OFFS[k >> 6]); Ef[k] = e;
      const unsigned a = cvtpk_s(e, 0.f) & 0xffffu; const float r1 = e - __uint_as_float(a << 16);
      const unsigned bb = cvtpk_s(r1, 0.f) & 0xffffu; const float r2 = r1 - __uint_as_float(bb << 16);
      const unsigned c = cvtpk_s(r2, 0.f) & 0xffffu;
      KX[k] = (u32x2_t){a | (bb << 16), c | 0x3F800000u}; }
    if (tid == 0) KX[SEQ] = (u32x2_t){0u, 0u};
  }
  DMA_K(2, 2 * SLOTB);
  WAIT_BAR(3);
  float mhat, l_reg; f32x16 o[2]; o[0] = f32x16{}; o[1] = f32x16{};
  if (MODE == 0) { mhat = ax.sinks[h] * LOG2E; l_reg = hi == 0 ? 1.0f : 0.0f; }
  else { mhat = Ef[qg]; l_reg = 0.f; }
  f32x16 negm = f32x16{};
  if (MODE == 0) {
#pragma unroll
    for (int r = 0; r < 16; ++r) negm[r] = -mhat;
    asm volatile("" : "+v"(negm)); }
  else qx = qx_frag(-mhat, hi);
  bool resc = false;
  u32x2_t ec0 = {0u, 0u}, ec1 = {0u, 0u};
#define MASKB(C0, C1, t) do { if (MODE == 0) { const int ib_ = 256 + qg - 64 * (tb + (t)) - 4 * hi; \
      _Pragma("unroll") for (int r = 0; r < 16; ++r) { const int idx_ = ib_ - ((r & 3) + 8 * (r >> 2)); C0[r] += TAB[idx_]; C1[r] += TAB[idx_ - 32]; } } \
    else { const int jb_ = (t) - (NT - 4); if (jb_ >= 0) cmask(C0, C1, jb_, qrel, hi); } } while (0)
#define DECIDE(C0, C1) do { float a = MX3(C0[0], C0[1], C1[0]), b_ = MX3(C0[2], C0[3], C1[1]); a = MX3(a, C1[2], C1[3]); \
      _Pragma("unroll") for (int r = 4; r < 16; r += 4) { a = MX3(a, C0[r], C0[r + 1]); b_ = MX3(b_, C0[r + 2], C0[r + 3]); a = MX3(a, C1[r], C1[r + 1]); b_ = MX3(b_, C1[r + 2], C1[r + 3]); } \
      float rm = __builtin_fmaxf(a, b_); { auto rr = __builtin_amdgcn_permlane32_swap(__float_as_uint(rm), __float_as_uint(rm), false, false); rm = __builtin_fmaxf(__uint_as_float(rr[0]), __uint_as_float(rr[1])); } \
      resc = false; \
      if (__builtin_expect(__any(rm > (float)THRL), 0)) { const float dl = __builtin_fmaxf(rm, 0.f); mhat += dl; \
        _Pragma("unroll") for (int r = 0; r < 16; ++r) { C0[r] -= dl; C1[r] -= dl; } \
        if (MODE == 0) { _Pragma("unroll") for (int r = 0; r < 16; ++r) negm[r] = -mhat; asm volatile("" : "+v"(negm)); } else qx = qx_frag(-mhat, hi); \
        const float f = __builtin_amdgcn_exp2f(-dl); l_reg *= f; if (hi == 0) wsf[r32] = f; resc = true; } } while (0)
#define RESC() do { if (resc) { asm volatile("s_waitcnt lgkmcnt(0)" ::: "memory"); \
      _Pragma("unroll") for (int d_ = 0; d_ < 2; ++d_) _Pragma("unroll") for (int r = 0; r < 16; ++r) o[d_][r] *= wsf[crow(r, hi)]; } } while (0)
  f32x16 pA0, pA1, pB0, pB1;
  int sl_prev = 0, sl_cur = 0, sl_next = SLOTB;
#define ROT() do { sl_prev = sl_cur; sl_cur = sl_next; sl_next = (sl_next == (NSLOT - 1) * SLOTB) ? 0 : sl_next + SLOTB; } while (0)
  if (MODE == 0) qkt(pA0, pA1, shm3 + LDS_K, qr, negm, r32, hi); else qkt(pA0, pA1, shm3 + LDS_K, qr, f32x16{}, r32, hi);
#define KXF(e) __builtin_bit_cast(bf16x8, (u32x4){(e)[0], (e)[1], kxc, 0u})
  if (MODE == 1) { const u32x2_t e0 = KX[kxi + kxs * tb], e1 = KX[kxi + kxs * tb + kxh];
    pA0 = __builtin_amdgcn_mfma_f32_32x32x16_bf16(KXF(e0), qx, pA0, 0, 0, 0); pA1 = __builtin_amdgcn_mfma_f32_32x32x16_bf16(KXF(e1), qx, pA1, 0, 0, 0);
    ec0 = KX[kxi + kxs * (tb + 1)]; ec1 = KX[kxi + kxs * (tb + 1) + kxh]; }
  MASKB(pA0, pA1, 0);
  DECIDE(pA0, pA1);
#pragma unroll
  for (int r = 0; r < 16; ++r) { pA0[r] = __builtin_amdgcn_exp2f(pA0[r]); pA1[r] = __builtin_amdgcn_exp2f(pA1[r]); }
  WAIT_BAR(0);
  DMA_K(3, 0); DMA_V(1, SLOTB);
  ROT();
  kload8(kf, kp0 + sl_cur);
  WAIT_BAR(2);
  s16x4 vlo[8], vhi[8]; u32x4 pw0, pw1, pw2, pw3;
#define PKW(P, B) cvtpk_s(P[B], P[B + 1])
#define PAF(k) __builtin_bit_cast(bf16x8, pw##k)
#define VFR(i) (bf16x8){vlo[i][0], vlo[i][1], vlo[i][2], vlo[i][3], vhi[i][0], vhi[i][1], vhi[i][2], vhi[i][3]}
#define PIN(x) asm volatile("" : "+v"(x))
#define GAPA(MF, A0, A1, A2, A3, W0, W1, PW) do { MF; sacc += A0; sacc += A1; sacc += A2; sacc += A3; PIN(sacc); W0; W1; PIN(PW); SBAR(); } while (0)
#define EX(v) __builtin_amdgcn_exp2f(v)
#define GAPB(MF, X, B) do { MF; X[B] = EX(X[B]); X[B + 1] = EX(X[B + 1]); X[B + 2] = EX(X[B + 2]); X[B + 3] = EX(X[B + 3]); PIN(X); SBAR(); } while (0)
#define VRD(i) do { vlo[i] = vtr(vp_ + (((i) >> 2) * 4096 + ((i) & 3) * 1024)); vhi[i] = vtr(vp_ + (((i) >> 2) * 4096 + ((i) & 3) * 1024 + 512)); } while (0)
#define KRD(G, j) do { if (G) { kload2(kf, kp0 + sl_next, j); SBAR(); } } while (0)
#define MF32(a, b, c) __builtin_amdgcn_mfma_f32_32x32x16_bf16(a, b, c, 0, 0, 0)
#define CIN (MODE == 0 ? negm : f32x16{})
#define STEP(C0, C1, P0, P1, t, GK, GV, GL) do { SBAR(); \
    const lds_cptr vp_ = vp0 + sl_prev; \
    VRD(0); SBAR(); float sacc = (P0[0] + P0[1]); \
    GAPA(C0 = MF32(kf[0], qr[0], CIN), P0[2], P0[3], P0[4], P0[5],     pw0[0] = PKW(P0, 0), pw0[1] = PKW(P0, 2), pw0); \
    VRD(4); SBAR(); GAPA(C1 = MF32(kf[1], qr[0], CIN), P0[6], P0[7], P0[8], P0[9],     pw0[2] = PKW(P0, 4), pw0[3] = PKW(P0, 6), pw0); \
    VRD(1); SBAR(); GAPA(C0 = MF32(kf[2], qr[1], C0),   P0[10], P0[11], P0[12], P0[13], pw1[0] = PKW(P0, 8), pw1[1] = PKW(P0, 10), pw1); \
    VRD(5); SBAR(); GAPA(C1 = MF32(kf[3], qr[1], C1),   P0[14], P0[15], P1[0], P1[1],   pw1[2] = PKW(P0, 12), pw1[3] = PKW(P0, 14), pw1); \
    VRD(2); SBAR(); GAPA(C0 = MF32(kf[4], qr[2], C0),   P1[2], P1[3], P1[4], P1[5],     pw2[0] = PKW(P1, 0), pw2[1] = PKW(P1, 2), pw2); \
    VRD(6); SBAR(); GAPA(C1 = MF32(kf[5], qr[2], C1),   P1[6], P1[7], P1[8], P1[9],     pw2[2] = PKW(P1, 4), pw2[3] = PKW(P1, 6), pw2); \
    VRD(3); SBAR(); GAPA(C0 = MF32(kf[6], qr[3], C0),   P1[10], P1[11], P1[12], P1[13], pw3[0] = PKW(P1, 8), pw3[1] = PKW(P1, 10), pw3); \
    VRD(7); SBAR(); GAPA(C1 = MF32(kf[7], qr[3], C1),   P1[14], P1[15], 0.f, 0.f,       pw3[2] = PKW(P1, 12), pw3[3] = PKW(P1, 14), pw3); \
    if (MODE == 1) { C0 = MF32(KXF(ec0), qx, C0); C1 = MF32(KXF(ec1), qx, C1); SBAR(); } \
    l_reg += sacc; \
    if (GK) { DMA_K((t) + 3, sl_cur); } if (GV) { DMA_V((t) + 1, sl_next); } \
    MASKB(C0, C1, t); \
    DECIDE(C0, C1); \
    SBAR(); \
    GAPB(o[0] = MF32(PAF(0), VFR(0), o[0]), C0, 0); \
    GAPB(o[1] = MF32(PAF(0), VFR(4), o[1]), C0, 4); \
    KRD(GL, 0); GAPB(o[0] = MF32(PAF(1), VFR(1), o[0]), C0, 8); \
    KRD(GL, 1); GAPB(o[1] = MF32(PAF(1), VFR(5), o[1]), C0, 12); \
    KRD(GL, 2); GAPB(o[0] = MF32(PAF(2), VFR(2), o[0]), C1, 0); \
    KRD(GL, 3); GAPB(o[1] = MF32(PAF(2), VFR(6), o[1]), C1, 4); \
    GAPB(o[0] = MF32(PAF(3), VFR(3), o[0]), C1, 8); \
    GAPB(o[1] = MF32(PAF(3), VFR(7), o[1]), C1, 12); \
    if (MODE == 1 && (GL)) { ec0 = KX[kxi + kxs * (tb + (t) + 1)]; ec1 = KX[kxi + kxs * (tb + (t) + 1) + kxh]; } \
    } while (0)
  int t = 1;
  if (MODE == 1) {
    for (; t + 5 < NT; t += 2) {
      STEP(pB0, pB1, pA0, pA1, t, true, true, true);     WAIT_BAR(2); RESC(); ROT();
      STEP(pA0, pA1, pB0, pB1, t + 1, true, true, true); WAIT_BAR(2); RESC(); ROT();
    }
  }
#define ENDW(tt) do { if ((tt) + 3 < NT) { WAIT_BAR(2); } else if ((tt) + 2 < NT) { WAIT_BAR(1); } else { WAIT_BAR(0); } } while (0)
  for (; t + 1 < NT; t += 2) {
    STEP(pB0, pB1, pA0, pA1, t, (t + 3 < NT), (t + 1 < NT), (t + 1 < NT));       ENDW(t);     RESC(); ROT();
    STEP(pA0, pA1, pB0, pB1, t + 1, (t + 4 < NT), (t + 2 < NT), (t + 2 < NT));   ENDW(t + 1); RESC(); ROT();
  }
  STEP(pB0, pB1, pA0, pA1, NT - 1, false, false, false); RESC();
  { float sacc = pB0[0] + pB0[1];
#pragma unroll
    for (int r = 2; r < 16; ++r) sacc += pB0[r];
#pragma unroll
    for (int r = 0; r < 16; ++r) sacc += pB1[r];
    l_reg += sacc;
    pw0 = (u32x4){PKW(pB0, 0), PKW(pB0, 2), PKW(pB0, 4), PKW(pB0, 6)}; pw1 = (u32x4){PKW(pB0, 8), PKW(pB0, 10), PKW(pB0, 12), PKW(pB0, 14)};
    pw2 = (u32x4){PKW(pB1, 0), PKW(pB1, 2), PKW(pB1, 4), PKW(pB1, 6)}; pw3 = (u32x4){PKW(pB1, 8), PKW(pB1, 10), PKW(pB1, 12), PKW(pB1, 14)};
    SBAR(); pv(o, vb0 + sl_cur, PAF(0), PAF(1), PAF(2), PAF(3)); }
  { auto rr = __builtin_amdgcn_permlane32_swap(__float_as_uint(l_reg), __float_as_uint(l_reg), false, false); l_reg = __uint_as_float(rr[0]) + __uint_as_float(rr[1]); }
  if (hi == 0) wsf[32 + r32] = l_reg;
  asm volatile("s_waitcnt lgkmcnt(0)" ::: "memory");
  float rli[16];
#pragma unroll
  for (int r = 0; r < 16; ++r) rli[r] = __builtin_amdgcn_rcpf(wsf[32 + crow(r, hi)]);
  bf16* Ow = O + (rowbase + q0 + wid * QBLK) * DM + h * D;
  { ALAS bf16* stg = (ALAS bf16*)(shm + LDS_OST) + wid * 2048;
#pragma unroll
    for (int r = 0; r < 16; ++r) { const int orow = crow(r, hi);
#pragma unroll
      for (int d0 = 0; d0 < 2; ++d0) stg[orow * 64 + d0 * 32 + r32] = (bf16)(cvtpk_s(o[d0][r] * rli[r], 0.f) & 0xffffu); }
    asm volatile("s_waitcnt lgkmcnt(0)" ::: "memory");
#pragma unroll
    for (int i = 0; i < 4; ++i) { const int row = i * 8 + (lane >> 3), ch = lane & 7; const u32x4 v = *(const ALAS u32x4*)(stg + row * 64 + ch * 8); *(u32x4*)(Ow + (long)row * DM + ch * 8) = v; } }
  asm volatile("s_waitcnt lgkmcnt(0)\n\ts_barrier" ::: "memory");
#undef DMA_K
#undef DMA_V
#undef MASKB
#undef DECIDE
#undef RESC
#undef ROT
#undef PKW
#undef PAF
#undef VFR
#undef PIN
#undef GAPA
#undef EX
#undef GAPB
#undef VRD
#undef KRD
#undef MF32
#undef CIN
#undef KXF
#undef STEP
#undef ENDW
}
}
#define GAS __attribute__((address_space(1)))
#define LAS __attribute__((address_space(3)))
typedef unsigned short bf16;
typedef unsigned v4u __attribute__((ext_vector_type(4)));
typedef float f32x4 __attribute__((ext_vector_type(4)));
typedef short bf16x8 __attribute__((ext_vector_type(8)));
typedef GAS unsigned gu32;
typedef GAS unsigned long long gu64;
#define RLX_AGENT __ATOMIC_RELAXED, __HIP_MEMORY_SCOPE_AGENT
#define LDS_WAIT() asm volatile("s_waitcnt lgkmcnt(0)" ::: "memory")
#define VM_WAIT() asm volatile("s_waitcnt vmcnt(0)" ::: "memory")
__device__ __forceinline__ unsigned long long rt() { return __builtin_amdgcn_s_memrealtime(); }
__device__ __forceinline__ unsigned f2bf(float f) { unsigned u = __builtin_bit_cast(unsigned, f); return (u + 0x7fffu + ((u >> 16) & 1u)) >> 16; }
__device__ __forceinline__ unsigned pk2(float lo, float hi) { return f2bf(lo) | (f2bf(hi) << 16); }

#define XB_TMO      128
#define XB_XCNT(j)  (256  + 64 * (j))
#define XB_XSUB(j)  (1280 + 64 * (j))
#define XB_XGEN(j)  (2304 + 64 * (j))
#define XB_TOP      3328
#define XB_TOPGEN   3392
#define XCD_BAR_WORDS 3456
#define XB_SPIN_CAP (1u << 18)

__device__ __forceinline__ unsigned xb_ld(unsigned* p)              { return __hip_atomic_load(p, __ATOMIC_RELAXED, __HIP_MEMORY_SCOPE_AGENT); }
__device__ __forceinline__ unsigned xb_add(unsigned* p, unsigned v) { return __hip_atomic_fetch_add(p, v, __ATOMIC_RELAXED, __HIP_MEMORY_SCOPE_AGENT); }
__device__ __forceinline__ unsigned xb_xcc_id() { return (unsigned)__builtin_amdgcn_s_getreg((3 << 11) | 20) & 0xFu; }
#define XB_SPIN(cond, bar) do { unsigned _sp = 0; while (cond) { __builtin_amdgcn_s_sleep(1); \
    if ((++_sp & 255u) == 0u) { if (xb_ld(&(bar)[XB_TMO])) break; if (_sp > XB_SPIN_CAP) { atomicAdd(&(bar)[XB_TMO], 1u); break; } } } } while (0)

struct XcdBarrier {
    unsigned* bar; unsigned x; unsigned G;
    volatile LAS unsigned* st;
};

__device__ __forceinline__ XcdBarrier xcd_barrier_post(unsigned* bar, volatile LAS unsigned* st, unsigned G) {
    XcdBarrier b; b.bar = bar; b.x = xb_xcc_id(); b.st = st; b.G = G;
    if (threadIdx.x == 0) (void)xb_add(&bar[XB_XCNT(b.x)], 1u);
    return b;
}
__device__ __forceinline__ void xcd_barrier_complete(unsigned* bar, unsigned x, unsigned& nloc, unsigned& nx, const unsigned G) {
    unsigned sum, cnt, mine, sp = 0u;
    for (;;) {
        sum = 0u; cnt = 0u; mine = 0u;
#pragma unroll
        for (unsigned j = 0; j < 16; ++j) { const unsigned c = xb_ld(&bar[XB_XCNT(j)]); sum += c; cnt += (c > 0u) ? 1u : 0u; mine = (j == x) ? c : mine; }
        if (sum == G) break;
        __builtin_amdgcn_s_sleep(1);
        if ((++sp & 255u) == 0u) { if (xb_ld(&bar[XB_TMO])) break; if (sp > XB_SPIN_CAP) { atomicAdd(&bar[XB_TMO], 1u); break; } }
    }
    nloc = mine > 0u ? mine : 1u; nx = cnt > 0u ? cnt : 1u;
}

__device__ __forceinline__ void xcd_barrier(const XcdBarrier& b) {
    asm volatile("s_waitcnt vmcnt(0)" ::: "memory");
    __syncthreads();
    if (threadIdx.x == 0) {
        unsigned* bar = b.bar; asm volatile("" : "+s"(bar));
        __builtin_amdgcn_s_waitcnt(0);
        unsigned nloc = b.st[0], nx = b.st[1];
        unsigned bx_ = b.x; asm volatile("" : "+s"(bx_));
        if (nloc == 0u) { xcd_barrier_complete(bar, bx_, nloc, nx, b.G); b.st[0] = nloc; b.st[1] = nx; }
        if (nx == 1u) asm volatile("buffer_inv sc1" ::: "memory");
        const unsigned old = xb_add(&bar[XB_XSUB(bx_)], 1u);
        const unsigned gen = old / nloc;
        if (nx == 1u) {
            const unsigned target = (gen + 1u) * nloc;
            if (old + 1u != target) XB_SPIN((int)(xb_ld(&bar[XB_XSUB(bx_)]) - target) < 0, bar);
            asm volatile("s_waitcnt vmcnt(0)" ::: "memory");
        } else
        if (old + 1u == (gen + 1u) * nloc) {
            if (nx > 1u) __builtin_amdgcn_fence(__ATOMIC_RELEASE, "agent");
            asm volatile("s_waitcnt vmcnt(0)" ::: "memory");
            const unsigned og = xb_add(&bar[XB_TOP], 1u);
            const unsigned tg = og / nx;
            if (og + 1u == (tg + 1u) * nx) xb_add(&bar[XB_TOPGEN], 1u);
            else XB_SPIN(xb_ld(&bar[XB_TOPGEN]) == tg, bar);
            __builtin_amdgcn_fence(__ATOMIC_ACQUIRE, "agent");
            xb_add(&bar[XB_XGEN(bx_)], 1u);
            asm volatile("s_waitcnt vmcnt(0)" ::: "memory");
        } else {
            XB_SPIN(xb_ld(&bar[XB_XGEN(bx_)]) == gen, bar);
            __builtin_amdgcn_fence(__ATOMIC_ACQUIRE, "agent");
            asm volatile("s_waitcnt vmcnt(0)" ::: "memory");
        }
    }
    __syncthreads();
}


__device__ __forceinline__ void row_barrier(unsigned* cnt, unsigned* tmo_bar) {
    asm volatile("s_waitcnt vmcnt(0)" ::: "memory");
    __syncthreads();
    if (threadIdx.x == 0) {
        asm volatile("" : "+s"(cnt), "+s"(tmo_bar));
        __builtin_amdgcn_s_waitcnt(0);
        asm volatile("buffer_inv sc1" ::: "memory");
        const unsigned old = xb_add(cnt, 1u);
        const unsigned target = (old / 4u + 1u) * 4u;
        if (old + 1u != target) XB_SPIN((int)(xb_ld(cnt) - target) < 0, tmo_bar);
        asm volatile("s_waitcnt vmcnt(0)" ::: "memory");
    }
    __syncthreads();
}

constexpr int NWAVES = 8;
constexpr int BATCH = 8, T = 2048, D = 1024, H = 16, HD = 64, FF = 4096, DEPTH = 4;
constexpr int M = BATCH * T;
constexpr int QKV_A = 1536, QKVF_B = 3088, NQKV_B = 3072;
constexpr size_t MiB = 1u << 20;
constexpr size_t WS_CTL = 0, CTL_ZERO_BYTES = 160 * 1024;
constexpr size_t WS_SSQ = 1 * MiB;
constexpr size_t WS_CT = 1 * MiB + 512 * 1024;
constexpr size_t WS_CL = 2 * MiB;
constexpr size_t WS_WF = 3 * MiB;
constexpr size_t WS_W = 4 * MiB;
constexpr size_t WS_XB = 94 * MiB;
constexpr size_t WS_BLK = 128 * MiB, BLK_BYTES = 16 * MiB;
constexpr size_t BLK_K = 4 * MiB, BLK_V = 8 * MiB, BLK_SPARE = 12 * MiB;
constexpr size_t WS_END = 256 * MiB;
__host__ __device__ constexpr size_t layer_w_base(int l) { return WS_W + (size_t)(l == 0 ? 0 : l == 1 ? 21 : l == 2 ? 45 : 66) * MiB; }
__host__ __device__ constexpr size_t layer_qkv_bytes(int l) { return (size_t)((l & 1) ? 6 : 3) * MiB; }
static_assert(layer_w_base(3) + 24 * MiB == WS_XB && WS_XB + 32 * MiB <= WS_BLK && WS_BLK + 8 * BLK_BYTES == WS_END, "ws map");
constexpr int CW_BAR = 4096;
static_assert((size_t)(CW_BAR + 9 * 3456) * 4 <= CTL_ZERO_BYTES && CTL_ZERO_BYTES <= WS_SSQ, "control words inside the per-call memset");
constexpr int RING_OFF = 0, RING_BYTES = 131072;
constexpr int LDSCTL_OFF = RING_BYTES, MISC_OFF = LDSCTL_OFF + 320;
constexpr int LDS_BYTES = 147456;
static_assert(att::LDS_BYTES <= RING_BYTES, "attention scratch inside the ring region");

__device__ __forceinline__ float wave_sum(float v) {
#pragma unroll
    for (int o = 1; o < 64; o <<= 1) v += __shfl_xor(v, o);
    return v;
}
struct TItem { const float* W; const float* gain; bf16* WT; int K, ldw, k0, n0; };
template <bool NT = false> __device__ __forceinline__ void p0_item_load(const TItem& it, f32x4 (&v)[8], float (&g)[8], int lane) {
    const int kq = lane >> 3, c4 = (lane & 7) * 4;
#pragma unroll
    for (int i = 0; i < 8; ++i) { const int kk = i * 8 + kq; v[i] = NT ? __builtin_nontemporal_load((const GAS f32x4*)(it.W + (size_t)(it.k0 + kk) * it.ldw + it.n0 + c4)) : *(const GAS f32x4*)(it.W + (size_t)(it.k0 + kk) * it.ldw + it.n0 + c4); g[i] = it.gain ? it.gain[it.k0 + kk] : 1.0f; }
}
template <bool NT = false> __device__ __forceinline__ void p0_item_store(const TItem& it, const f32x4 (&v)[8], const float (&g)[8], LAS float* scr, int lane) {
    const int kq = lane >> 3, c4 = (lane & 7) * 4;
#pragma unroll
    for (int i = 0; i < 8; ++i) { LAS float* d = scr + (i * 8 + kq) * 33 + c4; d[0] = v[i].x * g[i]; d[1] = v[i].y * g[i]; d[2] = v[i].z * g[i]; d[3] = v[i].w * g[i]; }
    LDS_WAIT(); asm volatile("" ::: "memory");
    const int c = lane & 7;
#pragma unroll
    for (int j = 0; j < 4; ++j) { const int n = (lane >> 3) + 8 * j; const LAS float* s = scr + (8 * c) * 33 + n;
        v4u o; o.x = pk2(s[0 * 33], s[1 * 33]); o.y = pk2(s[2 * 33], s[3 * 33]); o.z = pk2(s[4 * 33], s[5 * 33]); o.w = pk2(s[6 * 33], s[7 * 33]);
        if (NT) __builtin_nontemporal_store(o, (GAS v4u*)(it.WT + (size_t)(it.n0 + n) * it.K + it.k0 + 8 * c)); else *(GAS v4u*)(it.WT + (size_t)(it.n0 + n) * it.K + it.k0 + 8 * c) = o; }
    LDS_WAIT(); asm volatile("" ::: "memory");
}

struct Args { const float* in[15]; float* out; unsigned char* ws; };

#define ARGIN(k) ([&]() -> const float* { int k_ = (k); asm volatile("" : "+s"(k_)); return args.in[k_]; }())
enum { A_X = 0, A_RELB = 1, A_NMIX = 2, A_NMLP = 3, A_WQKVA = 4, A_BQKVA = 5, A_SINKS = 6, A_WOA = 7, A_BOA = 8, A_WQKVFB = 9, A_BFB = 10, A_WOB = 11, A_WUP = 12, A_WDOWN = 13, A_NFIN = 14 };
static_assert(pg8::EP_SSQ == WS_SSQ && pg8::EP_XB == WS_XB && pg8::EP_BLK == WS_BLK && pg8::EP_BLKB == BLK_BYTES && pg8::EP_KOFF == BLK_K && pg8::EP_VOFF == BLK_V, "epilogue workspace offsets");
__global__ void __launch_bounds__(NWAVES * 64, 2) mk_fwd(Args args) {
    extern __shared__ __attribute__((aligned(16))) unsigned char lds[];
    LAS unsigned char* const L = (LAS unsigned char*)lds;
    const int tid = threadIdx.x, lane = tid & 63, wave = __builtin_amdgcn_readfirstlane(tid >> 6);
    const int G = gridDim.x; const int bx = blockIdx.x; const int vcu = (G % 8 == 0) ? (bx % 8) * (G / 8) + bx / 8 : bx;
    unsigned char* const ws = args.ws;
    for (int u = tid; u < (LDS_BYTES - LDSCTL_OFF) / 4; u += NWAVES * 64) ((LAS unsigned*)(L + LDSCTL_OFF))[u] = 0u;
    __syncthreads();
    XcdBarrier bar = xcd_barrier_post((unsigned*)((gu32*)(ws + WS_CTL) + CW_BAR), (volatile LAS unsigned*)(L + MISC_OFF) + 8, (unsigned)G);
    XcdBarrier gbar = xcd_barrier_post((unsigned*)((gu32*)(ws + WS_CTL) + CW_BAR) + (1 + (vcu >> 5)) * XCD_BAR_WORDS, (volatile LAS unsigned*)(L + MISC_OFF) + 10, 32u);
#define GROUP_BAR() do { xcd_barrier(gbar); if (DBL == 4) xcd_barrier(gbar); } while (0)
#ifndef DBL
#define DBL (-1)
#endif
#define GRID_BAR() do { xcd_barrier(bar); if (DBL == 4) xcd_barrier(bar); } while (0)
    const int gw = vcu * NWAVES + wave, NGW = G * NWAVES;

    constexpr int I_QA = (D / 64) * (QKV_A / 32), I_QB = (D / 64) * (NQKV_B / 32), I_O = (D / 64) * (D / 32), I_U = (D / 64) * (FF / 32), I_D = (FF / 64) * (D / 32);
    constexpr int I_LA = I_QA + I_O + I_U + I_D, I_LB = I_QB + I_O + I_U + I_D, NITEMS = 2 * (I_LA + I_LB);
    constexpr int CW_CONV = 1024;
    for (int rep_ = 0; rep_ < (DBL == 0 ? 2 : 1); ++rep_) {
        LAS float* scr = (LAS float*)(L + RING_OFF + wave * 16384);
#define P0_DECODE(it_, T_) do { int r = (it_), l = 0; \
            for (; l < DEPTH; ++l) { const int n_ = (l & 1) ? I_LB : I_LA; if (r < n_) break; r -= n_; } \
            const int j = l >> 1; const bool isb = (l & 1) != 0; unsigned char* wb = ws + layer_w_base(l); const int iq = isb ? I_QB : I_QA; int N_; \
            if (r < iq) { if (isb) { T_.W = ARGIN(A_WQKVFB) + (size_t)j * D * QKVF_B; N_ = NQKV_B; T_.ldw = QKVF_B; } else { T_.W = ARGIN(A_WQKVA) + (size_t)j * D * QKV_A; N_ = QKV_A; T_.ldw = QKV_A; } T_.gain = ARGIN(A_NMIX) + l * D; T_.K = D; } \
            else { r -= iq; wb += layer_qkv_bytes(l); \
              if (r < I_O) { T_.W = ARGIN(isb ? A_WOB : A_WOA) + (size_t)j * D * D; N_ = D; T_.ldw = D; T_.gain = nullptr; T_.K = D; } \
              else { r -= I_O; wb += 2 * MiB; \
                if (r < I_U) { T_.W = ARGIN(A_WUP) + (size_t)l * D * FF; N_ = FF; T_.ldw = FF; T_.gain = ARGIN(A_NMLP) + l * D; T_.K = D; } \
                else { r -= I_U; wb += 8 * MiB; T_.W = ARGIN(A_WDOWN) + (size_t)l * FF * D; N_ = D; T_.ldw = D; T_.gain = nullptr; T_.K = FF; } } } \
            T_.WT = (bf16*)wb; const int nblk_ = N_ / 32; T_.k0 = 64 * (r / nblk_); T_.n0 = 32 * (r % nblk_); } while (0)
#define P0_RUN(IT0_, IT1_, GW_, NGW_) do { f32x4 va[8], vb[8]; float ga[8], gb[8]; TItem ta, tb; const int it1_ = (IT1_), ngw_ = (NGW_); \
            int it = (IT0_) + (GW_); \
            if (it < it1_) { P0_DECODE(it, ta); p0_item_load<true>(ta, va, ga, lane); } \
            for (; it < it1_; it += 2 * ngw_) { \
                const bool hb = it + ngw_ < it1_; \
                if (hb) { P0_DECODE(it + ngw_, tb); p0_item_load<true>(tb, vb, gb, lane); } \
                p0_item_store(ta, va, ga, scr, lane); \
                const bool ha = it + 2 * ngw_ < it1_; \
                if (ha) { P0_DECODE(it + 2 * ngw_, ta); p0_item_load<true>(ta, va, ga, lane); } \
                if (hb) p0_item_store(tb, vb, gb, scr, lane); } } while (0)
#define P0_RUN1(IT0_, IT1_, GW_, NGW_) do { f32x4 va[8]; float ga[8]; TItem ta; const int it1_ = (IT1_), ngw_ = (NGW_); \
            for (int it = (IT0_) + (GW_); it < it1_; it += ngw_) { P0_DECODE(it, ta); p0_item_load<true>(ta, va, ga, lane); p0_item_store<false>(ta, va, ga, scr, lane); } } while (0)
        P0_RUN(0, I_QA, gw, NGW);
        { const float* nm = ARGIN(A_NMIX); const float* wq = ARGIN(A_WQKVFB); bf16* WF = (bf16*)(ws + WS_WF);
          for (int e = gw * 64 + lane; e < 2 * 16 * D; e += NGW * 64) { const int j = e / (16 * D), hh = (e / D) % 16, k = e % D;
            WF[e] = (bf16)f2bf(nm[(2 * j + 1) * D + k] * wq[(size_t)j * D * QKVF_B + (size_t)k * QKVF_B + NQKV_B + hh]); } }
        { const float* x_in = ARGIN(A_X); bf16* XB = (bf16*)(ws + WS_XB); float* SSQ = (float*)(ws + WS_SSQ) + (size_t)4 * M;
          for (int m = gw; m < M; m += NGW) {
            const GAS f32x4* xr = (const GAS f32x4*)(x_in + (size_t)m * D) + lane; GAS unsigned long long* o8 = (GAS unsigned long long*)(XB + (size_t)m * D) + lane;
            float s = 0.f;
#pragma unroll
            for (int jj = 0; jj < 4; ++jj) { const f32x4 v = __builtin_nontemporal_load(xr + 64 * jj); s += (v.x * v.x + v.y * v.y) + (v.z * v.z + v.w * v.w);
                o8[64 * jj] = (unsigned long long)pk2(v.x, v.y) | ((unsigned long long)pk2(v.z, v.w) << 32); }
            s = wave_sum(s);
            if (lane == 0) *(f32x4*)(SSQ + 4 * (size_t)m) = (f32x4){s, 0.f, 0.f, 0.f};
          } }
    }
    GRID_BAR();

#ifdef STAGGER_TICKS
    { const unsigned long long t0_ = __builtin_amdgcn_s_memrealtime(), dl_ = (unsigned long long)(vcu >> 5) * STAGGER_TICKS;
      while (__builtin_amdgcn_s_memrealtime() - t0_ < dl_) __builtin_amdgcn_s_sleep(8); }
#endif
    for (int l = 0; l < DEPTH; ++l) {
        for (int half = 0; half < 2; ++half) {
            const int j = l >> 1; const bool isb = (l & 1) != 0;
            unsigned char* ws = args.ws; asm volatile("" : "+s"(ws));
#define CONV_POLL(k_) do { if (threadIdx.x == 0) { unsigned* cv = (unsigned*)((gu32*)(ws + WS_CTL) + CW_CONV + 64 * (k_)); unsigned* tb_ = (unsigned*)((gu32*)(ws + WS_CTL) + CW_BAR); \
                    XB_SPIN(xb_ld(cv) < 128u, tb_); } } while (0)
            {
                const int N = half ? FF : (isb ? NQKV_B : QKV_A);
                const bf16* Wl = (const bf16*)(ws + layer_w_base(l) + (half ? layer_qkv_bytes(l) + 2 * MiB : 0));
                pg8::Gemm g{(const bf16*)(ws + WS_XB), Wl, M, N, D, (size_t)T * D * 2}; pg8::StaticOrder S; S.init(M, N, G, bx);
                pg8::EpiProj E; E.ws = ws; E.bias = (!half && !isb) ? ARGIN(A_BQKVA) + j * QKV_A : nullptr; E.mode = half ? 2 : (isb ? 1 : 0);
#ifndef NO_G1
                for (int rep_ = 0; rep_ < (DBL == 1 ? 2 : 1); ++rep_)
                pg8::gemm_phase<pg8::EpiProj, pg8::StaticOrder, true, true>(L + RING_OFF, g, S, E);
#endif
            }
            if (!half && !isb && bx >= 128) {
                int tq = threadIdx.x; asm volatile("" : "+v"(tq)); const int lane = tq & 63, wave = __builtin_amdgcn_readfirstlane(tq >> 6);
                LAS float* scr = (LAS float*)(L + RING_OFF + wave * 16384);
                const int it0 = l == 0 ? I_QA : I_LA + I_LB + I_QA, it1 = l == 0 ? I_LA + I_LB + I_QA : NITEMS;
                for (int rep_ = 0; rep_ < (DBL == 9 ? 2 : 1); ++rep_)
                P0_RUN1(it0, it1, (bx - 128) * NWAVES + wave, 128 * NWAVES);
                asm volatile("s_waitcnt vmcnt(0)" ::: "memory"); __syncthreads();
                if (threadIdx.x == 0) { __builtin_amdgcn_fence(__ATOMIC_RELEASE, "agent"); asm volatile("s_waitcnt vmcnt(0)" ::: "memory");
                    xb_add((unsigned*)((gu32*)(ws + WS_CTL) + CW_CONV + 64 * (l >> 1)), 1u); }
            }
            if (!half) {
                if (isb) {
                    int tid = threadIdx.x; asm volatile("" : "+v"(tid)); const int lane = tid & 63;
                    const int R0 = 64 * vcu; const int fr = lane & 15, fq = lane >> 4;
                    for (int rep_ = 0; rep_ < (DBL == 6 ? 2 : 1); ++rep_) if (R0 < M) { if (rep_) { LDS_WAIT(); __builtin_amdgcn_s_barrier(); }
                    const bf16* XB = (const bf16*)(ws + WS_XB); const bf16* WF = (const bf16*)(ws + WS_WF); const float* SSQ = (const float*)(ws + WS_SSQ) + (size_t)4 * M;
                    float* CT = (float*)(ws + WS_CT); float* CL = (float*)(ws + WS_CL); const float* bfb = ARGIN(A_BFB) + j * 16;
                    pg8::f32x4 fa[4];
#pragma unroll
                    for (int gI = 0; gI < 4; ++gI) fa[gI] = (pg8::f32x4){0.f, 0.f, 0.f, 0.f};
                    const bf16* wf = WF + (size_t)j * 16 * D + (size_t)fr * D + 128 * wave + 8 * fq;
                    const bf16* xa = XB + (size_t)(R0 + fr) * D + 128 * wave + 8 * fq;
#pragma unroll
                    for (int ks = 0; ks < 4; ++ks) { const bf16x8 bfr = *(const bf16x8*)(wf + 32 * ks);
#pragma unroll
                        for (int gI = 0; gI < 4; ++gI) { const bf16x8 afr = *(const bf16x8*)(xa + (size_t)(16 * gI) * D + 32 * ks); fa[gI] = __builtin_amdgcn_mfma_f32_16x16x32_bf16(afr, bfr, fa[gI], 0, 0, 0); } }
                    LAS float* part = (LAS float*)(L + RING_OFF);
                    LAS float* lf = (LAS float*)(L + RING_OFF + 32768);
#pragma unroll
                    for (int gI = 0; gI < 4; ++gI)
#pragma unroll
                        for (int e = 0; e < 4; ++e) part[(wave * 64 + 16 * gI + 4 * fq + e) * 16 + fr] = fa[gI][e];
                    LDS_WAIT(); __builtin_amdgcn_s_barrier(); asm volatile("" ::: "memory");
                    for (int e = tid; e < 1024; e += NWAVES * 64) { const int row = e >> 4, hh = e & 15; float s = 0.f;
#pragma unroll
                        for (int w = 0; w < 8; ++w) s += part[(w * 64 + row) * 16 + hh];
                        const float z = s * pg8::row_rstd(SSQ, R0 + row) + bfb[hh];
                        lf[hh * 64 + row] = (fminf(z, 0.f) - log1pf(__expf(-fabsf(z)))) * att::LOG2E; }
                    LDS_WAIT(); __builtin_amdgcn_s_barrier(); asm volatile("" ::: "memory");
                    const int bb = R0 / T, t0 = R0 % T;
#pragma unroll
                    for (int q = 0; q < 2; ++q) { const int hh = 2 * wave + q; const float v = lf[hh * 64 + lane]; float inc = v;
#pragma unroll
                        for (int s = 1; s < 64; s <<= 1) { const float uu = __shfl_up(inc, s); if (lane >= s) inc += uu; }
                        CL[(size_t)(bb * 16 + hh) * T + t0 + lane] = inc;
                        if (lane == 63) CT[(size_t)(bb * 16 + hh) * 32 + (t0 >> 6)] = inc; }
                    }
                }
                GROUP_BAR();
                {
                    att::AttnAux ax; ax.rel_bias = ARGIN(A_RELB); ax.sinks = ARGIN(A_SINKS) + j * 16; ax.CL = (const float*)(ws + WS_CL); ax.CT = (const float*)(ws + WS_CT);
                    const int bh = vcu >> 1; unsigned char* const blk = ws + WS_BLK + (size_t)(bh >> 4) * BLK_BYTES;
                    bf16* const QB_ = (bf16*)blk; const bf16* const KB_ = (const bf16*)(blk + BLK_K); const bf16* const VB_ = (const bf16*)(blk + BLK_V);
                    const int nrep_ = (DBL == 2 || (DBL == 7 && !isb) || (DBL == 8 && isb)) ? 2 : 1;
                    for (int rep_ = 0; rep_ < nrep_; ++rep_) { bf16* const OB_ = (rep_ + 1 < nrep_) ? (bf16*)(blk + BLK_SPARE) : QB_;
                    if (!isb) {
#ifndef NO_SWA
                        att::attn_swa_sweep(bh & 15, vcu & 1, QB_, KB_, VB_, OB_, (LAS char*)(L + RING_OFF), ax);
#endif
                    } else
                    for (int i = 0; i < 4; ++i) {
                        if (isb) { const int s = vcu & 1; const int qb = s == 0 ? (i == 0 ? 7 : i == 1 ? 0 : i == 2 ? 5 : 2) : (i == 0 ? 6 : i == 1 ? 1 : i == 2 ? 4 : 3);

#ifndef NO_FOX
                            att::attn_unit_v2<1, 24>(bh >> 4, bh & 15, qb, QB_, KB_, VB_, OB_, (LAS char*)(L + RING_OFF), ax, i == 0);
#endif
                        }
                        else {
#ifndef NO_SWA
                            att::attn_unit_v1<0>(bh >> 4, bh & 15, (vcu & 1) * 4 + i, QB_, KB_, VB_, OB_, (LAS char*)(L + RING_OFF), ax);
#endif
                        }
                    } }
                }
                if (!isb) CONV_POLL(l >> 1);
                GROUP_BAR();
            } else {
                if (gbar.st[1] == 1u) row_barrier((unsigned*)((gu32*)(ws + WS_CTL) + 2048 + 16 * ((vcu >> 5) * 8 + (vcu & 7))), (unsigned*)((gu32*)(ws + WS_CTL) + CW_BAR)); else GROUP_BAR();
            }
            {
                const bf16* Wl = (const bf16*)(ws + layer_w_base(l) + layer_qkv_bytes(l) + (half ? 10 * MiB : 0));
                pg8::Gemm g{(const bf16*)(ws + WS_BLK), Wl, M, D, half ? FF : D, BLK_BYTES}; pg8::StaticOrder S; S.init(M, D, G, bx);
                const bool fin = half && l == DEPTH - 1;
                pg8::EpiRes E; E.ws = ws; E.bias = (!half && !isb) ? ARGIN(A_BOA) + j * D : nullptr; E.sq = half; E.fout = fin ? args.out : nullptr; E.fgain = ARGIN(A_NFIN); E.fbar = &gbar;
#ifndef NO_G2
                pg8::gemm_phase<pg8::EpiRes, pg8::StaticOrder, false, true>(L + RING_OFF, g, S, E);
#endif
            }
            if (half && l + 1 < DEPTH) CONV_POLL(l + 1 == 3 ? 1 : 0);
            if (!(half && l == DEPTH - 1)) GROUP_BAR();
        }
    }
#undef P0_RUN
#undef P0_RUN1
#undef P0_DECODE
#undef CONV_POLL
}

extern "C" void kernel_launch(void* const* d_in, const int* in_sizes, int n_in, void* d_out, int out_size, void* d_ws, size_t ws_size, hipStream_t stream) {
    static int grid = 0;
    if (grid == 0) {
        if (n_in != 15 || in_sizes[0] != M * D || out_size != M * D || ws_size < WS_END) { fprintf(stderr, "kernel_launch: unexpected shapes / workspace (n_in %d, in0 %d, out %d, ws %zu); nothing launched\n", n_in, n_in > 0 ? in_sizes[0] : -1, out_size, ws_size); grid = -1; return; }
        int dev = 0, cus = 0, per_cu = 0;
        if (hipGetDevice(&dev) != hipSuccess || hipDeviceGetAttribute(&cus, hipDeviceAttributeMultiprocessorCount, dev) != hipSuccess) { grid = -1; return; }
        if (hipFuncSetAttribute((const void*)mk_fwd, hipFuncAttributeMaxDynamicSharedMemorySize, LDS_BYTES) != hipSuccess) { fprintf(stderr, "kernel_launch: hipFuncSetAttribute failed\n"); grid = -1; return; }
        if (hipOccupancyMaxActiveBlocksPerMultiprocessor(&per_cu, (const void*)mk_fwd, NWAVES * 64, LDS_BYTES) != hipSuccess || per_cu < 1) { fprintf(stderr, "kernel_launch: occupancy query says %d blocks per CU\n", per_cu); }
        (void)hipGetLastError();
        grid = cus;
        if (grid != 256) { fprintf(stderr, "kernel_launch: built for a 256-CU device, found %d CUs; nothing launched\n", cus); grid = -1; return; }
    }
    if (grid < 0) return;
    if (hipMemsetAsync((char*)d_ws + WS_CTL, 0, CTL_ZERO_BYTES, stream) != hipSuccess) return;
    Args a{};
    for (int i = 0; i < 15; ++i) a.in[i] = (const float*)d_in[i];
    a.out = (float*)d_out; a.ws = (unsigned char*)d_ws;
    hipLaunchKernelGGL(mk_fwd, dim3(grid), dim3(NWAVES * 64), LDS_BYTES, stream, a);
}
```

```cpp
#include <hip/hip_runtime.h>
#include <cstdio>
#include <cstdint>
struct XcdBarrier; __device__ __forceinline__ void xcd_barrier(const XcdBarrier& b);
namespace pg8 {
#define PG8_LAS __attribute__((address_space(3)))
typedef unsigned short bf16_t;
typedef short bf16x8 __attribute__((ext_vector_type(8)));
typedef float f32x4 __attribute__((ext_vector_type(4)));
typedef unsigned u32x4 __attribute__((ext_vector_type(4)));
constexpr int BM = 256, BK = 64, HALF = 128, HTB = HALF * BK * 2  , STAGE_BYTES = 8 * HTB, NXCD = 8, WGM = 8;

__host__ __device__ __forceinline__ int lds_byte(int r, int c) { const int st = (r >> 4) * 2 + (c >> 5), rr = r & 15, cc = c & 31, ob = rr * 64 + cc * 2; return st * 1024 + (ob ^ (((ob >> 9) & 1) << 5)); }
__host__ __device__ __forceinline__ void stage_rc(int b, int& R, int& C) { const int st = b / 1024, sb = b % 1024, swz = sb ^ (((sb >> 9) & 1) << 5); R = (st >> 1) * 16 + swz / 64; C = (st & 1) * 32 + (swz % 64) / 2; }
__host__ __device__ __forceinline__ int perm32(int rho) { const int n = rho >> 4, i = rho & 15; return 8 * (i >> 2) + 4 * n + (i & 3); }

struct Unit { int pm, pn; };
struct Gemm { const bf16_t* A; const bf16_t* Bt; int M, N, K; size_t a_bstride; };

struct StaticOrder {
    int nM, nN, nwg, G, c;
    __host__ __device__ void init(int M, int N, int G_, int c_) { nM = M / BM; nN = N / BM; nwg = nM * nN; G = G_; c = c_; }
    __host__ __device__ bool next(int i, Unit& u) const {
        const long L = (long)i * G + c; if (L >= nwg) return false;
        int wgid = (int)L; { const int q = nwg / NXCD, r = nwg % NXCD, xcd = wgid % NXCD, off = wgid / NXCD; wgid = (xcd < r ? xcd * (q + 1) : r * (q + 1) + (xcd - r) * q) + off; }
        const int nig = WGM * nN, gid = wgid / nig, fm = gid * WGM, gsz = (nM - fm) < WGM ? (nM - fm) : WGM;
        u.pm = fm + ((wgid % nig) % gsz); u.pn = (wgid % nig) / gsz; return true;
    }
    __device__ __forceinline__ void a_ready(const Unit&) const {}
    __device__ __forceinline__ void done(const Unit&) const {}
};

constexpr float RMS_EPS = 1e-6f;
constexpr size_t EP_SSQ = (size_t)1 << 20, EP_XB = (size_t)94 << 20, EP_BLK = (size_t)128 << 20, EP_BLKB = (size_t)16 << 20, EP_KOFF = (size_t)4 << 20, EP_VOFF = (size_t)8 << 20;
constexpr float EP_C2 = 0.125f * 1.4426950408889634f;
typedef unsigned u32x2 __attribute__((ext_vector_type(2)));
__device__ __forceinline__ unsigned cvt_pk_bf16(float lo, float hi) { unsigned r; asm volatile("v_cvt_pk_bf16_f32 %0, %1, %2" : "=v"(r) : "v"(lo), "v"(hi)); return r; }
__device__ __forceinline__ float row_rstd(const float* ssq, int row) { const f32x4 s = *(const f32x4*)(ssq + 4 * (size_t)row); return 1.0f / sqrtf(((s[0] + s[1]) + (s[2] + s[3])) * (1.0f / 1024.0f) + RMS_EPS); }

struct EpiProj {
    static constexpr bool PERM = true, AFTER_DRAIN = false;
    unsigned char* ws; const float* bias; int mode;
    PG8_LAS unsigned* wt; unsigned* wcnt;
    __device__ __forceinline__ void operator()(const f32x4 (&acc)[2][2][4][2], const Unit& u, int wr, int wc, int fr, int fq) const {
        { const unsigned tg = *(volatile PG8_LAS unsigned*)wt;
          if (tg != 0u) {
            if (threadIdx.x == 0) { unsigned sp_ = 0u; while ((int)(__hip_atomic_load(wcnt, __ATOMIC_RELAXED, __HIP_MEMORY_SCOPE_AGENT) - tg) < 0 && ++sp_ < (1u << 22)) __builtin_amdgcn_s_sleep(1); }
            asm volatile("s_waitcnt lgkmcnt(0)\n\ts_barrier" ::: "memory");
            if (threadIdx.x == 0) *(volatile PG8_LAS unsigned*)wt = 0u;
            asm volatile("s_waitcnt lgkmcnt(0)" ::: "memory"); } }
        const int row0 = u.pm * BM + wr * 64 + fr, lrow0 = (u.pm & 7) * BM + wr * 64 + fr;
        unsigned char* blk = ws + EP_BLK + (size_t)(u.pm >> 3) * EP_BLKB;
        const float* ssq = (const float*)(ws + EP_SSQ) + (mode == 2 ? (size_t)0 : (size_t)4 * 16384); bf16_t* Q = (bf16_t*)blk; bf16_t* Kp = (bf16_t*)(blk + EP_KOFF); bf16_t* Vp = (bf16_t*)(blk + EP_VOFF);
        const int nq = mode == 2 ? 16 : 4, nk = mode == 0 ? 1 : 4, ldq = mode == 2 ? 4096 : 1024, ldk = mode == 0 ? 256 : 1024, act = mode == 2 ? 1 : 0; const float scale0 = mode == 2 ? 1.0f : EP_C2;
        bf16_t* base; int ld, ct; float sc = 1.f;
        if (u.pn < nq) { base = Q; ld = ldq; ct = u.pn; sc = scale0; } else if (u.pn < nq + nk) { base = Kp; ld = ldk; ct = u.pn - nq; } else { base = Vp; ld = ldk; ct = u.pn - nq - nk; }
        const int col0 = ct * BM + wc * 64 + 8 * fq, bcol0 = u.pn * BM + wc * 64 + 8 * fq;
        f32x4 bv[2][2];
#pragma unroll
        for (int bj = 0; bj < 2; ++bj)
#pragma unroll
            for (int n = 0; n < 2; ++n) bv[bj][n] = bias ? *(const f32x4*)(bias + bcol0 + bj * 32 + 4 * n) : (f32x4){0.f, 0.f, 0.f, 0.f};
        float rs[2][4];
#pragma unroll
        for (int ai = 0; ai < 2; ++ai) {
#pragma unroll
            for (int m = 0; m < 4; ++m) rs[ai][m] = row_rstd(ssq, row0 + ai * HALF + m * 16);
            asm volatile("" ::: "memory"); }
#pragma unroll
        for (int ai = 0; ai < 2; ++ai)
#pragma unroll
            for (int m = 0; m < 4; ++m) { bf16_t* rowp = base + (size_t)(lrow0 + ai * HALF + m * 16) * ld + col0; const float r = rs[ai][m];
#pragma unroll
                for (int bj = 0; bj < 2; ++bj) { f32x4 v0 = acc[ai][bj][m][0] * r + bv[bj][0], v1 = acc[ai][bj][m][1] * r + bv[bj][1];
                    if (act == 1) {
#pragma unroll
                        for (int e = 0; e < 4; ++e) { const float a = fmaxf(v0[e], 0.f), b = fmaxf(v1[e], 0.f); v0[e] = a * a; v1[e] = b * b; } }
                    v0 = v0 * sc; v1 = v1 * sc; u32x4 w; w.x = cvt_pk_bf16(v0[0], v0[1]); w.y = cvt_pk_bf16(v0[2], v0[3]); w.z = cvt_pk_bf16(v1[0], v1[1]); w.w = cvt_pk_bf16(v1[2], v1[3]);
                    *(u32x4*)(rowp + bj * 32) = w; } }
    }
};

struct EpiRes {
    static constexpr bool PERM = true, AFTER_DRAIN = true;
    unsigned char* ws; const float* bias; int sq;
    float* fout; const float* fgain; const XcdBarrier* fbar;
    __device__ __forceinline__ void fused(f32x4 (&acc)[2][2][4][2], const Unit& u, int wr, int wc, int fr, int fq, PG8_LAS unsigned char* lds, int wid, int lane) const {
        bf16_t* xb = (bf16_t*)(ws + EP_XB); float* ssq = (float*)(ws + EP_SSQ) + (sq ? (size_t)4 * 16384 : 0);
        PG8_LAS float* P = (PG8_LAS float*)lds;
        const int col0 = u.pn * BM + wc * 64 + 8 * fq;
        f32x4 bv[2][2];
#pragma unroll
        for (int bj = 0; bj < 2; ++bj)
#pragma unroll
            for (int n = 0; n < 2; ++n) bv[bj][n] = bias ? *(const f32x4*)(bias + col0 + bj * 32 + 4 * n) : (f32x4){0.f, 0.f, 0.f, 0.f};
#pragma unroll
        for (int ai = 0; ai < 2; ++ai)
#pragma unroll
            for (int m = 0; m < 4; ++m) { const int r = ai * HALF + wr * 64 + m * 16 + fr; const size_t off = (size_t)(u.pm * BM + r) * 1024 + col0; float s = 0.f;
#pragma unroll
                for (int bj = 0; bj < 2; ++bj) { const u32x4 b = *(const u32x4*)(xb + off + bj * 32);
                    f32x4 o0 = acc[ai][bj][m][0] + bv[bj][0], o1 = acc[ai][bj][m][1] + bv[bj][1];
                    o0[0] += __uint_as_float(b.x << 16); o0[1] += __uint_as_float(b.x & 0xffff0000u); o0[2] += __uint_as_float(b.y << 16); o0[3] += __uint_as_float(b.y & 0xffff0000u);
                    o1[0] += __uint_as_float(b.z << 16); o1[1] += __uint_as_float(b.z & 0xffff0000u); o1[2] += __uint_as_float(b.w << 16); o1[3] += __uint_as_float(b.w & 0xffff0000u);
                    u32x4 w; w.x = cvt_pk_bf16(o0[0], o0[1]); w.y = cvt_pk_bf16(o0[2], o0[3]); w.z = cvt_pk_bf16(o1[0], o1[1]); w.w = cvt_pk_bf16(o1[2], o1[3]);
                    if (fout) { acc[ai][bj][m][0] = o0; acc[ai][bj][m][1] = o1; } else *(u32x4*)(xb + off + bj * 32) = w;
                    s += ((o0[0] * o0[0] + o0[1] * o0[1]) + (o0[2] * o0[2] + o0[3] * o0[3])) + ((o1[0] * o1[0] + o1[1] * o1[1]) + (o1[2] * o1[2] + o1[3] * o1[3])); }
                s += __shfl_xor(s, 16); s += __shfl_xor(s, 32);
                if (fq == 0) P[r * 4 + wc] = s;
                if (m == 3) asm volatile("" ::: "memory"); }
        asm volatile("s_waitcnt lgkmcnt(0)" ::: "memory"); __builtin_amdgcn_s_barrier(); asm volatile("" ::: "memory");
        const int tid = wid * 64 + lane;
        if (tid < 256) { const f32x4 p = *(const PG8_LAS f32x4*)(P + tid * 4); ssq[(size_t)(u.pm * BM + tid) * 4 + u.pn] = (p[0] + p[1]) + (p[2] + p[3]); }
        if (fout) {
            xcd_barrier(*fbar);
            f32x4 gv[2][2];
#pragma unroll
            for (int bj = 0; bj < 2; ++bj)
#pragma unroll
                for (int n = 0; n < 2; ++n) gv[bj][n] = *(const f32x4*)(fgain + col0 + bj * 32 + 4 * n);
#pragma unroll
            for (int ai = 0; ai < 2; ++ai)
#pragma unroll
                for (int m = 0; m < 4; ++m) { const int row = u.pm * BM + ai * HALF + wr * 64 + m * 16 + fr; const float rs = row_rstd(ssq, row); float* orow = fout + (size_t)row * 1024 + col0;
#pragma unroll
                    for (int bj = 0; bj < 2; ++bj)
#pragma unroll
                        for (int n = 0; n < 2; ++n) *(f32x4*)(orow + bj * 32 + 4 * n) = (acc[ai][bj][m][n] * rs) * gv[bj][n]; }
        }
    }
};

template <class Epi, class Sched, bool ALIGN_EPI = false, bool SP2 = false>
__device__ __forceinline__ void gemm_phase(PG8_LAS unsigned char* lds, const Gemm g, const Sched& S, const Epi& E) {
    int tid_ = threadIdx.x; asm volatile("" : "+v"(tid_));
    const int tid = tid_, wid = __builtin_amdgcn_readfirstlane(tid >> 6), lane = tid & 63, wr = wid >> 2, wc = wid & 3, fr = lane & 15, fq = lane >> 4;
    const int K = g.K, nt = K / BK;
    unsigned voffA[2], voffB[2];
#pragma unroll
    for (int i = 0; i < 2; ++i) { int R, C; stage_rc(tid * 16 + i * 8192, R, C); const int Rb = Epi::PERM ? ((R & ~31) + perm32(R & 31)) : R;
        voffA[i] = (unsigned)(R * K + C) * 2u; voffB[i] = (unsigned)(((Rb >> 5) * 64 + (Rb & 31)) * K + C) * 2u; }
    const size_t kstep = (size_t)(BK * 2);
    const size_t hstep = (size_t)HALF * K * 2;
    const size_t tstep = 2 * hstep;
    const size_t hstepB = (size_t)32 * K * 2;
    const unsigned ldsw = (unsigned)wid * 1024u;
    const int aoff = lds_byte(wr * 64 + fr, fq * 8), boff = lds_byte(wc * 32 + fr, fq * 8);
#define PG8_SA(b, h) (((b) * 2 + (h)) * HTB)
#define PG8_SB(b, h) ((4 + (b) * 2 + (h)) * HTB)
#define PG8_STAGE(bufoff, gbase, voff) do { _Pragma("unroll") for (int _i = 0; _i < 2; ++_i) \
        __builtin_amdgcn_global_load_lds((const unsigned*)((const char*)(gbase) + (voff)[_i]), (PG8_LAS unsigned*)(lds + (bufoff) + ldsw + _i * 8192), 16, 0, 0); } while (0)
#define PG8_LDA(dst, b, h) do { _Pragma("unroll") for (int m = 0; m < 4; ++m) _Pragma("unroll") for (int k = 0; k < 2; ++k) dst[m][k] = *(const PG8_LAS bf16x8*)(lds + PG8_SA(b, h) + aoff + m * 2048 + k * 1024); } while (0)
#define PG8_LDB(dst, b, h) do { _Pragma("unroll") for (int n = 0; n < 2; ++n) _Pragma("unroll") for (int k = 0; k < 2; ++k) dst[n][k] = *(const PG8_LAS bf16x8*)(lds + PG8_SB(b, h) + boff + n * 2048 + k * 1024); } while (0)
#define PG8_MMA(ai, bj, At, Bt) do { __builtin_amdgcn_s_setprio(1); _Pragma("unroll") for (int m = 0; m < 4; ++m) _Pragma("unroll") for (int n = 0; n < 2; ++n) _Pragma("unroll") for (int k = 0; k < 2; ++k) \
        acc[ai][bj][m][n] = __builtin_amdgcn_mfma_f32_16x16x32_bf16(Bt[n][k], At[m][k], acc[ai][bj][m][n], 0, 0, 0); __builtin_amdgcn_s_setprio(0); } while (0)
#define PG8_WAIT_V(n) asm volatile("s_waitcnt vmcnt(" #n ")" ::: "memory")
#define PG8_WAIT_L(n) asm volatile("s_waitcnt lgkmcnt(" #n ")" ::: "memory")
#define PG8_BAR __builtin_amdgcn_s_barrier()
#define PG8_SCHED __builtin_amdgcn_sched_barrier(0)
    Unit cur, nxt; int ui = 0;
    if (!S.next(0, cur)) return;
    f32x4 acc[2][2][4][2];
#pragma unroll
    for (int a = 0; a < 2; ++a)
#pragma unroll
        for (int b = 0; b < 2; ++b)
#pragma unroll
            for (int m = 0; m < 4; ++m)
#pragma unroll
                for (int n = 0; n < 2; ++n) acc[a][b][m][n] = (f32x4){0.f, 0.f, 0.f, 0.f};
    bf16x8 At[4][2], B0[2][2], B1[2][2];
    const char* cA = (const char*)g.A + (size_t)(cur.pm >> 3) * g.a_bstride + (size_t)(cur.pm & 7) * tstep; const char* cB = (const char*)g.Bt + (size_t)cur.pn * tstep;
    S.a_ready(cur);
    if constexpr (SP2) {
        PG8_STAGE(PG8_SB(0, 0), cB, voffB); PG8_STAGE(PG8_SB(0, 1), cB + hstepB, voffB); PG8_STAGE(PG8_SA(0, 0), cA, voffA); PG8_STAGE(PG8_SA(0, 1), cA + hstep, voffA);
        if (wr == 1) PG8_BAR;
        PG8_WAIT_V(2); PG8_BAR;
        PG8_STAGE(PG8_SB(1, 0), cB + kstep, voffB); PG8_STAGE(PG8_SA(1, 0), cA + kstep, voffA); PG8_STAGE(PG8_SB(1, 1), cB + hstepB + kstep, voffB);
        PG8_WAIT_V(6); PG8_BAR;
    } else {
        PG8_STAGE(PG8_SB(0, 0), cB, voffB); PG8_STAGE(PG8_SA(0, 0), cA, voffA); PG8_STAGE(PG8_SB(0, 1), cB + hstepB, voffB); PG8_STAGE(PG8_SA(0, 1), cA + hstep, voffA);
        if (wr == 1) PG8_BAR;
        PG8_WAIT_V(4); PG8_BAR;
        PG8_STAGE(PG8_SB(1, 0), cB + kstep, voffB); PG8_STAGE(PG8_SA(1, 0), cA + kstep, voffA); PG8_STAGE(PG8_SB(1, 1), cB + hstepB + kstep, voffB);
        PG8_WAIT_V(6); PG8_BAR;
    }
    for (;;) {
        const bool has_next = S.next(ui + 1, nxt);
        const char* nA = has_next ? (const char*)g.A + (size_t)(nxt.pm >> 3) * g.a_bstride + (size_t)(nxt.pm & 7) * tstep : cA; const char* nB = has_next ? (const char*)g.Bt + (size_t)nxt.pn * tstep : cB;
        for (int t = 0; t < nt; t += 2) {
            const bool last = (t == nt - 2);
            const char* a1 = cA + (size_t)(t + 1) * kstep;
            const char* a2 = last ? nA : cA + (size_t)(t + 2) * kstep; const char* b2 = last ? nB : cB + (size_t)(t + 2) * kstep;
            const char* a3 = a2 + kstep; const char* b3 = b2 + kstep;
            if (last && has_next) S.a_ready(nxt);
            if constexpr (SP2) {
            PG8_LDB(B0, 0, 0); PG8_LDB(B1, 0, 1); PG8_SCHED; PG8_LDA(At, 0, 0); PG8_STAGE(PG8_SA(1, 1), a1 + hstep, voffA);
            PG8_WAIT_V(8); PG8_WAIT_L(0); PG8_BAR; PG8_MMA(0, 0, At, B0); PG8_MMA(0, 1, At, B1); PG8_BAR; PG8_SCHED;
            PG8_LDA(At, 0, 1); PG8_STAGE(PG8_SB(0, 0), b2, voffB); PG8_STAGE(PG8_SB(0, 1), b2 + hstepB, voffB); PG8_STAGE(PG8_SA(0, 0), a2, voffA);
            PG8_WAIT_V(8); PG8_WAIT_L(0); PG8_BAR; PG8_MMA(1, 0, At, B0); PG8_MMA(1, 1, At, B1); PG8_BAR; PG8_SCHED;
            PG8_LDB(B0, 1, 0); PG8_LDB(B1, 1, 1); PG8_SCHED; PG8_LDA(At, 1, 0); PG8_STAGE(PG8_SA(0, 1), a2 + hstep, voffA);
            PG8_WAIT_V(8); PG8_WAIT_L(0); PG8_BAR; PG8_MMA(0, 0, At, B0); PG8_MMA(0, 1, At, B1); PG8_BAR; PG8_SCHED;
            PG8_LDA(At, 1, 1); PG8_STAGE(PG8_SB(1, 0), b3, voffB); PG8_STAGE(PG8_SB(1, 1), b3 + hstepB, voffB); PG8_STAGE(PG8_SA(1, 0), a3, voffA);
            PG8_WAIT_V(8); PG8_WAIT_L(0); PG8_BAR; PG8_MMA(1, 0, At, B0); PG8_MMA(1, 1, At, B1); PG8_BAR; PG8_SCHED;
            } else {
            PG8_LDB(B0, 0, 0); PG8_SCHED; PG8_LDA(At, 0, 0); PG8_STAGE(PG8_SA(1, 1), a1 + hstep, voffA);
            PG8_WAIT_L(8); PG8_BAR; PG8_WAIT_L(0); PG8_MMA(0, 0, At, B0); PG8_BAR; PG8_SCHED;
            PG8_LDB(B1, 0, 1); PG8_STAGE(PG8_SB(0, 0), b2, voffB);
            PG8_BAR; PG8_WAIT_L(0); PG8_MMA(0, 1, At, B1); PG8_BAR;
            PG8_LDA(At, 0, 1); PG8_STAGE(PG8_SA(0, 0), a2, voffA);
            PG8_BAR; PG8_WAIT_L(0); PG8_MMA(1, 0, At, B0); PG8_BAR; PG8_SCHED;
            PG8_STAGE(PG8_SB(0, 1), b2 + hstepB, voffB);
            PG8_WAIT_V(6); PG8_BAR; PG8_MMA(1, 1, At, B1); PG8_BAR;
            PG8_LDB(B0, 1, 0); PG8_SCHED; PG8_LDA(At, 1, 0); PG8_STAGE(PG8_SA(0, 1), a2 + hstep, voffA);
            PG8_WAIT_L(8); PG8_BAR; PG8_WAIT_L(0); PG8_MMA(0, 0, At, B0); PG8_BAR; PG8_SCHED;
            PG8_LDB(B1, 1, 1); PG8_STAGE(PG8_SB(1, 0), b3, voffB);
            PG8_BAR; PG8_WAIT_L(0); PG8_MMA(0, 1, At, B1); PG8_BAR;
            PG8_LDA(At, 1, 1); PG8_STAGE(PG8_SA(1, 0), a3, voffA);
            PG8_BAR; PG8_WAIT_L(0); PG8_MMA(1, 0, At, B0); PG8_BAR; PG8_SCHED;
            PG8_STAGE(PG8_SB(1, 1), b3 + hstepB, voffB);
            PG8_WAIT_V(6); PG8_BAR; PG8_MMA(1, 1, At, B1); PG8_BAR;
            }
        }
        if constexpr (ALIGN_EPI) { if (wr == 0) PG8_BAR; }
        if constexpr (!Epi::AFTER_DRAIN) { E(acc, cur, wr, wc, fr, fq); S.done(cur); }
        if (!has_next) break;
#pragma unroll
        for (int a = 0; a < 2; ++a)
#pragma unroll
            for (int b = 0; b < 2; ++b)
#pragma unroll
                for (int m = 0; m < 4; ++m)
#pragma unroll
                    for (int n = 0; n < 2; ++n) acc[a][b][m][n] = (f32x4){0.f, 0.f, 0.f, 0.f};
        cur = nxt; cA = nA; cB = nB; ++ui;
        if constexpr (ALIGN_EPI) { if (wr == 1) PG8_BAR; }
    }
    PG8_WAIT_V(0);
    if constexpr (!ALIGN_EPI) { if (wr == 0) PG8_BAR; }
    PG8_BAR;
    if constexpr (Epi::AFTER_DRAIN) { E.fused(acc, cur, wr, wc, fr, fq, lds, wid, lane); S.done(cur); }
#undef PG8_SA
#undef PG8_SB
#undef PG8_STAGE
#undef PG8_LDA
#undef PG8_LDB
#undef PG8_MMA
#undef PG8_WAIT_V
#undef PG8_WAIT_L
#undef PG8_BAR
#undef PG8_SCHED
}
}
#include <cmath>
namespace att {
typedef unsigned short bf16;
using bf16x8 = __attribute__((ext_vector_type(8))) short;
using s16x4 = __attribute__((ext_vector_type(4))) short;
using f32x16 = __attribute__((ext_vector_type(16))) float;
using f32x4 = __attribute__((ext_vector_type(4))) float;
using u32x4 = __attribute__((ext_vector_type(4))) unsigned;
#define ALAS __attribute__((address_space(3)))
constexpr int SEQ = 2048, D = 64, DM = 1024, NW = 8, QBLK = 32, QB = QBLK * NW, KVBLK = 64, NQB = SEQ / QB;
constexpr int NSLOT = 3, SLOTB = 8192;
constexpr int LDS_K = 0, LDS_V = NSLOT * SLOTB, LDS_WS = 2 * NSLOT * SLOTB, LDS_OST = LDS_WS + NW * 64 * 4, LDS_E = LDS_OST + NW * 4096  , LDS_TAB = LDS_E + 2048 * 4  , LDS_OFFS = LDS_TAB + 640 * 4, LDS_KX = LDS_OFFS + 512  , LDS_BYTES = LDS_KX + 2048 * 8 + 16;
constexpr float LOG2E = 1.4426950408889634f;
constexpr float C2 = 0.125f * LOG2E;
__device__ __forceinline__ int crow(int r, int hi) { return (r & 3) + 8 * (r >> 2) + 4 * hi; }
#define SBAR() __builtin_amdgcn_sched_barrier(0)
__device__ __forceinline__ void glds16(const void* gsrc, unsigned lds_dst) { unsigned keep;
  asm volatile("s_mov_b32 %0, m0\n\ts_mov_b32 m0, %2\n\ts_nop 0\n\tglobal_load_lds_dwordx4 %1, off\n\ts_mov_b32 m0, %0" : "=&s"(keep) : "v"(gsrc), "s"(lds_dst) : "memory"); }
typedef float f32x2_t __attribute__((ext_vector_type(2))); typedef __bf16 bf16x2_t __attribute__((ext_vector_type(2)));
__device__ __forceinline__ unsigned cvtpk_s(float lo, float hi) { f32x2_t v = {lo, hi}; bf16x2_t b = __builtin_convertvector(v, bf16x2_t); return __builtin_bit_cast(unsigned, b); }
#define WAIT_BAR(N) asm volatile("s_waitcnt vmcnt(" #N ") lgkmcnt(0)\n\ts_barrier" ::: "memory")
typedef ALAS const char* lds_cptr;
typedef short v4i16_t __attribute__((ext_vector_type(4)));
#define MX3(a, b, c) __builtin_fmaxf(__builtin_fmaxf((a), (b)), (c))
__device__ __forceinline__ float rowmax(const f32x16& p0, const f32x16& p1) {
  float a = MX3(p0[0], p0[1], p1[0]), b = MX3(p0[2], p0[3], p1[1]); a = MX3(a, p1[2], p1[3]);
#pragma unroll
  for (int r = 4; r < 16; r += 4) { a = MX3(a, p0[r], p0[r + 1]); b = MX3(b, p0[r + 2], p0[r + 3]); a = MX3(a, p1[r], p1[r + 1]); b = MX3(b, p1[r + 2], p1[r + 3]); }
  float m = __builtin_fmaxf(a, b); auto rr = __builtin_amdgcn_permlane32_swap(__float_as_uint(m), __float_as_uint(m), false, false);
  return __builtin_fmaxf(__uint_as_float(rr[0]), __uint_as_float(rr[1])); }
__device__ __forceinline__ void qkt(f32x16& p0, f32x16& p1, lds_cptr Kslot, const bf16x8* qr, const f32x16& cin, int r32, int hi) {
  lds_cptr kb = Kslot + hi * 1024 + r32 * 16;
#pragma unroll
  for (int d0 = 0; d0 < 4; ++d0) {
    const bf16x8 b0 = *(const ALAS bf16x8*)(kb + d0 * 2048);
    const bf16x8 b1 = *(const ALAS bf16x8*)(kb + d0 * 2048 + 512);
    if (d0 == 0) { p0 = __builtin_amdgcn_mfma_f32_32x32x16_bf16(b0, qr[0], cin, 0, 0, 0); p1 = __builtin_amdgcn_mfma_f32_32x32x16_bf16(b1, qr[0], cin, 0, 0, 0); }
    else { p0 = __builtin_amdgcn_mfma_f32_32x32x16_bf16(b0, qr[d0], p0, 0, 0, 0); p1 = __builtin_amdgcn_mfma_f32_32x32x16_bf16(b1, qr[d0], p1, 0, 0, 0); } }
}
__device__ __forceinline__ void pv(f32x16* o, int vb, bf16x8 pa0, bf16x8 pa1, bf16x8 pa2, bf16x8 pa3) {
#pragma unroll
  for (int d0 = 0; d0 < 2; ++d0) { s16x4 lo[4], hi[4];
#pragma unroll
    for (int ks = 0; ks < 4; ++ks) {
      asm volatile("ds_read_b64_tr_b16 %0,%1 offset:%c2" : "=&v"(lo[ks]) : "v"(vb), "i"(d0 * 4096 + ks * 1024) : "memory");
      asm volatile("ds_read_b64_tr_b16 %0,%1 offset:%c2" : "=&v"(hi[ks]) : "v"(vb), "i"(d0 * 4096 + ks * 1024 + 512) : "memory"); }
    asm volatile("s_waitcnt lgkmcnt(0)" ::: "memory"); SBAR();
#define PK(k) (bf16x8){lo[k][0], lo[k][1], lo[k][2], lo[k][3], hi[k][0], hi[k][1], hi[k][2], hi[k][3]}
    o[d0] = __builtin_amdgcn_mfma_f32_32x32x16_bf16(pa0, PK(0), o[d0], 0, 0, 0);
    o[d0] = __builtin_amdgcn_mfma_f32_32x32x16_bf16(pa1, PK(1), o[d0], 0, 0, 0);
    o[d0] = __builtin_amdgcn_mfma_f32_32x32x16_bf16(pa2, PK(2), o[d0], 0, 0, 0);
    o[d0] = __builtin_amdgcn_mfma_f32_32x32x16_bf16(pa3, PK(3), o[d0], 0, 0, 0);
#undef PK
  }
}
__device__ __forceinline__ int t5_bucket(int d) {
  if (d < 16) return d;
  const int b = 16 + (int)(__logf((float)d * (1.0f / 16.0f)) * (16.0f / 2.0794415416798357f));
  return b < 31 ? b : 31;
}
struct AttnAux { const float* rel_bias; const float* sinks; const float* CL; const float* CT; };

template <int MODE> __device__ __forceinline__ void attn_unit_v1(int b, int h, int qb, const bf16* Q, const bf16* __restrict__ K, const bf16* __restrict__ V, bf16* O, ALAS char* shm, const AttnAux& ax) {
  constexpr int KP = MODE == 0 ? 256 : 1024;
  int tid_ = threadIdx.x; asm volatile("" : "+v"(tid_));
  const int tid = tid_, lane = tid & 63, r32 = lane & 31, hi = lane >> 5; const int wid = __builtin_amdgcn_readfirstlane(tid >> 6);
  const int kvh = MODE == 0 ? (h >> 2) : h;
  const long rowbase = 0; const int q0 = qb * QB;
  const bf16* Qw = Q + (rowbase + q0 + wid * QBLK) * DM + h * D;
  const bf16* Kh = K + rowbase * KP + kvh * D, *Vh = V + rowbase * KP + kvh * D;
  const unsigned lds0 = (unsigned)(uintptr_t)shm;
  ALAS float* wsf = (ALAS float*)(shm + LDS_WS) + wid * 64;
  ALAS float* Ef = (ALAS float*)(shm + LDS_E);
  ALAS float* TAB = (ALAS float*)(shm + LDS_TAB);
  ALAS float* OFFS = (ALAS float*)(shm + LDS_OFFS);
  const bf16* ksrc = Kh + (long)lane * KP + wid * 8;
  const bf16* vsrc = Vh + (long)(16 * (wid & 3) + (lane >> 2)) * KP + (wid >> 2) * 32 + (lane & 3) * 8;
  const unsigned kdst = lds0 + LDS_K + wid * 1024, vdst = lds0 + LDS_V + wid * 1024;
#define DMA_K(t, slot) glds16(ksrc + (long)(t) * KVBLK * KP, (unsigned)__builtin_amdgcn_readfirstlane(kdst + (slot)))
#define DMA_V(t, slot) glds16(vsrc + (long)(t) * KVBLK * KP, (unsigned)__builtin_amdgcn_readfirstlane(vdst + (slot)))
  const int vb0 = (int)(lds0 + LDS_V) + ((lane >> 4) & 1) * 32 + (lane & 3) * 8 + (4 * hi + ((lane & 15) >> 2)) * 64;
  const lds_cptr Kbase = (lds_cptr)shm + LDS_K;
  const int t_lo = MODE == 0 ? (qb > 0 ? 4 * qb - 2 : 0) : 0, t_hi = 4 * qb + 3;
  bf16x8 qr[4];
#pragma unroll
  for (int d0 = 0; d0 < 4; ++d0) qr[d0] = *reinterpret_cast<const bf16x8*>(&Qw[(long)r32 * DM + d0 * 16 + hi * 8]);
  float mhat, l_reg; f32x16 o[2]; o[0] = f32x16{}; o[1] = f32x16{};
  const int qg = q0 + wid * QBLK + r32;
  bf16x8 qx = bf16x8{};
  if (MODE == 0) {
    { const int dist = tid - 256; float v = -INFINITY;
      if (dist >= 0 && dist < 128) v = ax.rel_bias[t5_bucket(dist) * 16 + h] * LOG2E;
      TAB[tid] = v; if (tid < 128) TAB[512 + tid] = -INFINITY; }
    mhat = ax.sinks[h] * LOG2E; l_reg = hi == 0 ? 1.0f : 0.0f;
  } else {
    if (wid == 0) { float v = (lane <= t_hi) ? ax.CT[(size_t)(b * 16 + h) * 32 + (lane & 31)] : 0.f; if (lane >= 32) v = 0.f; float inc = v;
#pragma unroll
      for (int s = 1; s < 32; s <<= 1) { const float uu = __shfl_up(inc, s); if (lane >= s) inc += uu; }
      if (lane < 32) OFFS[lane] = inc - v; }
    asm volatile("s_waitcnt lgkmcnt(0)\n\ts_barrier" ::: "memory");
    const float* cl = ax.CL + (size_t)(b * 16 + h) * SEQ;
    for (int k = tid; k < (t_hi + 1) * 64; k += 512) Ef[k] = -(cl[k] + OFFS[k >> 6]);
    mhat = -INFINITY; l_reg = 0.f;
    if (hi == 0) { qx[0] = 0x3F80; qx[1] = 0x3F80; qx[2] = 0x3F80; }
  }
  f32x16 zero16 = f32x16{}; asm volatile("" : "+v"(zero16));
  DMA_K(t_lo, 0); DMA_V(t_lo, 0);
  for (int t = t_lo; t <= t_hi; ++t) {
    const int sl = ((t - t_lo) & 1) * SLOTB;
    WAIT_BAR(0);
    if (t < t_hi) { DMA_K(t + 1, sl ^ SLOTB); DMA_V(t + 1, sl ^ SLOTB); }
    if (MODE == 0) {
      const int qw = q0 + wid * QBLK;
      if (64 * t > qw + 31 || 64 * t + 63 < qw - 127) continue;
    }
    f32x16 p0, p1;
    qkt(p0, p1, Kbase + sl, qr, zero16, r32, hi);
    if (MODE == 1) {
      bf16x8 kx0 = bf16x8{}, kx1 = bf16x8{};
      const float e0 = Ef[64 * t + r32], e1 = Ef[64 * t + 32 + r32];
      if (hi == 0) {
        { const unsigned a = cvtpk_s(e0, 0.f) & 0xffffu; const float r1 = e0 - __uint_as_float(a << 16); const unsigned bb = cvtpk_s(r1, 0.f) & 0xffffu; const float r2 = r1 - __uint_as_float(bb << 16); const unsigned c = cvtpk_s(r2, 0.f) & 0xffffu;
          kx0[0] = (short)a; kx0[1] = (short)bb; kx0[2] = (short)c; }
        { const unsigned a = cvtpk_s(e1, 0.f) & 0xffffu; const float r1 = e1 - __uint_as_float(a << 16); const unsigned bb = cvtpk_s(r1, 0.f) & 0xffffu; const float r2 = r1 - __uint_as_float(bb << 16); const unsigned c = cvtpk_s(r2, 0.f) & 0xffffu;
          kx1[0] = (short)a; kx1[1] = (short)bb; kx1[2] = (short)c; }
      }
      p0 = __builtin_amdgcn_mfma_f32_32x32x16_bf16(kx0, qx, p0, 0, 0, 0); p1 = __builtin_amdgcn_mfma_f32_32x32x16_bf16(kx1, qx, p1, 0, 0, 0);
      if (t >= 4 * qb) {
        const int kb = 64 * t + 4 * hi;
#pragma unroll
        for (int r = 0; r < 16; ++r) { const int kv = kb + (r & 3) + 8 * (r >> 2); if (kv > qg) p0[r] = -INFINITY; if (kv + 32 > qg) p1[r] = -INFINITY; }
      }
    } else {
      const int ib = 256 + qg - 64 * t - 4 * hi;
#pragma unroll
      for (int g = 0; g < 4; ++g) { const int idx = ib - 8 * g; f32x4 t0 = {TAB[idx], TAB[idx - 1], TAB[idx - 2], TAB[idx - 3]}, t1 = {TAB[idx - 32], TAB[idx - 33], TAB[idx - 34], TAB[idx - 35]};
        asm volatile("" : "+v"(t0), "+v"(t1));
#pragma unroll
        for (int e = 0; e < 4; ++e) { p0[4 * g + e] += t0[e]; p1[4 * g + e] += t1[e]; } }
    }
    const float rm = rowmax(p0, p1);
    const float mn = __builtin_fmaxf(mhat, rm), f = __builtin_amdgcn_exp2f(mhat - mn); mhat = mn;
    float sacc = 0.f;
#pragma unroll
    for (int r = 0; r < 16; ++r) { p0[r] = __builtin_amdgcn_exp2f(p0[r] - mn); p1[r] = __builtin_amdgcn_exp2f(p1[r] - mn); sacc += p0[r] + p1[r]; }
    l_reg = l_reg * f + sacc;
    if (hi == 0) wsf[r32] = f;
    asm volatile("s_waitcnt lgkmcnt(0)" ::: "memory");
#pragma unroll
    for (int d_ = 0; d_ < 2; ++d_)
#pragma unroll
      for (int r = 0; r < 16; ++r) o[d_][r] *= wsf[crow(r, hi)];
    u32x4 pw0, pw1, pw2, pw3;
#define PKW(P, B) cvtpk_s(P[B], P[B + 1])
    pw0 = (u32x4){PKW(p0, 0), PKW(p0, 2), PKW(p0, 4), PKW(p0, 6)}; pw1 = (u32x4){PKW(p0, 8), PKW(p0, 10), PKW(p0, 12), PKW(p0, 14)};
    pw2 = (u32x4){PKW(p1, 0), PKW(p1, 2), PKW(p1, 4), PKW(p1, 6)}; pw3 = (u32x4){PKW(p1, 8), PKW(p1, 10), PKW(p1, 12), PKW(p1, 14)};
#undef PKW
    SBAR(); pv(o, vb0 + sl, __builtin_bit_cast(bf16x8, pw0), __builtin_bit_cast(bf16x8, pw1), __builtin_bit_cast(bf16x8, pw2), __builtin_bit_cast(bf16x8, pw3));
  }
  { auto rr = __builtin_amdgcn_permlane32_swap(__float_as_uint(l_reg), __float_as_uint(l_reg), false, false); l_reg = __uint_as_float(rr[0]) + __uint_as_float(rr[1]); }
  if (hi == 0) wsf[32 + r32] = l_reg;
  asm volatile("s_waitcnt lgkmcnt(0)" ::: "memory");
  float rli[16];
#pragma unroll
  for (int r = 0; r < 16; ++r) rli[r] = __builtin_amdgcn_rcpf(wsf[32 + crow(r, hi)]);
  bf16* Ow = O + (rowbase + q0 + wid * QBLK) * DM + h * D;
  { ALAS bf16* stg = (ALAS bf16*)(shm + LDS_OST) + wid * 2048;
#pragma unroll
    for (int r = 0; r < 16; ++r) { const int orow = crow(r, hi);
#pragma unroll
      for (int d0 = 0; d0 < 2; ++d0) stg[orow * 64 + d0 * 32 + r32] = (bf16)(cvtpk_s(o[d0][r] * rli[r], 0.f) & 0xffffu); }
    asm volatile("s_waitcnt lgkmcnt(0)" ::: "memory");
#pragma unroll
    for (int i = 0; i < 4; ++i) { const int row = i * 8 + (lane >> 3), ch = lane & 7; const u32x4 v = *(const ALAS u32x4*)(stg + row * 64 + ch * 8); *(u32x4*)(Ow + (long)row * DM + ch * 8) = v; } }
  asm volatile("s_waitcnt lgkmcnt(0)\n\ts_barrier" ::: "memory");
#undef DMA_K
#undef DMA_V
}

__device__ __forceinline__ void attn_swa_sweep(int h, int half, const bf16* Q, const bf16* __restrict__ K, const bf16* __restrict__ V, bf16* O, ALAS char* shm, const AttnAux& ax) {
  constexpr int KP = 256, NS = 4, NPAIR = 9;
  constexpr int S_K = 0, S_V = NS * SLOTB, S_WS = 2 * NS * SLOTB, S_QST = S_WS + NW * 64 * 4, S_OST = S_QST + NW * 4096, S_TAB = S_OST + NW * 1024;
  static_assert(S_TAB + 640 * 4 <= 131072, "sweep scratch inside the 128 KiB ring region");
  int tid_ = threadIdx.x; asm volatile("" : "+v"(tid_));
  const int tid = tid_, lane = tid & 63, r32 = lane & 31, hi = lane >> 5; const int wid = __builtin_amdgcn_readfirstlane(tid >> 6);
  const int kvh = h >> 2, R0 = 1024 * half, T0 = R0 / 64 - 2;
  const int j0 = (wid & 1) | ((wid & 2) << 1) | ((wid & 4) >> 1), a0 = j0 >> 2; const bool kodd = ((j0 >> 1) & 1) != 0;
  const bf16* Kh = K + kvh * D, *Vh = V + kvh * D;
  const unsigned lds0 = (unsigned)(uintptr_t)shm;
  ALAS float* wsf = (ALAS float*)(shm + S_WS) + wid * 64;
  ALAS float* TAB = (ALAS float*)(shm + S_TAB);
  const bf16* ksrc = Kh + (long)lane * KP + wid * 8;
  const bf16* vsrc = Vh + (long)(16 * (wid & 3) + (lane >> 2)) * KP + (wid >> 2) * 32 + (lane & 3) * 8;
  const unsigned kdst = lds0 + S_K + wid * 1024, vdst = lds0 + S_V + wid * 1024;
#define DMA_KV(s_) do { const int t__ = T0 + (s_) < 0 ? 0 : T0 + (s_); const int sl__ = ((s_) & (NS - 1)) * SLOTB; glds16(ksrc + (long)t__ * KVBLK * KP, (unsigned)__builtin_amdgcn_readfirstlane(kdst + sl__)); \
                        glds16(vsrc + (long)t__ * KVBLK * KP, (unsigned)__builtin_amdgcn_readfirstlane(vdst + sl__)); } while (0)
  const int vb0 = (int)(lds0 + S_V) + ((lane >> 4) & 1) * 32 + (lane & 3) * 8 + (4 * hi + ((lane & 15) >> 2)) * 64;
  const lds_cptr Kbase = (lds_cptr)shm + S_K;
  const bf16* qsrc = Q + (long)(R0 + 32 * j0 + (lane >> 3)) * DM + h * D + (((lane & 7) ^ ((lane >> 3) & 7)) * 8);
  const unsigned qdst = lds0 + S_QST + wid * 4096;
#define QDMA(blk) do { const bf16* q__ = qsrc + (long)(blk) * 256 * DM; \
    glds16(q__, (unsigned)__builtin_amdgcn_readfirstlane(qdst)); glds16(q__ + 8 * DM, (unsigned)__builtin_amdgcn_readfirstlane(qdst + 1024)); \
    glds16(q__ + 16 * DM, (unsigned)__builtin_amdgcn_readfirstlane(qdst + 2048)); glds16(q__ + 24 * DM, (unsigned)__builtin_amdgcn_readfirstlane(qdst + 3072)); } while (0)
  const lds_cptr qrd = (lds_cptr)shm + S_QST + wid * 4096 + r32 * 128;
  asm volatile("s_waitcnt lgkmcnt(0)\n\ts_barrier" ::: "memory");
  QDMA(0); DMA_KV(0); DMA_KV(1);
  { const int dist = tid - 256; float v = -INFINITY;
    if (dist >= 0 && dist < 128) v = ax.rel_bias[t5_bucket(dist) * 16 + h] * LOG2E;
    TAB[tid] = v; if (tid < 128) TAB[512 + tid] = -INFINITY; }
  const float sink2 = ax.sinks[h] * LOG2E;
  bf16* Ow = O + (long)(R0 + 32 * j0) * DM + h * D;
  bf16x8 qr[4]; qr[0] = bf16x8{}; qr[1] = bf16x8{}; qr[2] = bf16x8{}; qr[3] = bf16x8{};
  float mhat = 0.f, l_reg = 0.f; f32x16 o[2]; o[0] = f32x16{}; o[1] = f32x16{}; int qg = 0;
  f32x16 zero16 = f32x16{}; asm volatile("" : "+v"(zero16));
  for (int P = 0; P <= NPAIR; ++P) {
    if (P < NPAIR) {
      asm volatile("s_waitcnt vmcnt(0) lgkmcnt(0)\n\ts_barrier" ::: "memory");
      if (P + 1 < NPAIR) { DMA_KV(2 * P + 2); DMA_KV(2 * P + 3); }
    }
    const int q = P - a0;
    if (q < 0 || q > 8) continue;
    const bool second = (q & 1) != 0;
    if (!second) {
      if (q >= 2) {
        const int u = (q >> 1) - 1;
        { auto rr = __builtin_amdgcn_permlane32_swap(__float_as_uint(l_reg), __float_as_uint(l_reg), false, false); l_reg = __uint_as_float(rr[0]) + __uint_as_float(rr[1]); }
        if (hi == 0) wsf[32 + r32] = l_reg;
        asm volatile("s_waitcnt lgkmcnt(0)" ::: "memory");
        ALAS bf16* stg = (ALAS bf16*)(shm + S_OST) + wid * 512;
        bf16* Ob = Ow + (long)u * 256 * DM + (long)(lane >> 3) * DM + (lane & 7) * 8;
#pragma unroll
        for (int i = 0; i < 4; ++i) {
#pragma unroll
          for (int rr = 0; rr < 4; ++rr) { const int r = 4 * i + rr; const float rl = __builtin_amdgcn_rcpf(wsf[32 + crow(r, hi)]);
#pragma unroll
            for (int d0 = 0; d0 < 2; ++d0) stg[(rr + 4 * hi) * 64 + d0 * 32 + r32] = (bf16)(cvtpk_s(o[d0][r] * rl, 0.f) & 0xffffu); }
          asm volatile("s_waitcnt lgkmcnt(0)" ::: "memory");
          const u32x4 v = *(const ALAS u32x4*)(stg + lane * 8);
          asm volatile("s_waitcnt lgkmcnt(0)" ::: "memory");
          *(u32x4*)(Ob + (long)(8 * i) * DM) = v;
        }
      }
      if (q == 8) continue;
      const int u = q >> 1;
#pragma unroll
      for (int d0 = 0; d0 < 4; ++d0) qr[d0] = *(const ALAS bf16x8*)(qrd + (((2 * d0 + hi) ^ (r32 & 7)) * 16));
      asm volatile("s_waitcnt lgkmcnt(0)" ::: "memory");
      if (u < 3) QDMA(u + 1);
      mhat = sink2; l_reg = hi == 0 ? 1.0f : 0.0f; o[0] = f32x16{}; o[1] = f32x16{};
      qg = R0 + 32 * (j0 + 8 * u) + r32;
    }
    for (int e = 0; e < 2; ++e) {
      if (e == 0 ? (kodd && !second) : (!kodd && second)) continue;
      const int s = 2 * P + e, t = T0 + s;
      if (t < 0) continue;
      const int sl = (s & (NS - 1)) * SLOTB;
      f32x16 p0, p1;
      { const int ib = 256 + qg - 64 * t - 4 * hi;
#pragma unroll
        for (int g = 0; g < 4; ++g) { const int idx = ib - 8 * g; f32x4 t0 = {TAB[idx], TAB[idx - 1], TAB[idx - 2], TAB[idx - 3]}, t1 = {TAB[idx - 32], TAB[idx - 33], TAB[idx - 34], TAB[idx - 35]};
          asm volatile("" : "+v"(t0), "+v"(t1));
#pragma unroll
          for (int ee = 0; ee < 4; ++ee) { p0[4 * g + ee] = t0[ee] - mhat; p1[4 * g + ee] = t1[ee] - mhat; } } }
      { lds_cptr kb = Kbase + sl + hi * 1024 + r32 * 16;
#pragma unroll
        for (int d0 = 0; d0 < 4; ++d0) { const bf16x8 b0 = *(const ALAS bf16x8*)(kb + d0 * 2048), b1 = *(const ALAS bf16x8*)(kb + d0 * 2048 + 512);
          p0 = __builtin_amdgcn_mfma_f32_32x32x16_bf16(b0, qr[d0], p0, 0, 0, 0); p1 = __builtin_amdgcn_mfma_f32_32x32x16_bf16(b1, qr[d0], p1, 0, 0, 0); } }
      const float rm = rowmax(p0, p1);
      const bool mv = rm > 8.0f;
      if (__builtin_expect(__any(mv), 0)) {
        const float dl = mv ? rm : 0.f, f = __builtin_amdgcn_exp2f(-dl); mhat += dl;
#pragma unroll
        for (int r = 0; r < 16; ++r) { p0[r] -= dl; p1[r] -= dl; }
        l_reg *= f;
        if (hi == 0) wsf[r32] = f;
        asm volatile("s_waitcnt lgkmcnt(0)" ::: "memory");
#pragma unroll
        for (int d_ = 0; d_ < 2; ++d_)
#pragma unroll
          for (int r = 0; r < 16; ++r) o[d_][r] *= wsf[crow(r, hi)];
      }
      float sa0 = 0.f, sa1 = 0.f;
#pragma unroll
      for (int r = 0; r < 16; ++r) { p0[r] = __builtin_amdgcn_exp2f(p0[r]); p1[r] = __builtin_amdgcn_exp2f(p1[r]); sa0 += p0[r]; sa1 += p1[r]; }
      l_reg += sa0 + sa1;
      u32x4 pw0, pw1, pw2, pw3;
#define PKW(P_, B) cvtpk_s(P_[B], P_[B + 1])
      pw0 = (u32x4){PKW(p0, 0), PKW(p0, 2), PKW(p0, 4), PKW(p0, 6)}; pw1 = (u32x4){PKW(p0, 8), PKW(p0, 10), PKW(p0, 12), PKW(p0, 14)};
      pw2 = (u32x4){PKW(p1, 0), PKW(p1, 2), PKW(p1, 4), PKW(p1, 6)}; pw3 = (u32x4){PKW(p1, 8), PKW(p1, 10), PKW(p1, 12), PKW(p1, 14)};
#undef PKW
      SBAR(); pv(o, vb0 + sl, __builtin_bit_cast(bf16x8, pw0), __builtin_bit_cast(bf16x8, pw1), __builtin_bit_cast(bf16x8, pw2), __builtin_bit_cast(bf16x8, pw3));
    }
  }
#undef DMA_KV
#undef QDMA
}

__device__ __forceinline__ void kload8(bf16x8* kf, lds_cptr kp) {
  kf[0] = *(const ALAS bf16x8*)(kp);        kf[1] = *(const ALAS bf16x8*)(kp + 512);
  kf[2] = *(const ALAS bf16x8*)(kp + 2048); kf[3] = *(const ALAS bf16x8*)(kp + 2560);
  kf[4] = *(const ALAS bf16x8*)(kp + 4096); kf[5] = *(const ALAS bf16x8*)(kp + 4608);
  kf[6] = *(const ALAS bf16x8*)(kp + 6144); kf[7] = *(const ALAS bf16x8*)(kp + 6656);
}
__device__ __forceinline__ void kload2(bf16x8* kf, lds_cptr kp, int j) { kf[2 * j] = *(const ALAS bf16x8*)(kp + j * 2048); kf[2 * j + 1] = *(const ALAS bf16x8*)(kp + j * 2048 + 512); }
__device__ __forceinline__ s16x4 vtr(lds_cptr p) { return __builtin_bit_cast(s16x4, __builtin_amdgcn_ds_read_tr16_b64_v4i16((ALAS v4i16_t*)p)); }
__device__ __forceinline__ void cmask(f32x16& p0, f32x16& p1, int jb, int qrel, int hi) {
  const int kb = 64 * jb + 4 * hi;
#pragma unroll
  for (int r = 0; r < 16; ++r) { const int kv = kb + (r & 3) + 8 * (r >> 2); if (kv > qrel) p0[r] = -INFINITY; if (kv + 32 > qrel) p1[r] = -INFINITY; }
}
__device__ __forceinline__ bf16x8 kx_frag(float e, int hi) {
  const unsigned a = cvtpk_s(e, 0.f) & 0xffffu; const float r1 = e - __uint_as_float(a << 16);
  const unsigned bb = cvtpk_s(r1, 0.f) & 0xffffu; const float r2 = r1 - __uint_as_float(bb << 16);
  const unsigned c = cvtpk_s(r2, 0.f) & 0xffffu;
  u32x4 w = {hi == 0 ? (a | (bb << 16)) : 0u, hi == 0 ? (c | 0x3F800000u) : 0u, hi == 0 ? 0x3F803F80u : 0u, 0u};
  return __builtin_bit_cast(bf16x8, w);
}
__device__ __forceinline__ bf16x8 qx_frag(float nm, int hi) {
  const unsigned a = cvtpk_s(nm, 0.f) & 0xffffu; const float r1 = nm - __uint_as_float(a << 16);
  const unsigned bb = cvtpk_s(r1, 0.f) & 0xffffu; const float r2 = r1 - __uint_as_float(bb << 16);
  const unsigned c = cvtpk_s(r2, 0.f) & 0xffffu;
  u32x4 w = {hi == 0 ? 0x3F803F80u : 0u, hi == 0 ? (0x3F80u | (a << 16)) : 0u, hi == 0 ? (bb | (c << 16)) : 0u, 0u};
  return __builtin_bit_cast(bf16x8, w);
}

template <int MODE, int THRL> __device__ __forceinline__ void attn_unit_v2(int b, int h, int qb, const bf16* Q, const bf16* __restrict__ K, const bf16* __restrict__ V, bf16* O, ALAS char* shm, const AttnAux& ax, bool stage) {
  constexpr int KP = MODE == 0 ? 256 : 1024;
  int tid_ = threadIdx.x; asm volatile("" : "+v"(tid_));
  const int tid = tid_, lane = tid & 63, r32 = lane & 31, hi = lane >> 5; const int wid = __builtin_amdgcn_readfirstlane(tid >> 6);
  const int kvh = MODE == 0 ? (h >> 2) : h;
  const long rowbase = 0; const int q0 = qb * QB;
  const int tb = MODE == 0 ? (qb > 0 ? 4 * qb - 2 : 0) : 0; const int NT = 4 * qb + 4 - tb;
  const bf16* Qw = Q + (rowbase + q0 + wid * QBLK) * DM + h * D;
  const bf16* Kh = K + (rowbase + (long)tb * KVBLK) * KP + kvh * D, *Vh = V + (rowbase + (long)tb * KVBLK) * KP + kvh * D;
  const unsigned lds0 = (unsigned)(uintptr_t)shm;
  ALAS float* wsf = (ALAS float*)(shm + LDS_WS) + wid * 64;
  ALAS float* Ef = (ALAS float*)(shm + LDS_E);
  ALAS float* TAB = (ALAS float*)(shm + LDS_TAB);
  ALAS float* OFFS = (ALAS float*)(shm + LDS_OFFS);
  typedef unsigned u32x2_t __attribute__((ext_vector_type(2)));
  ALAS u32x2_t* KX = (ALAS u32x2_t*)(shm + LDS_KX);
  const int kxi = hi == 0 ? r32 : SEQ, kxs = hi == 0 ? 64 : 0, kxh = hi == 0 ? 32 : 0; const unsigned kxc = hi == 0 ? 0x3F803F80u : 0u;
  const bf16* ksrc = Kh + (long)lane * KP + wid * 8;
  const bf16* vsrc = Vh + (long)(16 * (wid & 3) + (lane >> 2)) * KP + (wid >> 2) * 32 + (lane & 3) * 8;
  const unsigned kdst = lds0 + LDS_K + wid * 1024, vdst = lds0 + LDS_V + wid * 1024;
#define DMA_K(t, slot) glds16(ksrc + (long)(t) * KVBLK * KP, (unsigned)__builtin_amdgcn_readfirstlane(kdst + (slot)))
#define DMA_V(t, slot) glds16(vsrc + (long)(t) * KVBLK * KP, (unsigned)__builtin_amdgcn_readfirstlane(vdst + (slot)))
  const int vb0 = (int)(lds0 + LDS_V) + ((lane >> 4) & 1) * 32 + (lane & 3) * 8 + (4 * hi + ((lane & 15) >> 2)) * 64;
  const lds_cptr shm3 = (lds_cptr)shm; const lds_cptr kp0 = shm3 + LDS_K + hi * 1024 + r32 * 16; const lds_cptr vp0 = shm3 + LDS_V + ((lane >> 4) & 1) * 32 + (lane & 3) * 8 + (4 * hi + ((lane & 15) >> 2)) * 64;
  bf16x8 kf[8];
  DMA_K(0, 0); DMA_V(0, 0); DMA_K(1, SLOTB);
  bf16x8 qr[4];
#pragma unroll
  for (int d0 = 0; d0 < 4; ++d0) qr[d0] = *reinterpret_cast<const bf16x8*>(&Qw[(long)r32 * DM + d0 * 16 + hi * 8]);
  const int qrel = wid * QBLK + r32, qg = q0 + qrel;
  bf16x8 qx = bf16x8{};
  if (MODE == 0) {
    for (int i = tid; i < 640; i += 512) { const int dist = i - 256; float v = -INFINITY;
      if (dist >= 0 && dist < 128) v = ax.rel_bias[t5_bucket(dist) * 16 + h] * LOG2E;
      TAB[i] = v; }
  } else if (stage) {
    if (wid == 0) { float v = ax.CT[(size_t)(b * 16 + h) * 32 + (lane & 31)]; if (lane >= 32) v = 0.f; float inc = v;
#pragma unroll
      for (int s = 1; s < 32; s <<= 1) { const float uu = __shfl_up(inc, s); if (lane >= s) inc += uu; }
      if (lane < 32) OFFS[lane] = inc - v; }
    asm volatile("s_waitcnt lgkmcnt(0)\n\ts_barrier" ::: "memory");
    const float* cl = ax.CL + (size_t)(b * 16 + h) * SEQ;
    for (int k = tid; k < SEQ; k += 512) { const float e = -(cl[k] + OFFS[k >> 6]); Ef[k] = e;
      const unsigned a = cvtpk_s(e, 0.f) & 0xffffu; const float r1 = e - __uint_as_float(a << 16);
      const unsigned bb = cvtpk_s(r1, 0.f) & 0xffffu; const float r2 = r1 - __uint_as_float(bb << 16);
      const unsigned c = cvtpk_s(r2, 0.f) & 0xffffu;
      KX[k] = (u32x2_t){a | (bb << 16), c | 0x3F800000u}; }
    if (tid == 0) KX[SEQ] = (u32x2_t){0u, 0u};
  }
  DMA_K(2, 2 * SLOTB);
  WAIT_BAR(3);
  float mhat, l_reg; f32x16 o[2]; o[0] = f32x16{}; o[1] = f32x16{};
  if (MODE == 0) { mhat = ax.sinks[h] * LOG2E; l_reg = hi == 0 ? 1.0f : 0.0f; }
  else { mhat = Ef[qg]; l_reg = 0.f; }
  f32x16 negm = f32x16{};
  if (MODE == 0) {
#pragma unroll
    for (int r = 0; r < 16; ++r) negm[r] = -mhat;
    asm volatile("" : "+v"(negm)); }
  else qx = qx_frag(-mhat, hi);
  bool resc = false;
  u32x2_t ec0 = {0u, 0u}, ec1 = {0u, 0u};
#define MASKB(C0, C1, t) do { if (MODE == 0) { const int ib_ = 256 + qg - 64 * (tb + (t)) - 4 * hi; \
      _Pragma("unroll") for (int r = 0; r < 16; ++r) { const int idx_ = ib_ - ((r & 3) + 8 * (r >> 2)); C0[r] += TAB[idx_]; C1[r] += TAB[idx_ - 32]; } } \
    else { const int jb_ = (t) - (NT - 4); if (jb_ >= 0) cmask(C0, C1, jb_, qrel, hi); } } while (0)
#define DECIDE(C0, C1) do { float a = MX3(C0[0], C0[1], C1[0]), b_ = MX3(C0[2], C0[3], C1[1]); a = MX3(a, C1[2], C1[3]); \
      _Pragma("unroll") for (int r = 4; r < 16; r += 4) { a = MX3(a, C0[r], C0[r + 1]); b_ = MX3(b_, C0[r + 2], C0[r + 3]); a = MX3(a, C1[r], C1[r + 1]); b_ = MX3(b_, C1[r + 2], C1[r + 3]); } \
      float rm = __builtin_fmaxf(a, b_); { auto rr = __builtin_amdgcn_permlane32_swap(__float_as_uint(rm), __float_as_uint(rm), false, false); rm = __builtin_fmaxf(__uint_as_float(rr[0]), __uint_as_float(rr[1])); } \
      resc = false; \
      if (__builtin_expect(__any(rm > (float)THRL), 0)) { const float dl = __builtin_fmaxf(rm, 0.f); mhat += dl; \
        _Pragma("unroll") for (int r = 0; r < 16; ++r) { C0[r] -= dl; C1[r] -= dl; } \
        if (MODE == 0) { _Pragma("unroll") for (int r = 0; r < 16; ++r) negm[r] = -mhat; asm volatile("" : "+v"(negm)); } else qx = qx_frag(-mhat, hi); \
        const float f = __builtin_amdgcn_exp2f(-dl); l_reg *= f; if (hi == 0) wsf[r32] = f; resc = true; } } while (0)
#define RESC() do { if (resc) { asm volatile("s_waitcnt lgkmcnt(0)" ::: "memory"); \
      _Pragma("unroll") for (int d_ = 0; d_ < 2; ++d_) _Pragma("unroll") for (int r = 0; r < 16; ++r) o[d_][r] *= wsf[crow(r, hi)]; } } while (0)
  f32x16 pA0, pA1, pB0, pB1;
  int sl_prev = 0, sl_cur = 0, sl_next = SLOTB;
#define ROT() do { sl_prev = sl_cur; sl_cur = sl_next; sl_next = (sl_next == (NSLOT - 1) * SLOTB) ? 0 : sl_next + SLOTB; } while (0)
  if (MODE == 0) qkt(pA0, pA1, shm3 + LDS_K, qr, negm, r32, hi); else qkt(pA0, pA1, shm3 + LDS_K, qr, f32x16{}, r32, hi);
#define KXF(e) __builtin_bit_cast(bf16x8, (u32x4){(e)[0], (e)[1], kxc, 0u})
  if (MODE == 1) { const u32x2_t e0 = KX[kxi + kxs * tb], e1 = KX[kxi + kxs * tb + kxh];
    pA0 = __builtin_amdgcn_mfma_f32_32x32x16_bf16(KXF(e0), qx, pA0, 0, 0, 0); pA1 = __builtin_amdgcn_mfma_f32_32x32x16_bf16(KXF(e1), qx, pA1, 0, 0, 0);
    ec0 = KX[kxi + kxs * (tb + 1)]; ec1 = KX[kxi + kxs * (tb + 1) + kxh]; }
  MASKB(pA0, pA1, 0);
  DECIDE(pA0, pA1);
#pragma unroll
  for (int r = 0; r < 16; ++r) { pA0[r] = __builtin_amdgcn_exp2f(pA0[r]); pA1[r] = __builtin_amdgcn_exp2f(pA1[r]); }
  WAIT_BAR(0);
  DMA_K(3, 0); DMA_V(1, SLOTB);
  ROT();
  kload8(kf, kp0 + sl_cur);
  WAIT_BAR(2);
  s16x4 vlo[8], vhi[8]; u32x4 pw0, pw1, pw2, pw3;
#define PKW(P, B) cvtpk_s(P[B], P[B + 1])
#define PAF(k) __builtin_bit_cast(bf16x8, pw##k)
#define VFR(i) (bf16x8){vlo[i][0], vlo[i][1], vlo[i][2], vlo[i][3], vhi[i][0], vhi[i][1], vhi[i][2], vhi[i][3]}
#define PIN(x) asm volatile("" : "+v"(x))
#define GAPA(MF, A0, A1, A2, A3, W0, W1, PW) do { MF; sacc += A0; sacc += A1; sacc += A2; sacc += A3; PIN(sacc); W0; W1; PIN(PW); SBAR(); } while (0)
#define EX(v) __builtin_amdgcn_exp2f(v)
#define GAPB(MF, X, B) do { MF; X[B] = EX(X[B]); X[B + 1] = EX(X[B + 1]); X[B + 2] = EX(X[B + 2]); X[B + 3] = EX(X[B + 3]); PIN(X); SBAR(); } while (0)
#define VRD(i) do { vlo[i] = vtr(vp_ + (((i) >> 2) * 4096 + ((i) & 3) * 1024)); vhi[i] = vtr(vp_ + (((i) >> 2) * 4096 + ((i) & 3) * 1024 + 512)); } while (0)
#define KRD(G, j) do { if (G) { kload2(kf, kp0 + sl_next, j); SBAR(); } } while (0)
#define MF32(a, b, c) __builtin_amdgcn_mfma_f32_32x32x16_bf16(a, b, c, 0, 0, 0)
#define CIN (MODE == 0 ? negm : f32x16{})
#define STEP(C0, C1, P0, P1, t, GK, GV, GL) do { SBAR(); \
    const lds_cptr vp_ = vp0 + sl_prev; \
    VRD(0); SBAR(); float sacc = (P0[0] + P0[1]); \
    GAPA(C0 = MF32(kf[0], qr[0], CIN), P0[2], P0[3], P0[4], P0[5],     pw0[0] = PKW(P0, 0), pw0[1] = PKW(P0, 2), pw0); \
    VRD(4); SBAR(); GAPA(C1 = MF32(kf[1], qr[0], CIN), P0[6], P0[7], P0[8], P0[9],     pw0[2] = PKW(P0, 4), pw0[3] = PKW(P0, 6), pw0); \
    VRD(1); SBAR(); GAPA(C0 = MF32(kf[2], qr[1], C0),   P0[10], P0[11], P0[12], P0[13], pw1[0] = PKW(P0, 8), pw1[1] = PKW(P0, 10), pw1); \
    VRD(5); SBAR(); GAPA(C1 = MF32(kf[3], qr[1], C1),   P0[14], P0[15], P1[0], P1[1],   pw1[2] = PKW(P0, 12), pw1[3] = PKW(P0, 14), pw1); \
    VRD(2); SBAR(); GAPA(C0 = MF32(kf[4], qr[2], C0),   P1[2], P1[3], P1[4], P1[5],     pw2[0] = PKW(P1, 0), pw2[1] = PKW(P1, 2), pw2); \
    VRD(6); SBAR(); GAPA(C1 = MF32(kf[5], qr[2], C1),   P1[6], P1[7], P1[8], P1[9],     pw2[2] = PKW(P1, 4), pw2[3] = PKW(P1, 6), pw2); \
    VRD(3); SBAR(); GAPA(C0 = MF32(kf[6], qr[3], C0),   P1[10], P1[11], P1[12], P1[13], pw3[0] = PKW(P1, 8), pw3[1] = PKW(P1, 10), pw3); \
    VRD(7); SBAR(); GAPA(C1 = MF32(kf[7], qr[3], C1),   P1[14], P1[15], 0.f, 0.f,       pw3[2] = PKW(P1, 12), pw3[3] = PKW(P1, 14), pw3); \
    if (MODE == 1) { C0 = MF32(KXF(ec0), qx, C0); C1 = MF32(KXF(ec1), qx, C1); SBAR(); } \
    l_reg += sacc; \
    if (GK) { DMA_K((t) + 3, sl_cur); } if (GV) { DMA_V((t) + 1, sl_next); } \
    MASKB(C0, C1, t); \
    DECIDE(C0, C1); \
    SBAR(); \
    GAPB(o[0] = MF32(PAF(0), VFR(0), o[0]), C0, 0); \
    GAPB(o[1] = MF32(PAF(0), VFR(4), o[1]), C0, 4); \
    KRD(GL, 0); GAPB(o[0] = MF32(PAF(1), VFR(1), o[0]), C0, 8); \
    KRD(GL, 1); GAPB(o[1] = MF32(PAF(1), VFR(5), o[1]), C0, 12); \
    KRD(GL, 2); GAPB(o[0] = MF32(PAF(2), VFR(2), o[0]), C1, 0); \
    KRD(GL, 3); GAPB(o[1] = MF32(PAF(2), VFR(6), o[1]), C1, 4); \
    GAPB(o[0] = MF32(PAF(3), VFR(3), o[0]), C1, 8); \
    GAPB(o[1] = MF32(PAF(3), VFR(7), o[1]), C1, 12); \
    if (MODE == 1 && (GL)) { ec0 = KX[kxi + kxs * (tb + (t) + 1)]; ec1 = KX[kxi + kxs * (tb + (t) + 1) + kxh]; } \
    } while (0)
  int t = 1;
  if (MODE == 1) {
    for (; t + 5 < NT; t += 2) {
      STEP(pB0, pB1, pA0, pA1, t, true, true, true);     WAIT_BAR(2); RESC(); ROT();
      STEP(pA0, pA1, pB0, pB1, t + 1, true, true, true); WAIT_BAR(2); RESC(); ROT();
    }
  }
#define ENDW(tt) do { if ((tt) + 3 < NT) { WAIT_BAR(2); } else if ((tt) + 2 < NT) { WAIT_BAR(1); } else { WAIT_BAR(0); } } while (0)
  for (; t + 1 < NT; t += 2) {
    STEP(pB0, pB1, pA0, pA1, t, (t + 3 < NT), (t + 1 < NT), (t + 1 < NT));       ENDW(t);     RESC(); ROT();
    STEP(pA0, pA1, pB0, pB1, t + 1, (t + 4 < NT), (t + 2 < NT), (t + 2 < NT));   ENDW(t + 1); RESC(); ROT();
  }
  STEP(pB0, pB1, pA0, pA1, NT - 1, false, false, false); RESC();
  { float sacc = pB0[0] + pB0[1];
#pragma unroll
    for (int r = 2; r < 16; ++r) sacc += pB0[r];
#pragma unroll
    for (int r = 0; r < 16; ++r) sacc += pB1[r];
    l_reg += sacc;
    pw0 = (u32x4){PKW(pB0, 0), PKW(pB0, 2), PKW(pB0, 4), PKW(pB0, 6)}; pw1 = (u32x4){PKW(pB0, 8), PKW(pB0, 10), PKW(pB0, 12), PKW(pB0, 14)};
    pw2 = (u32x4){PKW(pB1, 0), PKW(pB1, 2), PKW(pB1, 4), PKW(pB1, 6)}; pw3 = (u32x4){PKW(pB1, 8), PKW(pB1, 10), PKW(pB1, 12), PKW(pB1, 14)};
    SBAR(); pv(o, vb0 + sl_cur, PAF(0), PAF(1), PAF(2), PAF(3)); }
  { auto rr = __builtin_amdgcn_permlane32_swap(__float_as_uint(l_reg), __float_as_uint(l_reg), false, false); l_reg = __uint_as_float(rr[0]) + __uint_as_float(rr[1]); }
  if (hi == 0) wsf[32 + r32] = l_reg;
  asm volatile("s_waitcnt lgkmcnt(0)" ::: "memory");
  float rli[16];
#pragma unroll
  for (int r = 0; r < 16; ++r) rli[r] = __builtin_amdgcn_rcpf(wsf[32 + crow(r, hi)]);
  bf16* Ow = O + (rowbase + q0 + wid * QBLK) * DM + h * D;
  { ALAS bf16* stg = (ALAS bf16*)(shm + LDS_OST) + wid * 2048;
#pragma unroll
    for (int r = 0; r < 16; ++r) { const int orow = crow(r, hi);
#pragma unroll
      for (int d0 = 0; d0 < 2; ++d0) stg[orow * 64 + d0 * 32 + r32] = (bf16)(cvtpk_s(o[d0][r] * rli[r], 0.f) & 0xffffu); }
    asm volatile("s_waitcnt lgkmcnt(0)" ::: "memory");
#pragma unroll
    for (int i = 0; i < 4; ++i) { const int row = i * 8 + (lane >> 3), ch = lane & 7; const u32x4 v = *(const ALAS u32x4*)(stg + row * 64 + ch * 8); *(u32x4*)(Ow + (long)row * DM + ch * 8) = v; } }
  asm volatile("s_waitcnt lgkmcnt(0)\n\ts_barrier" ::: "memory");
#undef DMA_K
#undef DMA_V
#undef MASKB
#undef DECIDE
#undef RESC
#undef ROT
#undef PKW
#undef PAF
#undef VFR
#undef PIN
#undef GAPA
#undef EX
#undef GAPB
#undef VRD
#undef KRD
#undef MF32
#undef CIN
#undef KXF
#undef STEP
#undef ENDW
}
}
#define GAS __attribute__((address_space(1)))
#define LAS __attribute__((address_space(3)))
typedef unsigned short bf16;
typedef unsigned v4u __attribute__((ext_vector_type(4)));
typedef float f32x4 __attribute__((ext_vector_type(4)));
typedef short bf16x8 __attribute__((ext_vector_type(8)));
typedef GAS unsigned gu32;
typedef GAS unsigned long long gu64;
#define RLX_AGENT __ATOMIC_RELAXED, __HIP_MEMORY_SCOPE_AGENT
#define LDS_WAIT() asm volatile("s_waitcnt lgkmcnt(0)" ::: "memory")
#define VM_WAIT() asm volatile("s_waitcnt vmcnt(0)" ::: "memory")
__device__ __forceinline__ unsigned long long rt() { return __builtin_amdgcn_s_memrealtime(); }
__device__ __forceinline__ unsigned f2bf(float f) { unsigned u = __builtin_bit_cast(unsigned, f); return (u + 0x7fffu + ((u >> 16) & 1u)) >> 16; }
__device__ __forceinline__ unsigned pk2(float lo, float hi) { return f2bf(lo) | (f2bf(hi) << 16); }

#define XB_TMO      128
#define XB_XCNT(j)  (256  + 64 * (j))
#define XB_XSUB(j)  (1280 + 64 * (j))
#define XB_XGEN(j)  (2304 + 64 * (j))
#define XB_TOP      3328
#define XB_TOPGEN   3392
#define XCD_BAR_WORDS 3456
#define XB_SPIN_CAP (1u << 18)

__device__ __forceinline__ unsigned xb_ld(unsigned* p)              { return __hip_atomic_load(p, __ATOMIC_RELAXED, __HIP_MEMORY_SCOPE_AGENT); }
__device__ __forceinline__ unsigned xb_add(unsigned* p, unsigned v) { return __hip_atomic_fetch_add(p, v, __ATOMIC_RELAXED, __HIP_MEMORY_SCOPE_AGENT); }
__device__ __forceinline__ unsigned xb_xcc_id() { return (unsigned)__builtin_amdgcn_s_getreg((3 << 11) | 20) & 0xFu; }
#define XB_SPIN(cond, bar) do { unsigned _sp = 0; while (cond) { __builtin_amdgcn_s_sleep(1); \
    if ((++_sp & 255u) == 0u) { if (xb_ld(&(bar)[XB_TMO])) break; if (_sp > XB_SPIN_CAP) { atomicAdd(&(bar)[XB_TMO], 1u); break; } } } } while (0)

struct XcdBarrier {
    unsigned* bar; unsigned x; unsigned G;
    volatile LAS unsigned* st;
};

__device__ __forceinline__ XcdBarrier xcd_barrier_post(unsigned* bar, volatile LAS unsigned* st, unsigned G) {
    XcdBarrier b; b.bar = bar; b.x = xb_xcc_id(); b.st = st; b.G = G;
    if (threadIdx.x == 0) (void)xb_add(&bar[XB_XCNT(b.x)], 1u);
    return b;
}
__device__ __forceinline__ void xcd_barrier_complete(unsigned* bar, unsigned x, unsigned& nloc, unsigned& nx, const unsigned G) {
    unsigned sum, cnt, mine, sp = 0u;
    for (;;) {
        sum = 0u; cnt = 0u; mine = 0u;
#pragma unroll
        for (unsigned j = 0; j < 16; ++j) { const unsigned c = xb_ld(&bar[XB_XCNT(j)]); sum += c; cnt += (c > 0u) ? 1u : 0u; mine = (j == x) ? c : mine; }
        if (sum == G) break;
        __builtin_amdgcn_s_sleep(1);
        if ((++sp & 255u) == 0u) { if (xb_ld(&bar[XB_TMO])) break; if (sp > XB_SPIN_CAP) { atomicAdd(&bar[XB_TMO], 1u); break; } }
    }
    nloc = mine > 0u ? mine : 1u; nx = cnt > 0u ? cnt : 1u;
}

__device__ __forceinline__ void xcd_barrier(const XcdBarrier& b) {
    asm volatile("s_waitcnt vmcnt(0)" ::: "memory");
    __syncthreads();
    if (threadIdx.x == 0) {
        unsigned* bar = b.bar; asm volatile("" : "+s"(bar));
        __builtin_amdgcn_s_waitcnt(0);
        unsigned nloc = b.st[0], nx = b.st[1];
        unsigned bx_ = b.x; asm volatile("" : "+s"(bx_));
        if (nloc == 0u) { xcd_barrier_complete(bar, bx_, nloc, nx, b.G); b.st[0] = nloc; b.st[1] = nx; }
        if (nx == 1u) asm volatile("buffer_inv sc1" ::: "memory");
        const unsigned old = xb_add(&bar[XB_XSUB(bx_)], 1u);
        const unsigned gen = old / nloc;
        if (nx == 1u) {
            const unsigned target = (gen + 1u) * nloc;
            if (old + 1u != target) XB_SPIN((int)(xb_ld(&bar[XB_XSUB(bx_)]) - target) < 0, bar);
            asm volatile("s_waitcnt vmcnt(0)" ::: "memory");
        } else
        if (old + 1u == (gen + 1u) * nloc) {
            if (nx > 1u) __builtin_amdgcn_fence(__ATOMIC_RELEASE, "agent");
            asm volatile("s_waitcnt vmcnt(0)" ::: "memory");
            const unsigned og = xb_add(&bar[XB_TOP], 1u);
            const unsigned tg = og / nx;
            if (og + 1u == (tg + 1u) * nx) xb_add(&bar[XB_TOPGEN], 1u);
            else XB_SPIN(xb_ld(&bar[XB_TOPGEN]) == tg, bar);
            __builtin_amdgcn_fence(__ATOMIC_ACQUIRE, "agent");
            xb_add(&bar[XB_XGEN(bx_)], 1u);
            asm volatile("s_waitcnt vmcnt(0)" ::: "memory");
        } else {
            XB_SPIN(xb_ld(&bar[XB_XGEN(bx_)]) == gen, bar);
            __builtin_amdgcn_fence(__ATOMIC_ACQUIRE, "agent");
            asm volatile("s_waitcnt vmcnt(0)" ::: "memory");
        }
    }
    __syncthreads();
}


__device__ __forceinline__ void row_barrier(unsigned* cnt, unsigned* tmo_bar) {
    asm volatile("s_waitcnt vmcnt(0)" ::: "memory");
    __syncthreads();
    if (threadIdx.x == 0) {
        asm volatile("" : "+s"(cnt), "+s"(tmo_bar));
        __builtin_amdgcn_s_waitcnt(0);
        asm volatile("buffer_inv sc1" ::: "memory");
        const unsigned old = xb_add(cnt, 1u);
        const unsigned target = (old / 4u + 1u) * 4u;
        if (old + 1u != target) XB_SPIN((int)(xb_ld(cnt) - target) < 0, tmo_bar);
        asm volatile("s_waitcnt vmcnt(0)" ::: "memory");
    }
    __syncthreads();
}

__device__ __forceinline__ void split_barrier(const XcdBarrier& b, unsigned* rcnt, unsigned* tmo_bar, volatile LAS unsigned* tgt) {
    asm volatile("s_waitcnt vmcnt(0)" ::: "memory");
    __syncthreads();
    if (threadIdx.x == 0) {
        unsigned* bar = b.bar; asm volatile("" : "+s"(bar), "+s"(rcnt), "+s"(tmo_bar));
        __builtin_amdgcn_s_waitcnt(0);
        const unsigned nloc = b.st[0]; unsigned bx_ = b.x; asm volatile("" : "+s"(bx_));
        asm volatile("buffer_inv sc1" ::: "memory");
        const unsigned og = xb_add(&bar[XB_XSUB(bx_)], 1u);
        tgt[0] = (og / nloc + 1u) * nloc;
        const unsigned old = xb_add(rcnt, 1u);
        const unsigned target = (old / 4u + 1u) * 4u;
        if (old + 1u != target) XB_SPIN((int)(xb_ld(rcnt) - target) < 0, tmo_bar);
        asm volatile("s_waitcnt vmcnt(0) lgkmcnt(0)" ::: "memory");
    }
    __syncthreads();
}

constexpr int NWAVES = 8;
constexpr int BATCH = 8, T = 2048, D = 1024, H = 16, HD = 64, FF = 4096, DEPTH = 4;
constexpr int M = BATCH * T;
constexpr int QKV_A = 1536, QKVF_B = 3088, NQKV_B = 3072;
constexpr size_t MiB = 1u << 20;
constexpr size_t WS_CTL = 0, CTL_ZERO_BYTES = 160 * 1024;
constexpr size_t WS_SSQ = 1 * MiB;
constexpr size_t WS_CT = 1 * MiB + 512 * 1024;
constexpr size_t WS_CL = 2 * MiB;
constexpr size_t WS_WF = 3 * MiB;
constexpr size_t WS_W = 4 * MiB;
constexpr size_t WS_XB = 94 * MiB;
constexpr size_t WS_BLK = 128 * MiB, BLK_BYTES = 16 * MiB;
constexpr size_t BLK_K = 4 * MiB, BLK_V = 8 * MiB, BLK_SPARE = 12 * MiB;
constexpr size_t WS_END = 256 * MiB;
__host__ __device__ constexpr size_t layer_w_base(int l) { return WS_W + (size_t)(l == 0 ? 0 : l == 1 ? 21 : l == 2 ? 45 : 66) * MiB; }
__host__ __device__ constexpr size_t layer_qkv_bytes(int l) { return (size_t)((l & 1) ? 6 : 3) * MiB; }
static_assert(layer_w_base(3) + 24 * MiB == WS_XB && WS_XB + 32 * MiB <= WS_BLK && WS_BLK + 8 * BLK_BYTES == WS_END, "ws map");
constexpr int CW_BAR = 4096;
static_assert((size_t)(CW_BAR + 9 * 3456) * 4 <= CTL_ZERO_BYTES && CTL_ZERO_BYTES <= WS_SSQ, "control words inside the per-call memset");
constexpr int RING_OFF = 0, RING_BYTES = 131072;
constexpr int LDSCTL_OFF = RING_BYTES, MISC_OFF = LDSCTL_OFF + 320;
constexpr int LDS_BYTES = 147456;
static_assert(att::LDS_BYTES <= RING_BYTES, "attention scratch inside the ring region");

__device__ __forceinline__ float wave_sum(float v) {
#pragma unroll
    for (int o = 1; o < 64; o <<= 1) v += __shfl_xor(v, o);
    return v;
}
struct TItem { const float* W; const float* gain; bf16* WT; int K, ldw, k0, n0; };
template <bool NT = false> __device__ __forceinline__ void p0_item_load(const TItem& it, f32x4 (&v)[8], float (&g)[8], int lane) {
    const int kq = lane >> 3, c4 = (lane & 7) * 4;
#pragma unroll
    for (int i = 0; i < 8; ++i) { const int kk = i * 8 + kq; v[i] = NT ? __builtin_nontemporal_load((const GAS f32x4*)(it.W + (size_t)(it.k0 + kk) * it.ldw + it.n0 + c4)) : *(const GAS f32x4*)(it.W + (size_t)(it.k0 + kk) * it.ldw + it.n0 + c4); g[i] = it.gain ? it.gain[it.k0 + kk] : 1.0f; }
}
template <bool NT = false> __device__ __forceinline__ void p0_item_store(const TItem& it, const f32x4 (&v)[8], const float (&g)[8], LAS float* scr, int lane) {
    const int kq = lane >> 3, c4 = (lane & 7) * 4;
#pragma unroll
    for (int i = 0; i < 8; ++i) { LAS float* d = scr + (i * 8 + kq) * 33 + c4; d[0] = v[i].x * g[i]; d[1] = v[i].y * g[i]; d[2] = v[i].z * g[i]; d[3] = v[i].w * g[i]; }
    LDS_WAIT(); asm volatile("" ::: "memory");
    const int c = lane & 7;
#pragma unroll
    for (int j = 0; j < 4; ++j) { const int n = (lane >> 3) + 8 * j; const LAS float* s = scr + (8 * c) * 33 + n;
        v4u o; o.x = pk2(s[0 * 33], s[1 * 33]); o.y = pk2(s[2 * 33], s[3 * 33]); o.z = pk2(s[4 * 33], s[5 * 33]); o.w = pk2(s[6 * 33], s[7 * 33]);
        if (NT) __builtin_nontemporal_store(o, (GAS v4u*)(it.WT + (size_t)(it.n0 + n) * it.K + it.k0 + 8 * c)); else *(GAS v4u*)(it.WT + (size_t)(it.n0 + n) * it.K + it.k0 + 8 * c) = o; }
    LDS_WAIT(); asm volatile("" ::: "memory");
}

struct Args { const float* in[15]; float* out; unsigned char* ws; };

#define ARGIN(k) ([&]() -> const float* { int k_ = (k); asm volatile("" : "+s"(k_)); return args.in[k_]; }())
enum { A_X = 0, A_RELB = 1, A_NMIX = 2, A_NMLP = 3, A_WQKVA = 4, A_BQKVA = 5, A_SINKS = 6, A_WOA = 7, A_BOA = 8, A_WQKVFB = 9, A_BFB = 10, A_WOB = 11, A_WUP = 12, A_WDOWN = 13, A_NFIN = 14 };
static_assert(pg8::EP_SSQ == WS_SSQ && pg8::EP_XB == WS_XB && pg8::EP_BLK == WS_BLK && pg8::EP_BLKB == BLK_BYTES && pg8::EP_KOFF == BLK_K && pg8::EP_VOFF == BLK_V, "epilogue workspace offsets");
__global__ void __launch_bounds__(NWAVES * 64, 2) mk_fwd(Args args) {
    extern __shared__ __attribute__((aligned(16))) unsigned char lds[];
    LAS unsigned char* const L = (LAS unsigned char*)lds;
    const int tid = threadIdx.x, lane = tid & 63, wave = __builtin_amdgcn_readfirstlane(tid >> 6);
    const int G = gridDim.x; const int bx = blockIdx.x; const int vcu = (G % 8 == 0) ? (bx % 8) * (G / 8) + bx / 8 : bx;
    unsigned char* const ws = args.ws;
    for (int u = tid; u < (LDS_BYTES - LDSCTL_OFF) / 4; u += NWAVES * 64) ((LAS unsigned*)(L + LDSCTL_OFF))[u] = 0u;
    __syncthreads();
    XcdBarrier bar = xcd_barrier_post((unsigned*)((gu32*)(ws + WS_CTL) + CW_BAR), (volatile LAS unsigned*)(L + MISC_OFF) + 8, (unsigned)G);
    XcdBarrier gbar = xcd_barrier_post((unsigned*)((gu32*)(ws + WS_CTL) + CW_BAR) + (1 + (vcu >> 5)) * XCD_BAR_WORDS, (volatile LAS unsigned*)(L + MISC_OFF) + 10, 32u);
#define GROUP_BAR() do { xcd_barrier(gbar); if (DBL == 4) xcd_barrier(gbar); } while (0)
#ifndef DBL
#define DBL (-1)
#endif
#define GRID_BAR() do { xcd_barrier(bar); if (DBL == 4) xcd_barrier(bar); } while (0)
    const int gw = vcu * NWAVES + wave, NGW = G * NWAVES;

    constexpr int I_QA = (D / 64) * (QKV_A / 32), I_QB = (D / 64) * (NQKV_B / 32), I_O = (D / 64) * (D / 32), I_U = (D / 64) * (FF / 32), I_D = (FF / 64) * (D / 32);
    constexpr int I_LA = I_QA + I_O + I_U + I_D, I_LB = I_QB + I_O + I_U + I_D, NITEMS = 2 * (I_LA + I_LB);
    constexpr int CW_CONV = 1024;
    for (int rep_ = 0; rep_ < (DBL == 0 ? 2 : 1); ++rep_) {
        LAS float* scr = (LAS float*)(L + RING_OFF + wave * 16384);
#define P0_DECODE(it_, T_) do { int r = (it_), l = 0; \
            for (; l < DEPTH; ++l) { const int n_ = (l & 1) ? I_LB : I_LA; if (r < n_) break; r -= n_; } \
            const int j = l >> 1; const bool isb = (l & 1) != 0; unsigned char* wb = ws + layer_w_base(l); const int iq = isb ? I_QB : I_QA; int N_; \
            if (r < iq) { if (isb) { T_.W = ARGIN(A_WQKVFB) + (size_t)j * D * QKVF_B; N_ = NQKV_B; T_.ldw = QKVF_B; } else { T_.W = ARGIN(A_WQKVA) + (size_t)j * D * QKV_A; N_ = QKV_A; T_.ldw = QKV_A; } T_.gain = ARGIN(A_NMIX) + l * D; T_.K = D; } \
            else { r -= iq; wb += layer_qkv_bytes(l); \
              if (r < I_O) { T_.W = ARGIN(isb ? A_WOB : A_WOA) + (size_t)j * D * D; N_ = D; T_.ldw = D; T_.gain = nullptr; T_.K = D; } \
              else { r -= I_O; wb += 2 * MiB; \
                if (r < I_U) { T_.W = ARGIN(A_WUP) + (size_t)l * D * FF; N_ = FF; T_.ldw = FF; T_.gain = ARGIN(A_NMLP) + l * D; T_.K = D; } \
                else { r -= I_U; wb += 8 * MiB; T_.W = ARGIN(A_WDOWN) + (size_t)l * FF * D; N_ = D; T_.ldw = D; T_.gain = nullptr; T_.K = FF; } } } \
            T_.WT = (bf16*)wb; const int nblk_ = N_ / 32; T_.k0 = 64 * (r / nblk_); T_.n0 = 32 * (r % nblk_); } while (0)
#define P0_RUN(IT0_, IT1_, GW_, NGW_) do { f32x4 va[8], vb[8]; float ga[8], gb[8]; TItem ta, tb; const int it1_ = (IT1_), ngw_ = (NGW_); \
            int it = (IT0_) + (GW_); \
            if (it < it1_) { P0_DECODE(it, ta); p0_item_load<true>(ta, va, ga, lane); } \
            for (; it < it1_; it += 2 * ngw_) { \
                const bool hb = it + ngw_ < it1_; \
                if (hb) { P0_DECODE(it + ngw_, tb); p0_item_load<true>(tb, vb, gb, lane); } \
                p0_item_store(ta, va, ga, scr, lane); \
                const bool ha = it + 2 * ngw_ < it1_; \
                if (ha) { P0_DECODE(it + 2 * ngw_, ta); p0_item_load<true>(ta, va, ga, lane); } \
                if (hb) p0_item_store(tb, vb, gb, scr, lane); } } while (0)
#define P0_RUN1(IT0_, IT1_, GW_, NGW_) do { f32x4 va[8]; float ga[8]; TItem ta; const int it1_ = (IT1_), ngw_ = (NGW_); \
            for (int it = (IT0_) + (GW_); it < it1_; it += ngw_) { P0_DECODE(it, ta); p0_item_load<true>(ta, va, ga, lane); p0_item_store<false>(ta, va, ga, scr, lane); } } while (0)
        P0_RUN(0, I_QA, gw, NGW);
        { const float* nm = ARGIN(A_NMIX); const float* wq = ARGIN(A_WQKVFB); bf16* WF = (bf16*)(ws + WS_WF);
          for (int e = gw * 64 + lane; e < 2 * 16 * D; e += NGW * 64) { const int j = e / (16 * D), hh = (e / D) % 16, k = e % D;
            WF[e] = (bf16)f2bf(nm[(2 * j + 1) * D + k] * wq[(size_t)j * D * QKVF_B + (size_t)k * QKVF_B + NQKV_B + hh]); } }
        { const float* x_in = ARGIN(A_X); bf16* XB = (bf16*)(ws + WS_XB); float* SSQ = (float*)(ws + WS_SSQ) + (size_t)4 * M;
          for (int m = gw; m < M; m += NGW) {
            const GAS f32x4* xr = (const GAS f32x4*)(x_in + (size_t)m * D) + lane; GAS unsigned long long* o8 = (GAS unsigned long long*)(XB + (size_t)m * D) + lane;
            float s = 0.f;
#pragma unroll
            for (int jj = 0; jj < 4; ++jj) { const f32x4 v = __builtin_nontemporal_load(xr + 64 * jj); s += (v.x * v.x + v.y * v.y) + (v.z * v.z + v.w * v.w);
                o8[64 * jj] = (unsigned long long)pk2(v.x, v.y) | ((unsigned long long)pk2(v.z, v.w) << 32); }
            s = wave_sum(s);
            if (lane == 0) *(f32x4*)(SSQ + 4 * (size_t)m) = (f32x4){s, 0.f, 0.f, 0.f};
          } }
    }
    GRID_BAR();

#ifdef STAGGER_TICKS
    { const unsigned long long t0_ = __builtin_amdgcn_s_memrealtime(), dl_ = (unsigned long long)(vcu >> 5) * STAGGER_TICKS;
      while (__builtin_amdgcn_s_memrealtime() - t0_ < dl_) __builtin_amdgcn_s_sleep(8); }
#endif
    for (int l = 0; l < DEPTH; ++l) {
        for (int half = 0; half < 2; ++half) {
            const int j = l >> 1; const bool isb = (l & 1) != 0;
            unsigned char* ws = args.ws; asm volatile("" : "+s"(ws));
#define CONV_POLL(k_) do { if (threadIdx.x == 0) { unsigned* cv = (unsigned*)((gu32*)(ws + WS_CTL) + CW_CONV + 64 * (k_)); unsigned* tb_ = (unsigned*)((gu32*)(ws + WS_CTL) + CW_BAR); \
                    XB_SPIN(xb_ld(cv) < 128u, tb_); } } while (0)
            {
                const int N = half ? FF : (isb ? NQKV_B : QKV_A);
                const bf16* Wl = (const bf16*)(ws + layer_w_base(l) + (half ? layer_qkv_bytes(l) + 2 * MiB : 0));
                pg8::Gemm g{(const bf16*)(ws + WS_XB), Wl, M, N, D, (size_t)T * D * 2}; pg8::StaticOrder S; S.init(M, N, G, bx);
                pg8::EpiProj E; E.ws = ws; E.bias = (!half && !isb) ? ARGIN(A_BQKVA) + j * QKV_A : nullptr; E.mode = half ? 2 : (isb ? 1 : 0);
                E.wt = (LAS unsigned*)(L + MISC_OFF) + 12; E.wcnt = gbar.bar + XB_XSUB(gbar.x);
#ifndef NO_G1
                for (int rep_ = 0; rep_ < (DBL == 1 ? 2 : 1); ++rep_)
                pg8::gemm_phase<pg8::EpiProj, pg8::StaticOrder, true, true>(L + RING_OFF, g, S, E);
#endif
            }
            if (!half && !isb && bx >= 128) {
                int tq = threadIdx.x; asm volatile("" : "+v"(tq)); const int lane = tq & 63, wave = __builtin_amdgcn_readfirstlane(tq >> 6);
                LAS float* scr = (LAS float*)(L + RING_OFF + wave * 16384);
                const int it0 = l == 0 ? I_QA : I_LA + I_LB + I_QA, it1 = l == 0 ? I_LA + I_LB + I_QA : NITEMS;
                for (int rep_ = 0; rep_ < (DBL == 9 ? 2 : 1); ++rep_)
                P0_RUN1(it0, it1, (bx - 128) * NWAVES + wave, 128 * NWAVES);
                asm volatile("s_waitcnt vmcnt(0)" ::: "memory"); __syncthreads();
                if (threadIdx.x == 0) { __builtin_amdgcn_fence(__ATOMIC_RELEASE, "agent"); asm volatile("s_waitcnt vmcnt(0)" ::: "memory");
                    xb_add((unsigned*)((gu32*)(ws + WS_CTL) + CW_CONV + 64 * (l >> 1)), 1u); }
            }
            if (!half) {
                if (isb) {
                    int tid = threadIdx.x; asm volatile("" : "+v"(tid)); const int lane = tid & 63;
                    const int R0 = (vcu >> 5) * T + (vcu & 7) * 256 + ((vcu & 31) >> 3) * 64; const int fr = lane & 15, fq = lane >> 4;
                    for (int rep_ = 0; rep_ < (DBL == 6 ? 2 : 1); ++rep_) if (R0 < M) { if (rep_) { LDS_WAIT(); __builtin_amdgcn_s_barrier(); }
                    const bf16* XB = (const bf16*)(ws + WS_XB); const bf16* WF = (const bf16*)(ws + WS_WF); const float* SSQ = (const float*)(ws + WS_SSQ) + (size_t)4 * M;
                    float* CT = (float*)(ws + WS_CT); float* CL = (float*)(ws + WS_CL); const float* bfb = ARGIN(A_BFB) + j * 16;
                    pg8::f32x4 fa[4];
#pragma unroll
                    for (int gI = 0; gI < 4; ++gI) fa[gI] = (pg8::f32x4){0.f, 0.f, 0.f, 0.f};
                    const bf16* wf = WF + (size_t)j * 16 * D + (size_t)fr * D + 128 * wave + 8 * fq;
                    const bf16* xa = XB + (size_t)(R0 + fr) * D + 128 * wave + 8 * fq;
#pragma unroll
                    for (int ks = 0; ks < 4; ++ks) { const bf16x8 bfr = *(const bf16x8*)(wf + 32 * ks);
#pragma unroll
                        for (int gI = 0; gI < 4; ++gI) { const bf16x8 afr = *(const bf16x8*)(xa + (size_t)(16 * gI) * D + 32 * ks); fa[gI] = __builtin_amdgcn_mfma_f32_16x16x32_bf16(afr, bfr, fa[gI], 0, 0, 0); } }
                    LAS float* part = (LAS float*)(L + RING_OFF);
                    LAS float* lf = (LAS float*)(L + RING_OFF + 32768);
#pragma unroll
                    for (int gI = 0; gI < 4; ++gI)
#pragma unroll
                        for (int e = 0; e < 4; ++e) part[(wave * 64 + 16 * gI + 4 * fq + e) * 16 + fr] = fa[gI][e];
                    LDS_WAIT(); __builtin_amdgcn_s_barrier(); asm volatile("" ::: "memory");
                    for (int e = tid; e < 1024; e += NWAVES * 64) { const int row = e >> 4, hh = e & 15; float s = 0.f;
#pragma unroll
                        for (int w = 0; w < 8; ++w) s += part[(w * 64 + row) * 16 + hh];
                        const float z = s * pg8::row_rstd(SSQ, R0 + row) + bfb[hh];
                        lf[hh * 64 + row] = (fminf(z, 0.f) - log1pf(__expf(-fabsf(z)))) * att::LOG2E; }
                    LDS_WAIT(); __builtin_amdgcn_s_barrier(); asm volatile("" ::: "memory");
                    const int bb = R0 / T, t0 = R0 % T;
#pragma unroll
                    for (int q = 0; q < 2; ++q) { const int hh = 2 * wave + q; const float v = lf[hh * 64 + lane]; float inc = v;
#pragma unroll
                        for (int s = 1; s < 64; s <<= 1) { const float uu = __shfl_up(inc, s); if (lane >= s) inc += uu; }
                        CL[(size_t)(bb * 16 + hh) * T + t0 + lane] = inc;
                        if (lane == 63) CT[(size_t)(bb * 16 + hh) * 32 + (t0 >> 6)] = inc; }
                    }
                }
                GROUP_BAR();
                {
                    att::AttnAux ax; ax.rel_bias = ARGIN(A_RELB); ax.sinks = ARGIN(A_SINKS) + j * 16; ax.CL = (const float*)(ws + WS_CL); ax.CT = (const float*)(ws + WS_CT);
                    const int bh = vcu >> 1; unsigned char* const blk = ws + WS_BLK + (size_t)(bh >> 4) * BLK_BYTES;
                    bf16* const QB_ = (bf16*)blk; const bf16* const KB_ = (const bf16*)(blk + BLK_K); const bf16* const VB_ = (const bf16*)(blk + BLK_V);
                    const int nrep_ = (DBL == 2 || (DBL == 7 && !isb) || (DBL == 8 && isb)) ? 2 : 1;
                    for (int rep_ = 0; rep_ < nrep_; ++rep_) { bf16* const OB_ = (rep_ + 1 < nrep_) ? (bf16*)(blk + BLK_SPARE) : QB_;
                    if (!isb) {
#ifndef NO_SWA
                        att::attn_swa_sweep(bh & 15, vcu & 1, QB_, KB_, VB_, OB_, (LAS char*)(L + RING_OFF), ax);
#endif
                    } else
                    for (int i = 0; i < 4; ++i) {
                        if (isb) { const int s = vcu & 1; const int qb = s == 0 ? (i == 0 ? 7 : i == 1 ? 0 : i == 2 ? 5 : 2) : (i == 0 ? 6 : i == 1 ? 1 : i == 2 ? 4 : 3);

#ifndef NO_FOX
                            att::attn_unit_v2<1, 24>(bh >> 4, bh & 15, qb, QB_, KB_, VB_, OB_, (LAS char*)(L + RING_OFF), ax, i == 0);
#endif
                        }
                        else {
#ifndef NO_SWA
                            att::attn_unit_v1<0>(bh >> 4, bh & 15, (vcu & 1) * 4 + i, QB_, KB_, VB_, OB_, (LAS char*)(L + RING_OFF), ax);
#endif
                        }
                    } }
                }
                if (!isb) CONV_POLL(l >> 1);
                GROUP_BAR();
            } else {
                if (gbar.st[1] == 1u) row_barrier((unsigned*)((gu32*)(ws + WS_CTL) + 2048 + 16 * ((vcu >> 5) * 8 + (vcu & 7))), (unsigned*)((gu32*)(ws + WS_CTL) + CW_BAR)); else GROUP_BAR();
            }
            {
                const bf16* Wl = (const bf16*)(ws + layer_w_base(l) + layer_qkv_bytes(l) + (half ? 10 * MiB : 0));
                pg8::Gemm g{(const bf16*)(ws + WS_BLK), Wl, M, D, half ? FF : D, BLK_BYTES}; pg8::StaticOrder S; S.init(M, D, G, bx);
                const bool fin = half && l == DEPTH - 1;
                pg8::EpiRes E; E.ws = ws; E.bias = (!half && !isb) ? ARGIN(A_BOA) + j * D : nullptr; E.sq = half; E.fout = fin ? args.out : nullptr; E.fgain = ARGIN(A_NFIN); E.fbar = &gbar;
#ifndef NO_G2
                pg8::gemm_phase<pg8::EpiRes, pg8::StaticOrder, false, true>(L + RING_OFF, g, S, E);
#endif
            }
            if (half && l + 1 < DEPTH) CONV_POLL(l + 1 == 3 ? 1 : 0);
            if (!(half && l == DEPTH - 1)) {
                if (gbar.st[1] == 1u) split_barrier(gbar, (unsigned*)((gu32*)(ws + WS_CTL) + 2048 + 16 * ((vcu >> 5) * 8 + (vcu & 7))), (unsigned*)((gu32*)(ws + WS_CTL) + CW_BAR), (volatile LAS unsigned*)(L + MISC_OFF) + 12);
                else GROUP_BAR();
            }
        }
    }
#undef P0_RUN
#undef P0_RUN1
#undef P0_DECODE
#undef CONV_POLL
}

extern "C" void kernel_launch(void* const* d_in, const int* in_sizes, int n_in, void* d_out, int out_size, void* d_ws, size_t ws_size, hipStream_t stream) {
    static int grid = 0;
    if (grid == 0) {
        if (n_in != 15 || in_sizes[0] != M * D || out_size != M * D || ws_size < WS_END) { fprintf(stderr, "kernel_launch: unexpected shapes / workspace (n_in %d, in0 %d, out %d, ws %zu); nothing launched\n", n_in, n_in > 0 ? in_sizes[0] : -1, out_size, ws_size); grid = -1; return; }
        int dev = 0, cus = 0, per_cu = 0;
        if (hipGetDevice(&dev) != hipSuccess || hipDeviceGetAttribute(&cus, hipDeviceAttributeMultiprocessorCount, dev) != hipSuccess) { grid = -1; return; }
        if (hipFuncSetAttribute((const void*)mk_fwd, hipFuncAttributeMaxDynamicSharedMemorySize, LDS_BYTES) != hipSuccess) { fprintf(stderr, "kernel_launch: hipFuncSetAttribute failed\n"); grid = -1; return; }
        if (hipOccupancyMaxActiveBlocksPerMultiprocessor(&per_cu, (const void*)mk_fwd, NWAVES * 64, LDS_BYTES) != hipSuccess || per_cu < 1) { fprintf(stderr, "kernel_launch: occupancy query says %d blocks per CU\n", per_cu); }
        (void)hipGetLastError();
        grid = cus;
        if (grid != 256) { fprintf(stderr, "kernel_launch: built for a 256-CU device, found %d CUs; nothing launched\n", cus); grid = -1; return; }
    }
    if (grid < 0) return;
    if (hipMemsetAsync((char*)d_ws + WS_CTL, 0, CTL_ZERO_BYTES, stream) != hipSuccess) return;
    Args a{};
    for (int i = 0; i < 15; ++i) a.in[i] = (const float*)d_in[i];
    a.out = (float*)d_out; a.ws = (unsigned char*)d_ws;
    hipLaunchKernelGGL(mk_fwd, dim3(grid), dim3(NWAVES * 64), LDS_BYTES, stream, a);
}
```
